# Optimizing an MI355X kernel written in HIP

```python
import math
import jax
import jax.numpy as jnp
from jax import lax
import numpy as np

D_MODEL = 1024
BATCH = 8
SEQ = 4096
DEPTH = 2

N_MIXERS = 2
RMS_EPS = 1e-6

GLA_HEADS = 4
GLA_DK = D_MODEL // 2
GLA_DV = D_MODEL
GLA_DK_HEAD = GLA_DK // GLA_HEADS
GLA_DV_HEAD = GLA_DV // GLA_HEADS
GLA_GATE_RANK = 16
GLA_GATE_TEMP = 16.0
GLA_CHUNK = 64
GLA_IN_COLS = 2 * GLA_DK + 2 * GLA_DV + GLA_GATE_RANK

LRU_WIDTH = D_MODEL
LRU_BLOCKS = 4
LRU_BLOCK_W = LRU_WIDTH // LRU_BLOCKS
LRU_CONV_W = 4
LRU_C = 8.0

MOE_GROUPS = 4
MOE_EXPERTS_PER_GROUP = 8
MOE_EXPERTS = MOE_GROUPS * MOE_EXPERTS_PER_GROUP
MOE_TOPK = 2
MOE_FF = D_MODEL // 4
MOE_BLOCK = 128

N_GLA_LAYERS = (DEPTH + 1) // 2
N_LRU_LAYERS = DEPTH // 2

kernel_name = "hybrid_gla_rglru_hier_moe"


def rmsnorm(x, w):
    xf = x.astype(jnp.float32)
    y = xf * lax.rsqrt(jnp.mean(xf * xf, axis=-1, keepdims=True) + RMS_EPS)
    return (y * w.astype(jnp.float32)).astype(x.dtype)


def gla_mixer(x, norm_w, w_in, w_alpha, b_alpha, head_norm_w, w_out):
    bsz, seq, _ = x.shape
    n_chunks = seq // GLA_CHUNK
    h = rmsnorm(x, norm_w)
    proj = h @ w_in
    q, k, v, g, lr = jnp.split(
        proj, [GLA_DK, 2 * GLA_DK, 2 * GLA_DK + GLA_DV, 2 * GLA_DK + 2 * GLA_DV], axis=-1)
    log_a = jax.nn.log_sigmoid((lr @ w_alpha + b_alpha).astype(jnp.float32)) / GLA_GATE_TEMP

    def to_chunks(t, d):
        t = t.reshape(bsz, n_chunks, GLA_CHUNK, GLA_HEADS, d)
        return t.transpose(0, 3, 1, 2, 4).astype(jnp.float32)

    q = to_chunks(q, GLA_DK_HEAD) * (GLA_DK_HEAD ** -0.5)
    k = to_chunks(k, GLA_DK_HEAD)
    v = to_chunks(v, GLA_DV_HEAD)
    la = to_chunks(log_a, GLA_DK_HEAD)
    cum = jnp.cumsum(la, axis=3)
    ref = cum[:, :, :, GLA_CHUNK // 2:GLA_CHUNK // 2 + 1]

    q_in = q * jnp.exp(cum - ref)
    k_in = k * jnp.exp(ref - cum)
    causal = jnp.tril(jnp.ones((GLA_CHUNK, GLA_CHUNK), dtype=bool))
    scores = jnp.einsum('bhncd,bhnsd->bhncs', q_in, k_in)
    scores = jnp.where(causal, scores, 0.0)
    o_intra = jnp.einsum('bhncs,bhnse->bhnce', scores, v)

    last = cum[:, :, :, -1]
    k_st = k * jnp.exp(last[:, :, :, None, :] - cum)
    u = jnp.einsum('bhncd,bhnce->bhnde', k_st, v)

    def step(state, inp):
        decay, u_n = inp
        return decay[..., None] * state + u_n, state

    state0 = jnp.zeros((bsz, GLA_HEADS, GLA_DK_HEAD, GLA_DV_HEAD), jnp.float32)
    _, s_prev = lax.scan(step, state0, (jnp.moveaxis(jnp.exp(last), 2, 0), jnp.moveaxis(u, 2, 0)))
    s_prev = jnp.moveaxis(s_prev, 0, 2)
    o_inter = jnp.einsum('bhncd,bhnde->bhnce', q * jnp.exp(cum), s_prev)

    o = (o_intra + o_inter).transpose(0, 2, 3, 1, 4).reshape(bsz, seq, GLA_HEADS, GLA_DV_HEAD)
    o = rmsnorm(o, head_norm_w)
    o = o.reshape(bsz, seq, GLA_DV) * jax.nn.silu(g.astype(jnp.float32))
    return o.astype(x.dtype) @ w_out


def _lru_combine(left, right):
    a_l, b_l = left
    a_r, b_r = right
    return a_l * a_r, a_r * b_l + b_r


def rglru_mixer(x, norm_w, w_in, conv_w, conv_b, w_rgate, b_rgate, w_igate, b_igate, lam, w_out):
    bsz, seq, _ = x.shape
    h = rmsnorm(x, norm_w)
    xb, gb = jnp.split(h @ w_in, 2, axis=-1)
    gate = jax.nn.gelu(gb, approximate=True)
    xp = jnp.pad(xb, ((0, 0), (LRU_CONV_W - 1, 0), (0, 0)))
    xc = conv_b + xp[:, 0:seq] * conv_w[0]
    for tap in range(1, LRU_CONV_W):
        xc = xc + xp[:, tap:tap + seq] * conv_w[tap]
    xr = xc.reshape(bsz, seq, LRU_BLOCKS, LRU_BLOCK_W)
    r = jax.nn.sigmoid(jnp.einsum('bsni,nij->bsnj', xr, w_rgate).reshape(bsz, seq, LRU_WIDTH) + b_rgate)
    i = jax.nn.sigmoid(jnp.einsum('bsni,nij->bsnj', xr, w_igate).reshape(bsz, seq, LRU_WIDTH) + b_igate)
    log_a = -LRU_C * r.astype(jnp.float32) * jax.nn.softplus(-lam.astype(jnp.float32))
    a = jnp.exp(log_a)
    mult = jnp.sqrt(-jnp.expm1(2.0 * log_a))
    xn = xc.astype(jnp.float32) * i.astype(jnp.float32) * mult
    _, hs = lax.associative_scan(_lru_combine, (a, xn), axis=1)
    y = hs.astype(x.dtype) * gate
    return y @ w_out


def hier_moe(x, norm_w, w_group, w_expert, w_gate, w_up, w_down):
    bsz, seq, d = x.shape
    n_tok = bsz * seq
    h = rmsnorm(x, norm_w).reshape(n_tok, d)
    grp_logits = (h @ w_group).astype(jnp.float32)
    grp_prob = jax.nn.softmax(grp_logits, axis=-1)
    g_sel = jnp.argmax(grp_logits, axis=-1)
    p_g = jnp.take_along_axis(grp_prob, g_sel[:, None], axis=-1)[:, 0]
    exp_logits = (h @ w_expert).astype(jnp.float32).reshape(n_tok, MOE_GROUPS, MOE_EXPERTS_PER_GROUP)
    exp_logits = jnp.take_along_axis(exp_logits, g_sel[:, None, None], axis=1)[:, 0]
    exp_prob = jax.nn.softmax(exp_logits, axis=-1)
    top_p, top_e = lax.top_k(exp_prob, MOE_TOPK)
    top_p = top_p / jnp.sum(top_p, axis=-1, keepdims=True)
    weights = p_g[:, None] * top_p
    eid = g_sel[:, None] * MOE_EXPERTS_PER_GROUP + top_e

    n_assign = n_tok * MOE_TOPK
    eid_f = eid.reshape(-1).astype(jnp.int32)
    w_f = weights.reshape(-1)
    tok_f = jnp.repeat(jnp.arange(n_tok, dtype=jnp.int32), MOE_TOPK)
    order = jnp.argsort(eid_f)
    s_eid, s_tok, s_w = eid_f[order], tok_f[order], w_f[order]
    counts = jnp.bincount(eid_f, length=MOE_EXPERTS)
    starts = jnp.cumsum(counts) - counts
    pcounts = ((counts + MOE_BLOCK - 1) // MOE_BLOCK) * MOE_BLOCK
    pends = jnp.cumsum(pcounts)
    pstarts = pends - pcounts
    dest = pstarts[s_eid] + (jnp.arange(n_assign, dtype=jnp.int32) - starts[s_eid])
    n_blocks = (n_assign + MOE_BLOCK - 1) // MOE_BLOCK + MOE_EXPERTS
    n_rows = n_blocks * MOE_BLOCK
    buf_tok = jnp.full((n_rows,), n_tok, jnp.int32).at[dest].set(s_tok)
    buf_w = jnp.zeros((n_rows,), jnp.float32).at[dest].set(s_w)
    blk_start = jnp.arange(n_blocks, dtype=jnp.int32) * MOE_BLOCK
    blk_eid = jnp.minimum(jnp.searchsorted(pends, blk_start, side='right'), MOE_EXPERTS - 1)
    h_pad = jnp.concatenate([h, jnp.zeros((1, d), h.dtype)], axis=0)
    xb = h_pad[buf_tok].reshape(n_blocks, MOE_BLOCK, d)

    def expert_block(args):
        xblk, e = args
        return (jax.nn.silu(xblk @ w_gate[e]) * (xblk @ w_up[e])) @ w_down[e]

    yb = lax.map(expert_block, (xb, blk_eid)).reshape(n_rows, d)
    yb = yb * buf_w[:, None].astype(yb.dtype)
    out = jnp.zeros((n_tok + 1, d), yb.dtype).at[buf_tok].add(yb)[:n_tok]
    return out.reshape(bsz, seq, d).astype(x.dtype)


def setup_inputs(seed: int = 0) -> dict:
    key = jax.random.key(seed)
    ks = jax.random.split(key, 32)
    f32 = jnp.float32

    def nrm(k, shape, fan_in):
        return jax.random.normal(k, shape, f32) * (fan_in ** -0.5)

    def gain(k, shape):
        return 1.0 + 0.02 * jax.random.normal(k, shape, f32)

    def small(k, shape, s=0.02):
        return s * jax.random.normal(k, shape, f32)

    ng, nl, L = N_GLA_LAYERS, N_LRU_LAYERS, DEPTH
    u = jax.random.uniform(ks[18], (nl, LRU_WIDTH), f32, minval=0.9, maxval=0.999)
    s = u ** (1.0 / LRU_C)
    lam = jnp.log(s) - jnp.log1p(-s)
    return {
        "x": jax.random.normal(ks[0], (BATCH, SEQ, D_MODEL), f32),
        "gla_norm": gain(ks[1], (ng, D_MODEL)),
        "gla_w_in": nrm(ks[2], (ng, D_MODEL, GLA_IN_COLS), D_MODEL),
        "gla_w_alpha": nrm(ks[3], (ng, GLA_GATE_RANK, GLA_DK), GLA_GATE_RANK),
        "gla_b_alpha": small(ks[4], (ng, GLA_DK), 0.1),
        "gla_head_norm": gain(ks[5], (ng, GLA_DV_HEAD)),
        "gla_w_out": nrm(ks[6], (ng, GLA_DV, D_MODEL), GLA_DV),
        "lru_norm": gain(ks[7], (nl, D_MODEL)),
        "lru_w_in": nrm(ks[8], (nl, D_MODEL, 2 * LRU_WIDTH), D_MODEL),
        "lru_conv_w": nrm(ks[9], (nl, LRU_CONV_W, LRU_WIDTH), LRU_CONV_W),
        "lru_conv_b": small(ks[10], (nl, LRU_WIDTH)),
        "lru_w_rgate": nrm(ks[11], (nl, LRU_BLOCKS, LRU_BLOCK_W, LRU_BLOCK_W), LRU_BLOCK_W),
        "lru_b_rgate": small(ks[12], (nl, LRU_WIDTH)),
        "lru_w_igate": nrm(ks[13], (nl, LRU_BLOCKS, LRU_BLOCK_W, LRU_BLOCK_W), LRU_BLOCK_W),
        "lru_b_igate": small(ks[14], (nl, LRU_WIDTH)),
        "lru_lambda": lam,
        "lru_w_out": nrm(ks[15], (nl, LRU_WIDTH, D_MODEL), LRU_WIDTH),
        "moe_norm": gain(ks[16], (L, D_MODEL)),
        "moe_w_group": nrm(ks[17], (L, D_MODEL, MOE_GROUPS), D_MODEL),
        "moe_w_expert": nrm(ks[19], (L, D_MODEL, MOE_EXPERTS), D_MODEL),
        "moe_w_gate": nrm(ks[20], (L, MOE_EXPERTS, D_MODEL, MOE_FF), D_MODEL),
        "moe_w_up": nrm(ks[21], (L, MOE_EXPERTS, D_MODEL, MOE_FF), D_MODEL),
        "moe_w_down": nrm(ks[22], (L, MOE_EXPERTS, MOE_FF, D_MODEL), MOE_FF),
        "final_norm": gain(ks[23], (D_MODEL,)),
    }


def reference(x, gla_norm, gla_w_in, gla_w_alpha, gla_b_alpha, gla_head_norm, gla_w_out,
              lru_norm, lru_w_in, lru_conv_w, lru_conv_b, lru_w_rgate, lru_b_rgate,
              lru_w_igate, lru_b_igate, lru_lambda, lru_w_out,
              moe_norm, moe_w_group, moe_w_expert, moe_w_gate, moe_w_up, moe_w_down,
              final_norm):
    for layer in range(DEPTH):
        j = layer // N_MIXERS
        if layer % N_MIXERS == 0:
            x = x + gla_mixer(x, gla_norm[j], gla_w_in[j], gla_w_alpha[j], gla_b_alpha[j],
                              gla_head_norm[j], gla_w_out[j])
        else:
            x = x + rglru_mixer(x, lru_norm[j], lru_w_in[j], lru_conv_w[j], lru_conv_b[j],
                                lru_w_rgate[j], lru_b_rgate[j], lru_w_igate[j], lru_b_igate[j],
                                lru_lambda[j], lru_w_out[j])
        x = x + hier_moe(x, moe_norm[layer], moe_w_group[layer], moe_w_expert[layer],
                         moe_w_gate[layer], moe_w_up[layer], moe_w_down[layer])
    return rmsnorm(x, final_norm)
```

```cpp
#include <hip/hip_runtime.h>
#include <cstdio>
#include <cstdint>

typedef unsigned short bf16;
constexpr int T = 32768, D = 1024, SEQ = 4096, NB = 8;
constexpr float EPS = 1e-6f;
constexpr size_t MiB = 1u << 20;
constexpr size_t WS_CTL = 0;
constexpr size_t WS_RS0 = 1 * MiB, WS_RS1 = WS_RS0 + 128 * 1024, WS_RS2 = WS_RS1 + 128 * 1024, WS_RS3 = WS_RS2 + 128 * 1024;
constexpr size_t WS_EREF = 2 * MiB, WS_ELAST = 3 * MiB, WS_ELR = 4 * MiB;
constexpr size_t WS_S0 = 128 * MiB, WS_S1 = 192 * MiB, WS_S2 = 256 * MiB, WS_S3 = 320 * MiB, WS_S4 = 384 * MiB, WS_S5 = 448 * MiB, WS_END = 512 * MiB;

__device__ __forceinline__ float bf2f(bf16 b) { return __uint_as_float(((unsigned)b) << 16); }
__device__ __forceinline__ bf16 f2bf(float f) { unsigned u = __float_as_uint(f); u += 0x7fffu + ((u >> 16) & 1u); return (bf16)(u >> 16); }
__device__ __forceinline__ float wave_sum(float v) {
#pragma unroll
    for (int o = 1; o < 64; o <<= 1) v += __shfl_xor(v, o);
    return v;
}
__device__ __forceinline__ float sigmoidf_(float x) { return 1.f / (1.f + __expf(-x)); }
__device__ __forceinline__ float siluf_(float x) { return x / (1.f + __expf(-x)); }
__device__ __forceinline__ float logsigmoidf_(float x) { return fminf(x, 0.f) - log1pf(__expf(-fabsf(x))); }
__device__ __forceinline__ float softplusf_(float x) { return fmaxf(x, 0.f) + log1pf(__expf(-fabsf(x))); }
__device__ __forceinline__ float gelu_tanhf_(float x) { const float u = 0.7978845608028654f * (x + 0.044715f * x * x * x); return 0.5f * x * (1.f + tanhf(u)); }

__global__ void __launch_bounds__(256) n_prologue(const float* x, bf16* XB, float* RS) {
    const int row = blockIdx.x * 4 + (threadIdx.x >> 6), lane = threadIdx.x & 63;
    const float* xr = x + (size_t)row * D; float s = 0.f;
    for (int i = lane; i < D; i += 64) { const float v = xr[i]; s += v * v; XB[(size_t)row * D + i] = f2bf(v); }
    s = wave_sum(s);
    if (lane == 0) RS[row] = rsqrtf(s * (1.f / D) + EPS);
}

template <class Epi>
__global__ void __launch_bounds__(256) n_gemm(const bf16* A, int lda, const float* rs, const float* nw, const float* W, int ldw, int M, int N, int K, Epi epi) {
    __shared__ float As[16][65], Ws[16][64];
    const int tid = threadIdx.x, tx = tid & 15, ty = tid >> 4, m0 = blockIdx.y * 64, n0 = blockIdx.x * 64;
    float acc[4][4];
#pragma unroll
    for (int i = 0; i < 4; ++i)
#pragma unroll
        for (int j = 0; j < 4; ++j) acc[i][j] = 0.f;
    for (int k0 = 0; k0 < K; k0 += 16) {
#pragma unroll
        for (int i = 0; i < 4; ++i) { const int idx = tid + 256 * i, r = idx >> 4, kk = idx & 15; As[kk][r] = bf2f(A[(size_t)(m0 + r) * lda + k0 + kk]) * (nw ? nw[k0 + kk] : 1.f); }
#pragma unroll
        for (int i = 0; i < 4; ++i) { const int idx = tid + 256 * i, kk = idx >> 6, n = idx & 63; Ws[kk][n] = (n0 + n < N) ? W[(size_t)(k0 + kk) * ldw + n0 + n] : 0.f; }
        __syncthreads();
#pragma unroll
        for (int kk = 0; kk < 16; ++kk) {
            float a[4], b[4];
#pragma unroll
            for (int i = 0; i < 4; ++i) a[i] = As[kk][ty * 4 + i];
#pragma unroll
            for (int j = 0; j < 4; ++j) b[j] = Ws[kk][tx + 16 * j];
#pragma unroll
            for (int i = 0; i < 4; ++i)
#pragma unroll
                for (int j = 0; j < 4; ++j) acc[i][j] += a[i] * b[j];
        }
        __syncthreads();
    }
#pragma unroll
    for (int i = 0; i < 4; ++i) { const int r = m0 + ty * 4 + i; const float sc = rs ? rs[r] : 1.f;
#pragma unroll
        for (int j = 0; j < 4; ++j) { const int c = n0 + tx + 16 * j; if (c < N) epi(r, c, acc[i][j] * sc); } }
}
struct EpiGlaProj { bf16 *Q, *Kb, *V, *SG; float* LR;
    __device__ void operator()(int r, int c, float v) const {
        if (c < 512) Q[(size_t)r * 512 + c] = f2bf(v);
        else if (c < 1024) Kb[(size_t)r * 512 + c - 512] = f2bf(v);
        else if (c < 2048) V[(size_t)r * 1024 + c - 1024] = f2bf(v);
        else if (c < 3072) SG[(size_t)r * 1024 + c - 2048] = f2bf(siluf_(v));
        else LR[(size_t)r * 16 + c - 3072] = v; } };
struct EpiResid { const float* xf; const bf16* xb; bf16* out;
    __device__ void operator()(int r, int c, float v) const { const size_t i = (size_t)r * D + c; out[i] = f2bf((xf ? xf[i] : bf2f(xb[i])) + v); } };
struct EpiLruIn { bf16 *XBR, *GATE;
    __device__ void operator()(int r, int c, float v) const { if (c < 1024) XBR[(size_t)r * D + c] = f2bf(v); else GATE[(size_t)r * D + c - 1024] = f2bf(gelu_tanhf_(v)); } };
struct EpiGate { bf16* O; const float* bias; int coff;
    __device__ void operator()(int r, int c, float v) const { O[(size_t)r * D + coff + c] = f2bf(sigmoidf_(v + bias[coff + c])); } };

__global__ void __launch_bounds__(256) n_gla_prep(const float* LR, const float* w_alpha, const float* b_alpha, bf16* EQ, bf16* EK, float* EREF, float* ELAST, float* ELR, float* AF) {
    const int gi = blockIdx.x * 256 + threadIdx.x, chunk = gi >> 9, col = gi & 511;
    float wa[16];
#pragma unroll
    for (int r = 0; r < 16; ++r) wa[r] = w_alpha[r * 512 + col];
    const float ba = b_alpha[col];
    float cum = 0.f, ref = 0.f;
    for (int i = 0; i < 64; ++i) { const float* lr = LR + (size_t)(chunk * 64 + i) * 16; float z = ba;
#pragma unroll
        for (int r = 0; r < 16; ++r) z += lr[r] * wa[r];
        const float la = logsigmoidf_(z) * (1.f / 16.f); cum += la; if (i == 32) ref = cum; AF[(size_t)(chunk * 64 + i) * 512 + col] = __expf(la); }
    const float last = cum;
    EREF[chunk * 512 + col] = __expf(ref); ELAST[chunk * 512 + col] = __expf(last); ELR[chunk * 512 + col] = __expf(last - ref);
    cum = 0.f;
    for (int i = 0; i < 64; ++i) { const float* lr = LR + (size_t)(chunk * 64 + i) * 16; float z = ba;
#pragma unroll
        for (int r = 0; r < 16; ++r) z += lr[r] * wa[r];
        cum += logsigmoidf_(z) * (1.f / 16.f);
        const size_t o = (size_t)(chunk * 64 + i) * 512 + col;
        EQ[o] = f2bf(0.08838834764831845f * __expf(cum - ref)); EK[o] = f2bf(__expf(ref - cum)); }
}
__global__ void __launch_bounds__(256) n_gla_core(const bf16* Q, const bf16* Kb, const bf16* V, const bf16* SG, const float* AF, const float* hn, bf16* OG) {
    __shared__ float red[4];
    const int bh = blockIdx.x, b = bh >> 2, h = bh & 3, e = threadIdx.x, lane = e & 63, w = e >> 6;
    float S[128];
#pragma unroll
    for (int d = 0; d < 128; ++d) S[d] = 0.f;
    const float hw = hn[e];
    for (int t = 0; t < SEQ; ++t) {
        const size_t row = (size_t)b * SEQ + t;
        const float v = bf2f(V[row * 1024 + h * 256 + e]);
        const float* a = AF + row * 512 + h * 128; const bf16* k = Kb + row * 512 + h * 128; const bf16* q = Q + row * 512 + h * 128;
        float o = 0.f;
#pragma unroll
        for (int d = 0; d < 128; ++d) { S[d] = a[d] * S[d] + bf2f(k[d]) * v; o += bf2f(q[d]) * S[d]; }
        o *= 0.08838834764831845f;
        float ss = wave_sum(o * o);
        __syncthreads();
        if (lane == 0) red[w] = ss;
        __syncthreads();
        ss = red[0] + red[1] + red[2] + red[3];
        const float rstd = rsqrtf(ss * (1.f / 256.f) + EPS);
        OG[row * 1024 + h * 256 + e] = f2bf(o * rstd * hw * bf2f(SG[row * 1024 + h * 256 + e]));
    }
}
__global__ void __launch_bounds__(256) n_moe(const bf16* Xin, const float* nw, const float* wg, const float* we, const float* Wgate, const float* Wup, const float* Wdown,
                                             bf16* Xout, float* RSout, const float* final_w, float* out) {
    __shared__ float hs[1024], logit[36], act[256], red[4]; __shared__ int sel[2]; __shared__ float selw[2];
    const int t = blockIdx.x, tid = threadIdx.x, lane = tid & 63, w = tid >> 6;
    float xv[4]; float s = 0.f;
#pragma unroll
    for (int i = 0; i < 4; ++i) { xv[i] = bf2f(Xin[(size_t)t * D + tid + 256 * i]); s += xv[i] * xv[i]; }
    s = wave_sum(s); if (lane == 0) red[w] = s; __syncthreads();
    const float rstd = rsqrtf((red[0] + red[1] + red[2] + red[3]) * (1.f / D) + EPS);
#pragma unroll
    for (int i = 0; i < 4; ++i) hs[tid + 256 * i] = xv[i] * rstd * nw[tid + 256 * i];
    __syncthreads();
    for (int li = w * 9; li < w * 9 + 9; ++li) { float p = 0.f;
        for (int k = lane; k < D; k += 64) p += hs[k] * (li < 4 ? wg[k * 4 + li] : we[k * 32 + li - 4]);
        p = wave_sum(p); if (lane == 0) logit[li] = p; }
    __syncthreads();
    if (tid == 0) {
        int g = 0; float gm = logit[0];
        for (int i = 1; i < 4; ++i) if (logit[i] > gm) { gm = logit[i]; g = i; }
        float gs = 0.f; for (int i = 0; i < 4; ++i) gs += __expf(logit[i] - gm);
        const float pg = 1.f / gs;
        const float* el = logit + 4 + g * 8; int e0 = 0; float m0 = el[0];
        for (int i = 1; i < 8; ++i) if (el[i] > m0) { m0 = el[i]; e0 = i; }
        int e1 = -1; float m1 = -3.0e38f;
        for (int i = 0; i < 8; ++i) if (i != e0 && el[i] > m1) { m1 = el[i]; e1 = i; }
        const float p1 = __expf(m1 - m0), den = 1.f + p1;
        sel[0] = g * 8 + e0; sel[1] = g * 8 + e1; selw[0] = pg / den; selw[1] = pg * p1 / den;
    }
    __syncthreads();
    float oacc[4] = {0.f, 0.f, 0.f, 0.f};
    for (int kk = 0; kk < 2; ++kk) {
        const int e = sel[kk]; const float wt = selw[kk];
        const float* G = Wgate + (size_t)e * D * 256; const float* U = Wup + (size_t)e * D * 256; const float* Dn = Wdown + (size_t)e * 256 * D;
        float ga = 0.f, ua = 0.f;
        for (int k = 0; k < D; ++k) { const float hv = hs[k]; ga += hv * G[k * 256 + tid]; ua += hv * U[k * 256 + tid]; }
        __syncthreads();
        act[tid] = siluf_(ga) * ua;
        __syncthreads();
        float o4[4] = {0.f, 0.f, 0.f, 0.f};
        for (int f = 0; f < 256; ++f) { const float av = act[f];
#pragma unroll
            for (int i = 0; i < 4; ++i) o4[i] += av * Dn[(size_t)f * D + tid + 256 * i]; }
#pragma unroll
        for (int i = 0; i < 4; ++i) oacc[i] += wt * o4[i];
    }
    float s2 = 0.f;
#pragma unroll
    for (int i = 0; i < 4; ++i) { xv[i] += oacc[i]; s2 += xv[i] * xv[i]; }
    s2 = wave_sum(s2); __syncthreads(); if (lane == 0) red[w] = s2; __syncthreads();
    const float rstd2 = rsqrtf((red[0] + red[1] + red[2] + red[3]) * (1.f / D) + EPS);
    if (out) {
#pragma unroll
        for (int i = 0; i < 4; ++i) out[(size_t)t * D + tid + 256 * i] = xv[i] * rstd2 * final_w[tid + 256 * i];
    } else {
#pragma unroll
        for (int i = 0; i < 4; ++i) Xout[(size_t)t * D + tid + 256 * i] = f2bf(xv[i]);
        if (tid == 0) RSout[t] = rstd2;
    }
}
__global__ void __launch_bounds__(256) n_conv(const bf16* XBR, const float* cw, const float* cb, bf16* XC) {
    const size_t i = (size_t)blockIdx.x * 256 + threadIdx.x; const int c = (int)(i & 1023); const int row = (int)(i >> 10), s = row & (SEQ - 1);
    float v = cb[c];
#pragma unroll
    for (int tap = 0; tap < 4; ++tap) { const int ss = s - 3 + tap; if (ss >= 0) v += cw[tap * 1024 + c] * bf2f(XBR[(size_t)(row - 3 + tap) * D + c]); }
    XC[i] = f2bf(v);
}
__global__ void __launch_bounds__(256) n_lru_scan(const bf16* XC, const bf16* RG, const bf16* IG, const bf16* GATE, const float* lam, bf16* YL) {
    const int gi = blockIdx.x * 256 + threadIdx.x, b = gi >> 10, c = gi & 1023;
    const float sp = softplusf_(-lam[c]); float h = 0.f;
    for (int t = 0; t < SEQ; ++t) { const size_t i = ((size_t)b * SEQ + t) * D + c;
        const float la = -8.f * bf2f(RG[i]) * sp, a = __expf(la), mult = sqrtf(-expm1f(2.f * la));
        h = a * h + bf2f(XC[i]) * bf2f(IG[i]) * mult;
        YL[i] = f2bf(h * bf2f(GATE[i])); }
}

extern "C" void kernel_launch(void* const* d_in, const int* in_sizes, int n_in, void* d_out, int out_size, void* d_ws, size_t ws_size, hipStream_t stream) {
    if (n_in != 24 || out_size != T * D || ws_size < WS_END) { fprintf(stderr, "kernel_launch: unexpected shapes (n_in %d out %d ws %zu)\n", n_in, out_size, ws_size); return; }
    const float* const* in = (const float* const*)d_in; unsigned char* ws = (unsigned char*)d_ws;
    float *RS0 = (float*)(ws + WS_RS0), *RS2 = (float*)(ws + WS_RS2);
    float *EREF = (float*)(ws + WS_EREF), *ELAST = (float*)(ws + WS_ELAST), *ELR = (float*)(ws + WS_ELR);
    bf16 *S0 = (bf16*)(ws + WS_S0), *S1 = (bf16*)(ws + WS_S1), *S2 = (bf16*)(ws + WS_S2), *S3 = (bf16*)(ws + WS_S3), *S4 = (bf16*)(ws + WS_S4), *S5 = (bf16*)(ws + WS_S5);
    bf16 *XB = S0, *Q = S1, *Kb = S1 + (size_t)T * 512, *V = S2, *SG = S3, *EQ = S4, *EK = S4 + (size_t)T * 512;
    float* AF = (float*)S5; float* LR = (float*)(ws + 5 * MiB);
    n_prologue<<<T / 4, 256, 0, stream>>>(in[0], XB, RS0);
    n_gemm<<<dim3((3088 + 63) / 64, T / 64), 256, 0, stream>>>(XB, D, RS0, in[1], in[2], 3088, T, 3088, D, EpiGlaProj{Q, Kb, V, SG, LR});
    n_gla_prep<<<512 * 512 / 256, 256, 0, stream>>>(LR, in[3], in[4], EQ, EK, EREF, ELAST, ELR, AF);
    bf16* OG = S0;
    n_gla_core<<<32, 256, 0, stream>>>(Q, Kb, V, SG, AF, in[5], OG);
    bf16* X1 = S1;
    n_gemm<<<dim3(D / 64, T / 64), 256, 0, stream>>>(OG, D, nullptr, nullptr, in[6], D, T, D, D, EpiResid{in[0], nullptr, X1});
    bf16* X2 = S0;
    n_moe<<<T, 256, 0, stream>>>(X1, in[17], in[18], in[19], in[20], in[21], in[22], X2, RS2, nullptr, nullptr);
    bf16 *XBR = S1, *GATE = S2, *XC = S3, *RG = S4, *IG = S5;
    n_gemm<<<dim3(2048 / 64, T / 64), 256, 0, stream>>>(X2, D, RS2, in[7], in[8], 2048, T, 2048, D, EpiLruIn{XBR, GATE});
    n_conv<<<T * D / 256, 256, 0, stream>>>(XBR, in[9], in[10], XC);
    for (int n = 0; n < 4; ++n) {
        n_gemm<<<dim3(256 / 64, T / 64), 256, 0, stream>>>(XC + n * 256, D, nullptr, nullptr, in[11] + (size_t)n * 65536, 256, T, 256, 256, EpiGate{RG, in[12], n * 256});
        n_gemm<<<dim3(256 / 64, T / 64), 256, 0, stream>>>(XC + n * 256, D, nullptr, nullptr, in[13] + (size_t)n * 65536, 256, T, 256, 256, EpiGate{IG, in[14], n * 256});
    }
    bf16* YL = S1;
    n_lru_scan<<<NB * D / 256, 256, 0, stream>>>(XC, RG, IG, GATE, in[15], YL);
    bf16* X3 = S5;
    n_gemm<<<dim3(D / 64, T / 64), 256, 0, stream>>>(YL, D, nullptr, nullptr, in[16], D, T, D, D, EpiResid{nullptr, X2, X3});
    n_moe<<<T, 256, 0, stream>>>(X3, in[17] + D, in[18] + D * 4, in[19] + D * 32, in[20] + (size_t)32 * D * 256, in[21] + (size_t)32 * D * 256, in[22] + (size_t)32 * 256 * D,
                                 nullptr, nullptr, in[23], (float*)d_out);
}
```

```cpp
#include <hip/hip_runtime.h>
#include <cstdio>
#include <cstdint>

typedef unsigned short bf16;
constexpr int T = 32768, D = 1024, SEQ = 4096, NB = 8;
constexpr float EPS = 1e-6f;
constexpr size_t MiB = 1u << 20;
constexpr size_t WS_CTL = 0;
constexpr size_t WS_RS0 = 1 * MiB, WS_RS1 = WS_RS0 + 128 * 1024, WS_RS2 = WS_RS1 + 128 * 1024, WS_RS3 = WS_RS2 + 128 * 1024;
constexpr size_t WS_EREF = 2 * MiB, WS_ELAST = 3 * MiB, WS_ELR = 4 * MiB;
constexpr size_t WS_S0 = 128 * MiB, WS_S1 = 192 * MiB, WS_S2 = 256 * MiB, WS_S3 = 320 * MiB, WS_S4 = 384 * MiB, WS_S5 = 448 * MiB, WS_END = 512 * MiB;

__device__ __forceinline__ float bf2f(bf16 b) { return __uint_as_float(((unsigned)b) << 16); }
__device__ __forceinline__ bf16 f2bf(float f) { unsigned u = __float_as_uint(f); u += 0x7fffu + ((u >> 16) & 1u); return (bf16)(u >> 16); }
__device__ __forceinline__ float wave_sum(float v) {
#pragma unroll
    for (int o = 1; o < 64; o <<= 1) v += __shfl_xor(v, o);
    return v;
}
__device__ __forceinline__ float sigmoidf_(float x) { return 1.f / (1.f + __expf(-x)); }
__device__ __forceinline__ float siluf_(float x) { return x / (1.f + __expf(-x)); }
__device__ __forceinline__ float logsigmoidf_(float x) { return fminf(x, 0.f) - log1pf(__expf(-fabsf(x))); }
__device__ __forceinline__ float softplusf_(float x) { return fmaxf(x, 0.f) + log1pf(__expf(-fabsf(x))); }
__device__ __forceinline__ float gelu_tanhf_(float x) { const float u = 0.7978845608028654f * (x + 0.044715f * x * x * x); return 0.5f * x * (1.f + tanhf(u)); }

__global__ void __launch_bounds__(256) n_prologue(const float* x, bf16* XB, float* RS) {
    const int row = blockIdx.x * 4 + (threadIdx.x >> 6), lane = threadIdx.x & 63;
    const float* xr = x + (size_t)row * D; float s = 0.f;
    for (int i = lane; i < D; i += 64) { const float v = xr[i]; s += v * v; XB[(size_t)row * D + i] = f2bf(v); }
    s = wave_sum(s);
    if (lane == 0) RS[row] = rsqrtf(s * (1.f / D) + EPS);
}

template <class Epi>
__global__ void __launch_bounds__(256) n_gemm(const bf16* A, int lda, const float* rs, const float* nw, const float* W, int ldw, int M, int N, int K, Epi epi) {
    __shared__ float As[16][65], Ws[16][64];
    const int tid = threadIdx.x, tx = tid & 15, ty = tid >> 4, m0 = blockIdx.y * 64, n0 = blockIdx.x * 64;
    float acc[4][4];
#pragma unroll
    for (int i = 0; i < 4; ++i)
#pragma unroll
        for (int j = 0; j < 4; ++j) acc[i][j] = 0.f;
    for (int k0 = 0; k0 < K; k0 += 16) {
#pragma unroll
        for (int i = 0; i < 4; ++i) { const int idx = tid + 256 * i, r = idx >> 4, kk = idx & 15; As[kk][r] = bf2f(A[(size_t)(m0 + r) * lda + k0 + kk]) * (nw ? nw[k0 + kk] : 1.f); }
#pragma unroll
        for (int i = 0; i < 4; ++i) { const int idx = tid + 256 * i, kk = idx >> 6, n = idx & 63; Ws[kk][n] = (n0 + n < N) ? W[(size_t)(k0 + kk) * ldw + n0 + n] : 0.f; }
        __syncthreads();
#pragma unroll
        for (int kk = 0; kk < 16; ++kk) {
            float a[4], b[4];
#pragma unroll
            for (int i = 0; i < 4; ++i) a[i] = As[kk][ty * 4 + i];
#pragma unroll
            for (int j = 0; j < 4; ++j) b[j] = Ws[kk][tx + 16 * j];
#pragma unroll
            for (int i = 0; i < 4; ++i)
#pragma unroll
                for (int j = 0; j < 4; ++j) acc[i][j] += a[i] * b[j];
        }
        __syncthreads();
    }
#pragma unroll
    for (int i = 0; i < 4; ++i) { const int r = m0 + ty * 4 + i; const float sc = rs ? rs[r] : 1.f;
#pragma unroll
        for (int j = 0; j < 4; ++j) { const int c = n0 + tx + 16 * j; if (c < N) epi(r, c, acc[i][j] * sc); } }
}
struct EpiGlaProj { bf16 *Q, *Kb, *V, *SG; float* LR;
    __device__ void operator()(int r, int c, float v) const {
        if (c < 512) Q[(size_t)r * 512 + c] = f2bf(v);
        else if (c < 1024) Kb[(size_t)r * 512 + c - 512] = f2bf(v);
        else if (c < 2048) V[(size_t)r * 1024 + c - 1024] = f2bf(v);
        else if (c < 3072) SG[(size_t)r * 1024 + c - 2048] = f2bf(siluf_(v));
        else LR[(size_t)r * 16 + c - 3072] = v; } };
struct EpiResid { const float* xf; const bf16* xb; bf16* out;
    __device__ void operator()(int r, int c, float v) const { const size_t i = (size_t)r * D + c; out[i] = f2bf((xf ? xf[i] : bf2f(xb[i])) + v); } };
struct EpiLruIn { bf16 *XBR, *GATE;
    __device__ void operator()(int r, int c, float v) const { if (c < 1024) XBR[(size_t)r * D + c] = f2bf(v); else GATE[(size_t)r * D + c - 1024] = f2bf(gelu_tanhf_(v)); } };
struct EpiGate { bf16* O; const float* bias; int coff; int pad;
    __device__ void operator()(int r, int c, float v) const { O[(size_t)r * D + coff + c] = f2bf(sigmoidf_(v + bias[coff + c])); } };

__global__ void __launch_bounds__(256) n_gla_prep(const float* LR, const float* w_alpha, const float* b_alpha, bf16* EQ, bf16* EK, float* EREF, float* ELAST, float* ELR, float* AF) {
    const int gi = blockIdx.x * 256 + threadIdx.x, chunk = gi >> 9, col = gi & 511;
    float wa[16];
#pragma unroll
    for (int r = 0; r < 16; ++r) wa[r] = w_alpha[r * 512 + col];
    const float ba = b_alpha[col];
    float cum = 0.f, ref = 0.f;
    for (int i = 0; i < 64; ++i) { const float* lr = LR + (size_t)(chunk * 64 + i) * 16; float z = ba;
#pragma unroll
        for (int r = 0; r < 16; ++r) z += lr[r] * wa[r];
        const float la = logsigmoidf_(z) * (1.f / 16.f); cum += la; if (i == 32) ref = cum; AF[(size_t)(chunk * 64 + i) * 512 + col] = __expf(la); }
    const float last = cum;
    EREF[chunk * 512 + col] = __expf(ref); ELAST[chunk * 512 + col] = __expf(last); ELR[chunk * 512 + col] = __expf(last - ref);
    cum = 0.f;
    for (int i = 0; i < 64; ++i) { const float* lr = LR + (size_t)(chunk * 64 + i) * 16; float z = ba;
#pragma unroll
        for (int r = 0; r < 16; ++r) z += lr[r] * wa[r];
        cum += logsigmoidf_(z) * (1.f / 16.f);
        const size_t o = (size_t)(chunk * 64 + i) * 512 + col;
        EQ[o] = f2bf(0.08838834764831845f * __expf(cum - ref)); EK[o] = f2bf(__expf(ref - cum)); }
}
__global__ void __launch_bounds__(256) n_gla_core(const bf16* Q, const bf16* Kb, const bf16* V, const bf16* SG, const float* AF, const float* hn, bf16* OG) {
    __shared__ float red[4];
    const int bh = blockIdx.x, b = bh >> 2, h = bh & 3, e = threadIdx.x, lane = e & 63, w = e >> 6;
    float S[128];
#pragma unroll
    for (int d = 0; d < 128; ++d) S[d] = 0.f;
    const float hw = hn[e];
    for (int t = 0; t < SEQ; ++t) {
        const size_t row = (size_t)b * SEQ + t;
        const float v = bf2f(V[row * 1024 + h * 256 + e]);
        const float* a = AF + row * 512 + h * 128; const bf16* k = Kb + row * 512 + h * 128; const bf16* q = Q + row * 512 + h * 128;
        float o = 0.f;
#pragma unroll
        for (int d = 0; d < 128; ++d) { S[d] = a[d] * S[d] + bf2f(k[d]) * v; o += bf2f(q[d]) * S[d]; }
        o *= 0.08838834764831845f;
        float ss = wave_sum(o * o);
        __syncthreads();
        if (lane == 0) red[w] = ss;
        __syncthreads();
        ss = red[0] + red[1] + red[2] + red[3];
        const float rstd = rsqrtf(ss * (1.f / 256.f) + EPS);
        OG[row * 1024 + h * 256 + e] = f2bf(o * rstd * hw * bf2f(SG[row * 1024 + h * 256 + e]));
    }
}
__global__ void __launch_bounds__(256) n_moe(const bf16* Xin, const float* nw, const float* wg, const float* we, const float* Wgate, const float* Wup, const float* Wdown,
                                             bf16* Xout, float* RSout, const float* final_w, float* out) {
    __shared__ float hs[1024], logit[36], act[256], red[4]; __shared__ int sel[2]; __shared__ float selw[2];
    const int t = blockIdx.x, tid = threadIdx.x, lane = tid & 63, w = tid >> 6;
    float xv[4]; float s = 0.f;
#pragma unroll
    for (int i = 0; i < 4; ++i) { xv[i] = bf2f(Xin[(size_t)t * D + tid + 256 * i]); s += xv[i] * xv[i]; }
    s = wave_sum(s); if (lane == 0) red[w] = s; __syncthreads();
    const float rstd = rsqrtf((red[0] + red[1] + red[2] + red[3]) * (1.f / D) + EPS);
#pragma unroll
    for (int i = 0; i < 4; ++i) hs[tid + 256 * i] = xv[i] * rstd * nw[tid + 256 * i];
    __syncthreads();
    for (int li = w * 9; li < w * 9 + 9; ++li) { float p = 0.f;
        for (int k = lane; k < D; k += 64) p += hs[k] * (li < 4 ? wg[k * 4 + li] : we[k * 32 + li - 4]);
        p = wave_sum(p); if (lane == 0) logit[li] = p; }
    __syncthreads();
    if (tid == 0) {
        int g = 0; float gm = logit[0];
        for (int i = 1; i < 4; ++i) if (logit[i] > gm) { gm = logit[i]; g = i; }
        float gs = 0.f; for (int i = 0; i < 4; ++i) gs += __expf(logit[i] - gm);
        const float pg = 1.f / gs;
        const float* el = logit + 4 + g * 8; int e0 = 0; float m0 = el[0];
        for (int i = 1; i < 8; ++i) if (el[i] > m0) { m0 = el[i]; e0 = i; }
        int e1 = -1; float m1 = -3.0e38f;
        for (int i = 0; i < 8; ++i) if (i != e0 && el[i] > m1) { m1 = el[i]; e1 = i; }
        const float p1 = __expf(m1 - m0), den = 1.f + p1;
        sel[0] = g * 8 + e0; sel[1] = g * 8 + e1; selw[0] = pg / den; selw[1] = pg * p1 / den;
    }
    __syncthreads();
    float oacc[4] = {0.f, 0.f, 0.f, 0.f};
    for (int kk = 0; kk < 2; ++kk) {
        const int e = sel[kk]; const float wt = selw[kk];
        const float* G = Wgate + (size_t)e * D * 256; const float* U = Wup + (size_t)e * D * 256; const float* Dn = Wdown + (size_t)e * 256 * D;
        float ga = 0.f, ua = 0.f;
        for (int k = 0; k < D; ++k) { const float hv = hs[k]; ga += hv * G[k * 256 + tid]; ua += hv * U[k * 256 + tid]; }
        __syncthreads();
        act[tid] = siluf_(ga) * ua;
        __syncthreads();
        float o4[4] = {0.f, 0.f, 0.f, 0.f};
        for (int f = 0; f < 256; ++f) { const float av = act[f];
#pragma unroll
            for (int i = 0; i < 4; ++i) o4[i] += av * Dn[(size_t)f * D + tid + 256 * i]; }
#pragma unroll
        for (int i = 0; i < 4; ++i) oacc[i] += wt * o4[i];
    }
    float s2 = 0.f;
#pragma unroll
    for (int i = 0; i < 4; ++i) { xv[i] += oacc[i]; s2 += xv[i] * xv[i]; }
    s2 = wave_sum(s2); __syncthreads(); if (lane == 0) red[w] = s2; __syncthreads();
    const float rstd2 = rsqrtf((red[0] + red[1] + red[2] + red[3]) * (1.f / D) + EPS);
    if (out) {
#pragma unroll
        for (int i = 0; i < 4; ++i) out[(size_t)t * D + tid + 256 * i] = xv[i] * rstd2 * final_w[tid + 256 * i];
    } else {
#pragma unroll
        for (int i = 0; i < 4; ++i) Xout[(size_t)t * D + tid + 256 * i] = f2bf(xv[i]);
        if (tid == 0) RSout[t] = rstd2;
    }
}
__global__ void __launch_bounds__(256) n_conv(const bf16* XBR, const float* cw, const float* cb, bf16* XC) {
    const size_t i = (size_t)blockIdx.x * 256 + threadIdx.x; const int c = (int)(i & 1023); const int row = (int)(i >> 10), s = row & (SEQ - 1);
    float v = cb[c];
#pragma unroll
    for (int tap = 0; tap < 4; ++tap) { const int ss = s - 3 + tap; if (ss >= 0) v += cw[tap * 1024 + c] * bf2f(XBR[(size_t)(row - 3 + tap) * D + c]); }
    XC[i] = f2bf(v);
}
__global__ void __launch_bounds__(256) n_lru_scan(const bf16* XC, const bf16* RG, const bf16* IG, const bf16* GATE, const float* lam, bf16* YL) {
    const int gi = blockIdx.x * 256 + threadIdx.x, b = gi >> 10, c = gi & 1023;
    const float sp = softplusf_(-lam[c]); float h = 0.f;
    for (int t = 0; t < SEQ; ++t) { const size_t i = ((size_t)b * SEQ + t) * D + c;
        const float la = -8.f * bf2f(RG[i]) * sp, a = __expf(la), mult = sqrtf(-expm1f(2.f * la));
        h = a * h + bf2f(XC[i]) * bf2f(IG[i]) * mult;
        YL[i] = f2bf(h * bf2f(GATE[i])); }
}


#define LAS __attribute__((address_space(3)))
#define GAS __attribute__((address_space(1)))
typedef short bf16x8 __attribute__((ext_vector_type(8)));
typedef float f32x4 __attribute__((ext_vector_type(4)));
typedef float f32x2 __attribute__((ext_vector_type(2)));
typedef unsigned u32x4 __attribute__((ext_vector_type(4)));
typedef unsigned u32x2 __attribute__((ext_vector_type(2)));
typedef GAS unsigned gu32;
#define RLX_AGENT __ATOMIC_RELAXED, __HIP_MEMORY_SCOPE_AGENT
constexpr int NWAVES = 8, NTHR = 512;
constexpr int LDS_STAGE = 131072, LDS_MISC = LDS_STAGE, LDS_BYTES = 147456;
constexpr float QSCALE = 0.08838834764831845f;

constexpr size_t WS_SP = 1 * MiB + 512 * 1024;
constexpr size_t WS_WR = 14 * MiB;
constexpr size_t WS_W1 = 16 * MiB;
constexpr size_t WS_WO = WS_W1 + (size_t)3584 * 1024 * 2;
constexpr size_t WS_WLI = WS_WO + (size_t)1024 * 1024 * 2;
constexpr size_t WS_WLO = WS_WLI + (size_t)2048 * 1024 * 2;
constexpr size_t WS_WG = WS_WLO + (size_t)1024 * 1024 * 2;
constexpr size_t WS_WGU = WS_WG + (size_t)4 * 512 * 256 * 2;
constexpr size_t WS_WD = WS_WGU + (size_t)64 * 512 * 1024 * 2;
static_assert(WS_WD + (size_t)64 * 1024 * 256 * 2 <= WS_S0, "weights fit below the activation slots");
constexpr int CW_TMO = 0, CW_BAR = 4096;

__device__ __forceinline__ unsigned cvt_pk_bf16(float lo, float hi) { unsigned r; asm volatile("v_cvt_pk_bf16_f32 %0, %1, %2" : "=v"(r) : "v"(lo), "v"(hi)); return r; }
__device__ __forceinline__ float fexp(float x) { return __builtin_amdgcn_exp2f(x * 1.4426950408889634f); }
__device__ __forceinline__ float flog(float x) { return __builtin_amdgcn_logf(x) * 0.6931471805599453f; }
__device__ __forceinline__ float frcp(float x) { return __builtin_amdgcn_rcpf(x); }
__device__ __forceinline__ float fsilu(float x) { return x * frcp(1.f + fexp(-x)); }
__device__ __forceinline__ float fsigmoid(float x) { return frcp(1.f + fexp(-x)); }
__device__ __forceinline__ float flogsigmoid(float x) { return fminf(x, 0.f) - flog(1.f + fexp(-fabsf(x))); }
__device__ __forceinline__ float fgelu_tanh(float x) { const float u = 1.5957691216057308f * (x + 0.044715f * x * x * x); return x * frcp(1.f + fexp(-u)); }
__device__ __forceinline__ int lane_id_v() { int l; asm volatile("v_mbcnt_lo_u32_b32 %0, -1, 0\n\tv_mbcnt_hi_u32_b32 %0, -1, %0" : "=v"(l)); return l; }
template <int N> __device__ __forceinline__ float dpp_shr(float v) {
    return __builtin_bit_cast(float, __builtin_amdgcn_update_dpp(0, __builtin_bit_cast(int, v), 0x110 + N, 0xf, 0xf, true)); }

#define XB_TMO      128
#define XB_XCNT(j)  (256  + 64 * (j))
#define XB_XSUB(j)  (1280 + 64 * (j))
#define XB_XGEN(j)  (2304 + 64 * (j))
#define XB_TOP      3328
#define XB_TOPGEN   3392
#define XCD_BAR_WORDS 3456
#define XB_SPIN_CAP (1u << 18)
__device__ __forceinline__ unsigned xb_ld(unsigned* p)              { return __hip_atomic_load(p, __ATOMIC_RELAXED, __HIP_MEMORY_SCOPE_AGENT); }
__device__ __forceinline__ unsigned xb_add(unsigned* p, unsigned v) { return __hip_atomic_fetch_add(p, v, __ATOMIC_RELAXED, __HIP_MEMORY_SCOPE_AGENT); }
__device__ __forceinline__ unsigned xb_xcc_id() { return (unsigned)__builtin_amdgcn_s_getreg((3 << 11) | 20) & 0xFu; }
#define XB_SPIN(cond, bar) do { unsigned _sp = 0; while (cond) { __builtin_amdgcn_s_sleep(1); \
    if ((++_sp & 255u) == 0u) { if (xb_ld(&(bar)[XB_TMO])) break; if (_sp > XB_SPIN_CAP) { atomicAdd(&(bar)[XB_TMO], 1u); break; } } } } while (0)
struct XcdBarrier { unsigned* bar; unsigned x; volatile LAS unsigned* st; };
__device__ __forceinline__ XcdBarrier xcd_barrier_post(unsigned* bar, volatile LAS unsigned* st, bool t0) {
    XcdBarrier b; b.bar = bar; b.x = xb_xcc_id(); b.st = st;
    if (t0) (void)xb_add(&bar[XB_XCNT(b.x)], 1u);
    return b;
}
__device__ __forceinline__ void xcd_barrier_complete(unsigned* bar, unsigned x, unsigned& nloc, unsigned& nx) {
    const unsigned G = gridDim.x * gridDim.y * gridDim.z;
    unsigned sum, cnt, mine, sp = 0u;
    for (;;) {
        sum = 0u; cnt = 0u; mine = 0u;
#pragma unroll
        for (unsigned j = 0; j < 16; ++j) { const unsigned c = xb_ld(&bar[XB_XCNT(j)]); sum += c; cnt += (c > 0u) ? 1u : 0u; mine = (j == x) ? c : mine; }
        if (sum == G) break;
        __builtin_amdgcn_s_sleep(1);
        if ((++sp & 255u) == 0u) { if (xb_ld(&bar[XB_TMO])) break; if (sp > XB_SPIN_CAP) { atomicAdd(&bar[XB_TMO], 1u); break; } }
    }
    nloc = mine > 0u ? mine : 1u; nx = cnt > 0u ? cnt : 1u;
}
__device__ __forceinline__ void xcd_barrier(const XcdBarrier& b, int wave_) {
    asm volatile("s_waitcnt vmcnt(0)" ::: "memory");
    __syncthreads();
    if (wave_ == 0 && lane_id_v() == 0) {
        unsigned* bar = b.bar;
        __builtin_amdgcn_s_waitcnt(0);
        unsigned nloc = b.st[0], nx = b.st[1];
        if (nloc == 0u) { xcd_barrier_complete(bar, b.x, nloc, nx); b.st[0] = nloc; b.st[1] = nx; }
        const unsigned old = xb_add(&bar[XB_XSUB(b.x)], 1u);
        const unsigned gen = old / nloc;
        if (old + 1u == (gen + 1u) * nloc) {
            __builtin_amdgcn_fence(__ATOMIC_RELEASE, "agent");
            asm volatile("s_waitcnt vmcnt(0)" ::: "memory");
            const unsigned og = xb_add(&bar[XB_TOP], 1u);
            const unsigned tg = og / nx;
            if (og + 1u == (tg + 1u) * nx) xb_add(&bar[XB_TOPGEN], 1u);
            else XB_SPIN(xb_ld(&bar[XB_TOPGEN]) == tg, bar);
            __builtin_amdgcn_fence(__ATOMIC_ACQUIRE, "agent");
            xb_add(&bar[XB_XGEN(b.x)], 1u);
            asm volatile("s_waitcnt vmcnt(0)" ::: "memory");
        } else {
            XB_SPIN(xb_ld(&bar[XB_XGEN(b.x)]) == gen, bar);
            __builtin_amdgcn_fence(__ATOMIC_ACQUIRE, "agent");
            asm volatile("s_waitcnt vmcnt(0)" ::: "memory");
        }
    }
    __syncthreads();
}

namespace pg8 {
constexpr int BM = 256, BK = 64, HALF = 128, HTB = HALF * BK * 2, NXCD = 8, WGM = 8;
__device__ __forceinline__ int lds_byte(int r, int c) { const int st = (r >> 4) * 2 + (c >> 5), rr = r & 15, cc = c & 31, ob = rr * 64 + cc * 2; return st * 1024 + (ob ^ (((ob >> 9) & 1) << 5)); }
__device__ __forceinline__ void stage_rc(int b, int& R, int& C) { const int st = b / 1024, sb = b % 1024, swz = sb ^ (((sb >> 9) & 1) << 5); R = (st >> 1) * 16 + swz / 64; C = (st & 1) * 32 + (swz % 64) / 2; }
__device__ __forceinline__ int perm32(int rho) { const int n = rho >> 4, i = rho & 15; return 8 * (i >> 2) + 4 * n + (i & 3); }
__device__ __forceinline__ void tile_order(int L, int nM, int nN, int& pm, int& pn) {
    const int nwg = nM * nN; int wgid = L; { const int q = nwg / NXCD, r = nwg % NXCD, xcd = wgid % NXCD, off = wgid / NXCD; wgid = (xcd < r ? xcd * (q + 1) : r * (q + 1) + (xcd - r) * q) + off; }
    const int nig = WGM * nN, gid = wgid / nig, fm = gid * WGM, gsz = (nM - fm) < WGM ? (nM - fm) : WGM;
    pm = fm + ((wgid % nig) % gsz); pn = (wgid % nig) / gsz;
}
struct Unit { const char* a; const char* b; const int* rows; int pm, pn, e; };

template <class Epi, class Sched, bool GATHER>
__device__ __forceinline__ void gemm_phase(LAS unsigned char* lds, const int lda, const int ldb, const int K, const Sched& S, const Epi& E, const int wid) {
    const int lane = lane_id_v(), tid = wid * 64 + lane, wr = wid >> 2, wc = wid & 3, fr = lane & 15, fq = lane >> 4;
    int nt = K / BK; asm volatile("" : "+s"(nt));
    int Rr[2], Cc[2]; unsigned voffB[2];
#pragma unroll
    for (int i = 0; i < 2; ++i) { int R, C; stage_rc(tid * 16 + i * 8192, R, C); Rr[i] = R; Cc[i] = C; const int Rb = (R & ~31) + perm32(R & 31); voffB[i] = (unsigned)(Rb * ldb + C) * 2u; }
    const size_t kstep = (size_t)(BK * 2);
    const size_t hstepB = (size_t)HALF * ldb * 2;
    const unsigned ldsw = (unsigned)wid * 1024u;
    const int aoff = lds_byte(wr * 64 + fr, fq * 8), boff = lds_byte(wc * 32 + fr, fq * 8);
#define PG8_SA(b, h) (((b) * 2 + (h)) * HTB)
#define PG8_SB(b, h) ((4 + (b) * 2 + (h)) * HTB)
#define PG8_STAGE(bufoff, gbase, voff) do { _Pragma("unroll") for (int _i = 0; _i < 2; ++_i) \
        __builtin_amdgcn_global_load_lds((const unsigned*)((const char*)(gbase) + (voff)[_i]), (LAS unsigned*)(lds + (bufoff) + ldsw + _i * 8192), 16, 0, 0); } while (0)
#define PG8_LDA(dst, b, h) do { _Pragma("unroll") for (int m = 0; m < 4; ++m) _Pragma("unroll") for (int k = 0; k < 2; ++k) dst[m][k] = *(const LAS bf16x8*)(lds + PG8_SA(b, h) + aoff + m * 2048 + k * 1024); } while (0)
#define PG8_LDB(dst, b, h) do { _Pragma("unroll") for (int n = 0; n < 2; ++n) _Pragma("unroll") for (int k = 0; k < 2; ++k) dst[n][k] = *(const LAS bf16x8*)(lds + PG8_SB(b, h) + boff + n * 2048 + k * 1024); } while (0)
#define PG8_MMA(ai, bj, At, Bt) do { __builtin_amdgcn_s_setprio(1); _Pragma("unroll") for (int m = 0; m < 4; ++m) _Pragma("unroll") for (int n = 0; n < 2; ++n) _Pragma("unroll") for (int k = 0; k < 2; ++k) \
        acc[ai][bj][m][n] = __builtin_amdgcn_mfma_f32_16x16x32_bf16(Bt[n][k], At[m][k], acc[ai][bj][m][n], 0, 0, 0); __builtin_amdgcn_s_setprio(0); } while (0)
#define PG8_WAIT_V(n) asm volatile("s_waitcnt vmcnt(" #n ")" ::: "memory")
#define PG8_WAIT_L(n) asm volatile("s_waitcnt lgkmcnt(" #n ")" ::: "memory")
#define PG8_BAR __builtin_amdgcn_s_barrier()
#define PG8_SCHED __builtin_amdgcn_sched_barrier(0)
#define PG8_SETVOFF(v, u) do { _Pragma("unroll") for (int _h = 0; _h < 2; ++_h) _Pragma("unroll") for (int _i = 0; _i < 2; ++_i) { \
        if (GATHER) { unsigned _tk = (unsigned)(u).rows[_h * HALF + Rr[_i]]; _tk = _tk < (unsigned)T ? _tk : 0u; (v)[_h][_i] = (_tk * (unsigned)lda + (unsigned)Cc[_i]) * 2u; } else (v)[_h][_i] = (unsigned)(((_h * HALF + Rr[_i]) * lda + Cc[_i]) * 2); } } while (0)
    Unit cur, nxt; int ui = 0;
    if (!S.next(0, cur)) return;
    f32x4 acc[2][2][4][2];
#pragma unroll
    for (int a = 0; a < 2; ++a)
#pragma unroll
        for (int b = 0; b < 2; ++b)
#pragma unroll
            for (int m = 0; m < 4; ++m)
#pragma unroll
                for (int n = 0; n < 2; ++n) acc[a][b][m][n] = (f32x4){0.f, 0.f, 0.f, 0.f};
    bf16x8 At[4][2], B0[2][2], B1[2][2];
    unsigned vA[2][2], vN[2][2];
    PG8_SETVOFF(vA, cur);
    if (GATHER) asm volatile("" :: "v"(vA[0][0]), "v"(vA[0][1]), "v"(vA[1][0]), "v"(vA[1][1]));
    const char* cA = cur.a; const char* cB = cur.b;
    PG8_STAGE(PG8_SB(0, 0), cB, voffB); PG8_STAGE(PG8_SB(0, 1), cB + hstepB, voffB); PG8_STAGE(PG8_SA(0, 0), cA, vA[0]); PG8_STAGE(PG8_SA(0, 1), cA, vA[1]);
    if (wr == 1) PG8_BAR;
    PG8_WAIT_V(2); PG8_BAR;
    PG8_STAGE(PG8_SB(1, 0), cB + kstep, voffB); PG8_STAGE(PG8_SA(1, 0), cA + kstep, vA[0]); PG8_STAGE(PG8_SB(1, 1), cB + hstepB + kstep, voffB);
    PG8_WAIT_V(6); PG8_BAR;
    for (;;) {
        const bool has_next = S.next(ui + 1, nxt);
        const char* nA = has_next ? nxt.a : cA; const char* nB = has_next ? nxt.b : cB;
        if (GATHER) {
            if (has_next) { PG8_SETVOFF(vN, nxt); } else {
#pragma unroll
                for (int h = 0; h < 2; ++h)
#pragma unroll
                    for (int i = 0; i < 2; ++i) vN[h][i] = vA[h][i]; }
            asm volatile("" :: "v"(vN[0][0]), "v"(vN[0][1]), "v"(vN[1][0]), "v"(vN[1][1]));
        }
#pragma nounroll
        for (int t = 0; t < nt; t += 2) {
            const bool last = (t == nt - 2);
            const char* a1 = cA + (size_t)(t + 1) * kstep;
            const char* a2 = last ? nA : cA + (size_t)(t + 2) * kstep; const char* b2 = last ? nB : cB + (size_t)(t + 2) * kstep;
            const char* a3 = a2 + kstep; const char* b3 = b2 + kstep;
            PG8_LDB(B0, 0, 0); PG8_LDB(B1, 0, 1); PG8_SCHED; PG8_LDA(At, 0, 0); PG8_STAGE(PG8_SA(1, 1), a1, vA[1]);
            if (GATHER && last) {
#pragma unroll
                for (int h = 0; h < 2; ++h)
#pragma unroll
                    for (int i = 0; i < 2; ++i) vA[h][i] = vN[h][i]; }
            PG8_WAIT_V(8); PG8_WAIT_L(0); PG8_BAR; PG8_MMA(0, 0, At, B0); PG8_MMA(0, 1, At, B1); PG8_BAR; PG8_SCHED;
            PG8_LDA(At, 0, 1); PG8_STAGE(PG8_SB(0, 0), b2, voffB); PG8_STAGE(PG8_SB(0, 1), b2 + hstepB, voffB); PG8_STAGE(PG8_SA(0, 0), a2, vA[0]);
            PG8_WAIT_V(8); PG8_WAIT_L(0); PG8_BAR; PG8_MMA(1, 0, At, B0); PG8_MMA(1, 1, At, B1); PG8_BAR; PG8_SCHED;
            PG8_LDB(B0, 1, 0); PG8_LDB(B1, 1, 1); PG8_SCHED; PG8_LDA(At, 1, 0); PG8_STAGE(PG8_SA(0, 1), a2, vA[1]);
            PG8_WAIT_V(8); PG8_WAIT_L(0); PG8_BAR; PG8_MMA(0, 0, At, B0); PG8_MMA(0, 1, At, B1); PG8_BAR; PG8_SCHED;
            PG8_LDA(At, 1, 1); PG8_STAGE(PG8_SB(1, 0), b3, voffB); PG8_STAGE(PG8_SB(1, 1), b3 + hstepB, voffB); PG8_STAGE(PG8_SA(1, 0), a3, vA[0]);
            PG8_WAIT_V(8); PG8_WAIT_L(0); PG8_BAR; PG8_MMA(1, 0, At, B0); PG8_MMA(1, 1, At, B1); PG8_BAR; PG8_SCHED;
        }
        if (wr == 0) PG8_BAR;
        E(acc, cur, wr, wc, fr, fq, lane);
        if (!has_next) break;
#pragma unroll
        for (int a = 0; a < 2; ++a)
#pragma unroll
            for (int b = 0; b < 2; ++b)
#pragma unroll
                for (int m = 0; m < 4; ++m)
#pragma unroll
                    for (int n = 0; n < 2; ++n) acc[a][b][m][n] = (f32x4){0.f, 0.f, 0.f, 0.f};
        cur = nxt; cA = nA; cB = nB; ++ui;
        if (wr == 1) PG8_BAR;
    }
    PG8_WAIT_V(0);
    PG8_BAR;
#undef PG8_SA
#undef PG8_SB
#undef PG8_STAGE
#undef PG8_LDA
#undef PG8_LDB
#undef PG8_MMA
#undef PG8_WAIT_V
#undef PG8_WAIT_L
#undef PG8_BAR
#undef PG8_SCHED
#undef PG8_SETVOFF
}
struct SchedDense {
    int nM, nN, G, c; const char* A; const char* B; size_t a_tile, b_tile; int pn_div; size_t a_pn_step;
    __device__ __forceinline__ bool next(int i, Unit& u) const {
        const long L = (long)i * G + c; if (L >= (long)nM * nN) return false;
        int pm, pn; tile_order((int)L, nM, nN, pm, pn);
        u.pm = pm; u.pn = pn; u.e = 0; u.rows = nullptr; u.a = A + (size_t)pm * a_tile + (size_t)(pn / pn_div) * a_pn_step; u.b = B + (size_t)pn * b_tile; return true;
    }
};
}

__device__ __forceinline__ void unpack8(const u32x4 p, f32x4& r0, f32x4& r1) {
    r0 = (f32x4){__uint_as_float(p.x << 16), __uint_as_float(p.x & 0xffff0000u), __uint_as_float(p.y << 16), __uint_as_float(p.y & 0xffff0000u)};
    r1 = (f32x4){__uint_as_float(p.z << 16), __uint_as_float(p.z & 0xffff0000u), __uint_as_float(p.w << 16), __uint_as_float(p.w & 0xffff0000u)}; }
__device__ __forceinline__ u32x4 pack8(const f32x4 v0, const f32x4 v1) { u32x4 w; w.x = cvt_pk_bf16(v0[0], v0[1]); w.y = cvt_pk_bf16(v0[2], v0[3]); w.z = cvt_pk_bf16(v1[0], v1[1]); w.w = cvt_pk_bf16(v1[2], v1[3]); return w; }

struct EpiG1 {
    bf16 *Q, *Kb, *V, *SG, *EQ, *EK; float *EREF, *ELAST, *ELR, *AF; const float* RS; const float* b_alpha;
    __device__ __forceinline__ void operator()(f32x4 (&acc)[2][2][4][2], const pg8::Unit& u, int wr, int wc, int fr, int fq, int lane) const {
        const int row0 = u.pm * 256 + wr * 64 + fr, pn = u.pn;
        if (pn < 12) {
            bf16* base; int ldc, colt; const bool act = pn >= 8;
            if (pn < 2) { base = Q; ldc = 512; colt = pn * 256; } else if (pn < 4) { base = Kb; ldc = 512; colt = (pn - 2) * 256; }
            else if (pn < 8) { base = V; ldc = 1024; colt = (pn - 4) * 256; } else { base = SG; ldc = 1024; colt = (pn - 8) * 256; }
            const int col0 = colt + wc * 32 + 8 * fq;
#pragma unroll
            for (int ai = 0; ai < 2; ++ai)
#pragma unroll
                for (int m = 0; m < 4; ++m) { const int row = row0 + ai * 128 + m * 16; const float rs = RS[row]; bf16* rowp = base + (size_t)row * ldc + col0;
#pragma unroll
                    for (int bj = 0; bj < 2; ++bj) { f32x4 v0 = acc[ai][bj][m][0] * rs, v1 = acc[ai][bj][m][1] * rs;
                        if (act) {
#pragma unroll
                            for (int j = 0; j < 4; ++j) { v0[j] = fsilu(v0[j]); v1[j] = fsilu(v1[j]); } }
                        u32x4 w; w.x = cvt_pk_bf16(v0[0], v0[1]); w.y = cvt_pk_bf16(v0[2], v0[3]); w.z = cvt_pk_bf16(v1[0], v1[1]); w.w = cvt_pk_bf16(v1[2], v1[3]);
                        *(u32x4*)(rowp + bj * 128) = w; } }
        } else {
            const int colt = (pn - 12) * 256;
#pragma unroll
            for (int ai = 0; ai < 2; ++ai) {
                const int chunk = u.pm * 4 + ai * 2 + wr; float rsv[4];
#pragma unroll
                for (int m = 0; m < 4; ++m) rsv[m] = RS[row0 + ai * 128 + m * 16];
#pragma unroll
                for (int bj = 0; bj < 2; ++bj)
#pragma unroll
                    for (int n = 0; n < 2; ++n) {
                        const int c = colt + bj * 128 + wc * 32 + 8 * fq + 4 * n;
                        const f32x4 ba = *(const f32x4*)(b_alpha + c);
                        f32x4 cum[4]; f32x4 run = (f32x4){0.f, 0.f, 0.f, 0.f};
#pragma unroll
                        for (int m = 0; m < 4; ++m) { const f32x4 z = acc[ai][bj][m][n] * rsv[m] + ba; f32x4 la;
#pragma unroll
                            for (int j = 0; j < 4; ++j) la[j] = flogsigmoid(z[j]) * 0.0625f;
                            if (AF) { f32x4 ea;
#pragma unroll
                                for (int j = 0; j < 4; ++j) ea[j] = fexp(la[j]);
                                *(f32x4*)(AF + (size_t)(row0 + ai * 128 + m * 16) * 512 + c) = ea; }
                            f32x4 tot;
#pragma unroll
                            for (int j = 0; j < 4; ++j) { float v = la[j]; v += dpp_shr<1>(v); v += dpp_shr<2>(v); v += dpp_shr<4>(v); v += dpp_shr<8>(v); la[j] = v; tot[j] = __shfl(v, lane | 15); }
                            cum[m] = la + run; run += tot; }
                        f32x4 ref;
#pragma unroll
                        for (int j = 0; j < 4; ++j) ref[j] = __shfl(cum[2][j], lane & 48);
#pragma unroll
                        for (int m = 0; m < 4; ++m) { const size_t o = (size_t)(row0 + ai * 128 + m * 16) * 512 + c; float q[4], k[4];
#pragma unroll
                            for (int j = 0; j < 4; ++j) { q[j] = QSCALE * fexp(cum[m][j] - ref[j]); k[j] = fexp(ref[j] - cum[m][j]); }
                            u32x2 wq, wk; wq.x = cvt_pk_bf16(q[0], q[1]); wq.y = cvt_pk_bf16(q[2], q[3]); wk.x = cvt_pk_bf16(k[0], k[1]); wk.y = cvt_pk_bf16(k[2], k[3]);
                            *(u32x2*)(EQ + o) = wq; *(u32x2*)(EK + o) = wk; }
                        if (fr == 0) { f32x4 er, el, elr;
#pragma unroll
                            for (int j = 0; j < 4; ++j) { er[j] = fexp(ref[j]); el[j] = fexp(run[j]); elr[j] = fexp(run[j] - ref[j]); }
                            *(f32x4*)(EREF + chunk * 512 + c) = er; *(f32x4*)(ELAST + chunk * 512 + c) = el; *(f32x4*)(ELR + chunk * 512 + c) = elr; }
                    }
            }
        }
    }
};
__device__ __forceinline__ unsigned opaque_u0(unsigned v) { asm volatile("" : "+v"(v)); return v; }
struct EpiResidF {
    const float* xf; const bf16* xb; bf16* out;
    __device__ __forceinline__ void operator()(f32x4 (&acc)[2][2][4][2], const pg8::Unit& u, int wr, int wc, int fr, int fq, int lane) const {
        const size_t uo = (size_t)u.pm * 256 * 1024 + u.pn * 256;
        const char* xfb = (const char*)(xf + uo); const char* xbb = (const char*)(xb + uo); char* ob = (char*)(out + uo);
        const unsigned lo = opaque_u0((unsigned)((wr * 64 + fr) * 1024 + wc * 32 + 8 * fq) * 2u);
#pragma unroll
        for (int ai = 0; ai < 2; ++ai)
#pragma unroll
            for (int m = 0; m < 4; ++m)
#pragma unroll
                for (int bj = 0; bj < 2; ++bj) { const unsigned o = lo + (unsigned)((ai * 128 + m * 16) * 1024 + bj * 128) * 2u; f32x4 r0, r1;
                    if (xf) { r0 = *(const f32x4*)(xfb + 2u * o); r1 = *(const f32x4*)(xfb + (2u * o + 16u)); }
                    else unpack8(*(const u32x4*)(xbb + o), r0, r1);
                    *(u32x4*)(ob + o) = pack8(acc[ai][bj][m][0] + r0, acc[ai][bj][m][1] + r1); }
    }
};

__device__ __forceinline__ void cvt_item(const float* W, int ldn, int scol0, const float* kscale, bf16* dst, int dstK, int drow0, int kb, int nb, LAS float* scr, int lane) {
    const int k0 = 64 * kb, n0 = 32 * nb;
#pragma unroll 8
    for (int i = 0; i < 32; ++i) { const int kk = 2 * i + (lane >> 5); float v = W[(size_t)(k0 + kk) * ldn + scol0 + n0 + (lane & 31)]; if (kscale) v *= kscale[k0 + kk]; scr[kk * 33 + (lane & 31)] = v; }
    asm volatile("s_waitcnt lgkmcnt(0)" ::: "memory");
    const int c = lane & 7;
#pragma unroll
    for (int j = 0; j < 4; ++j) { const int n = (lane >> 3) + 8 * j; const LAS float* s = scr + (8 * c) * 33 + n;
        u32x4 o; o.x = cvt_pk_bf16(s[0 * 33], s[1 * 33]); o.y = cvt_pk_bf16(s[2 * 33], s[3 * 33]); o.z = cvt_pk_bf16(s[4 * 33], s[5 * 33]); o.w = cvt_pk_bf16(s[6 * 33], s[7 * 33]);
        *(u32x4*)(dst + (size_t)(drow0 + n0 + n) * dstK + k0 + 8 * c) = o; }
    asm volatile("s_waitcnt lgkmcnt(0)" ::: "memory");
}
__device__ __forceinline__ void cvt_item_la(const float* Win, const float* wal, const float* kscale, bf16* dst, int kb, int nb, LAS float* scr, int lane) {
    const int k0 = 64 * kb, n0 = 32 * nb; float wa[16];
#pragma unroll
    for (int r = 0; r < 16; ++r) wa[r] = wal[r * 512 + n0 + (lane & 31)];
#pragma unroll 4
    for (int i = 0; i < 32; ++i) { const int kk = 2 * i + (lane >> 5); const float* lr = Win + (size_t)(k0 + kk) * 3088 + 3072; float v = 0.f;
#pragma unroll
        for (int r = 0; r < 16; ++r) v += lr[r] * wa[r];
        scr[kk * 33 + (lane & 31)] = v * kscale[k0 + kk]; }
    asm volatile("s_waitcnt lgkmcnt(0)" ::: "memory");
    const int c = lane & 7;
#pragma unroll
    for (int j = 0; j < 4; ++j) { const int n = (lane >> 3) + 8 * j; const LAS float* s = scr + (8 * c) * 33 + n;
        u32x4 o; o.x = cvt_pk_bf16(s[0 * 33], s[1 * 33]); o.y = cvt_pk_bf16(s[2 * 33], s[3 * 33]); o.z = cvt_pk_bf16(s[4 * 33], s[5 * 33]); o.w = cvt_pk_bf16(s[6 * 33], s[7 * 33]);
        *(u32x4*)(dst + (size_t)(3072 + n0 + n) * 1024 + k0 + 8 * c) = o; }
    asm volatile("s_waitcnt lgkmcnt(0)" ::: "memory");
}


constexpr int CAP = 32768;
constexpr size_t WS_LIST = 5 * MiB, WS_LW = 9 * MiB, WS_POS = 13 * MiB;
constexpr size_t WS_AGG = 13 * MiB + 512 * 1024;
constexpr size_t WS_CARRY = 5 * MiB;
constexpr int CW_CNT = 16384;
constexpr int TS_OFF = 256;

namespace pg8 {
struct SchedMoe {
    const LAS int* ts; int G, c, npn; const char* A; const char* B; const int* LIST; size_t b_exp, b_pn, a_tile; bool gather;
    __device__ __forceinline__ bool next(int i, Unit& u) const {
        const int NT = __builtin_amdgcn_readfirstlane(ts[32]); const long L = (long)i * G + c; if (L >= (long)NT * npn) return false;
        const int tg = (int)(L / npn), pn = (int)(L % npn);
        const int e = __builtin_amdgcn_readfirstlane(ts[64 + tg]);
        const int tile = tg - __builtin_amdgcn_readfirstlane(ts[e]);
        u.pm = tg; u.pn = pn; u.e = e; u.rows = LIST + (size_t)e * CAP + tile * 256; u.a = gather ? A : A + (size_t)tg * a_tile; u.b = B + (size_t)e * b_exp + (size_t)pn * b_pn; return true;
    }
};
}
__device__ __forceinline__ unsigned opaque_u(unsigned v) { asm volatile("" : "+v"(v)); return v; }
struct EpiM1 {
    bf16* ACT; const int* LIST; const float* LW; const float* RS;
    __device__ __forceinline__ void operator()(f32x4 (&acc)[2][2][4][2], const pg8::Unit& u, int wr, int wc, int fr, int fq, int lane) const {
        const char* rowsb = (const char*)u.rows; const char* lwb = (const char*)(LW + (u.rows - LIST)); const char* rsb = (const char*)RS;
        char* ob = (char*)(ACT + (size_t)u.pm * 256 * 256 + u.pn * 128);
        const unsigned r4 = opaque_u((unsigned)(wr * 64 + fr) * 4u), lo = opaque_u((unsigned)((wr * 64 + fr) * 256 + wc * 32 + 8 * fq) * 2u);
#pragma unroll
        for (int ai = 0; ai < 2; ++ai)
#pragma unroll
            for (int m = 0; m < 4; ++m) { const unsigned ro = r4 + (unsigned)(ai * 128 + m * 16) * 4u;
                unsigned tk = *(const unsigned*)(rowsb + ro); tk = tk < (unsigned)T ? tk : 0u;
                const float rs = *(const float*)(rsb + tk * 4u), w = *(const float*)(lwb + ro); f32x4 o[2];
#pragma unroll
                for (int n = 0; n < 2; ++n) { const f32x4 g = acc[ai][0][m][n] * rs, up = acc[ai][1][m][n] * rs;
#pragma unroll
                    for (int j = 0; j < 4; ++j) o[n][j] = fsilu(g[j]) * up[j] * w; }
                *(u32x4*)(ob + (lo + (unsigned)(ai * 128 + m * 16) * 512u)) = pack8(o[0], o[1]); }
    }
};
struct EpiStore {
    bf16* O; int ldc; int pad;
    __device__ __forceinline__ void operator()(f32x4 (&acc)[2][2][4][2], const pg8::Unit& u, int wr, int wc, int fr, int fq, int lane) const {
        char* ob = (char*)(O + (size_t)u.pm * 256 * 1024 + u.pn * 256);
        const unsigned lo = opaque_u((unsigned)((wr * 64 + fr) * 1024 + wc * 32 + 8 * fq) * 2u);
#pragma unroll
        for (int ai = 0; ai < 2; ++ai)
#pragma unroll
            for (int m = 0; m < 4; ++m)
#pragma unroll
                for (int bj = 0; bj < 2; ++bj) *(u32x4*)(ob + (lo + (unsigned)((ai * 128 + m * 16) * 1024 + bj * 128) * 2u)) = pack8(acc[ai][bj][m][0], acc[ai][bj][m][1]);
    }
};
struct EpiL1 {
    bf16 *XBR, *GATE; const float* RS;
    __device__ __forceinline__ void operator()(f32x4 (&acc)[2][2][4][2], const pg8::Unit& u, int wr, int wc, int fr, int fq, int lane) const {
        const bool act = u.pn >= 4; char* ob = (char*)((act ? GATE : XBR) + (size_t)u.pm * 256 * 1024 + (u.pn & 3) * 256); const char* rsb = (const char*)(RS + u.pm * 256);
        const unsigned r4 = opaque_u((unsigned)(wr * 64 + fr) * 4u), lo = opaque_u((unsigned)((wr * 64 + fr) * 1024 + wc * 32 + 8 * fq) * 2u);
#pragma unroll
        for (int ai = 0; ai < 2; ++ai)
#pragma unroll
            for (int m = 0; m < 4; ++m) { const float rs = *(const float*)(rsb + (r4 + (unsigned)(ai * 128 + m * 16) * 4u));
#pragma unroll
                for (int bj = 0; bj < 2; ++bj) { f32x4 v0 = acc[ai][bj][m][0] * rs, v1 = acc[ai][bj][m][1] * rs;
                    if (act) {
#pragma unroll
                        for (int j = 0; j < 4; ++j) { v0[j] = fgelu_tanh(v0[j]); v1[j] = fgelu_tanh(v1[j]); } }
                    *(u32x4*)(ob + (lo + (unsigned)((ai * 128 + m * 16) * 1024 + bj * 128) * 2u)) = pack8(v0, v1); } }
    }
};
struct EpiL2 {
    const bf16* XC; bf16 *LOGA, *XN; const float *br, *bi, *SP;
    __device__ __forceinline__ void operator()(f32x4 (&acc)[2][2][4][2], const pg8::Unit& u, int wr, int wc, int fr, int fq, int lane) const {
        const int cu = (u.pn >> 1) * 256 + (u.pn & 1) * 128; const size_t uo = (size_t)u.pm * 256 * 1024 + cu;
        const char* xcb = (const char*)(XC + uo); char* lab = (char*)(LOGA + uo); char* xnb = (char*)(XN + uo);
        const unsigned cl = opaque_u((unsigned)(wc * 32 + 8 * fq) * 4u), lo = opaque_u((unsigned)((wr * 64 + fr) * 1024 + wc * 32 + 8 * fq) * 2u);
        f32x4 vbr[2], vbi[2], vsp[2];
#pragma unroll
        for (int n = 0; n < 2; ++n) { vbr[n] = *(const f32x4*)((const char*)(br + cu) + (cl + 16u * n)); vbi[n] = *(const f32x4*)((const char*)(bi + cu) + (cl + 16u * n)); vsp[n] = *(const f32x4*)((const char*)(SP + cu) + (cl + 16u * n)); }
#pragma unroll
        for (int ai = 0; ai < 2; ++ai)
#pragma unroll
            for (int m = 0; m < 4; ++m) { const unsigned o = lo + (unsigned)((ai * 128 + m * 16) * 1024) * 2u;
                f32x4 xc[2]; unpack8(*(const u32x4*)(xcb + o), xc[0], xc[1]); f32x4 la[2], xn[2];
#pragma unroll
                for (int n = 0; n < 2; ++n)
#pragma unroll
                    for (int j = 0; j < 4; ++j) { const float r = fsigmoid(acc[ai][0][m][n][j] + vbr[n][j]), ig = fsigmoid(acc[ai][1][m][n][j] + vbi[n][j]);
                        const float l = -8.f * r * vsp[n][j]; la[n][j] = l; xn[n][j] = xc[n][j] * ig * sqrtf(fmaxf(1.f - fexp(2.f * l), 0.f)); }
                *(u32x4*)(lab + o) = pack8(la[0], la[1]); *(u32x4*)(xnb + o) = pack8(xn[0], xn[1]); }
    }
};

__device__ __forceinline__ void build_ts(unsigned* CNT, LAS int* ts, int tid) {
    __syncthreads();
    if (tid < 32) ts[400 + tid] = (int)((xb_ld(CNT + tid) + 255u) >> 8);
    __syncthreads();
    if (tid == 0) { int a = 0; for (int e = 0; e < 32; ++e) { ts[e] = a; a += ts[400 + e]; } ts[32] = a; }
    __syncthreads();
    if (tid < 32) { const int b = ts[tid], n = ts[tid + 1] - b; for (int k = 0; k < n; ++k) ts[64 + b + k] = tid; }
    __syncthreads();
}
__device__ __forceinline__ void router_phase(LAS unsigned char* lds, const bf16* X, const bf16* WRl, float* RS, unsigned* CNT, int* LIST, float* LW, int* POS, int bx, int G, int tid, int lane, int wave) {
    LAS float* lg = (LAS float*)lds + wave * (16 * 48);
    LAS float* rsl = (LAS float*)(lds + 24576) + wave * 16;
    LAS unsigned* cnt_l = (LAS unsigned*)(lds + 25600); LAS unsigned* base_l = cnt_l + 32;
    const int fr = lane & 15, fq = lane >> 4;
    for (int grp = bx; grp < T / 128; grp += G) {
        if (tid < 32) cnt_l[tid] = 0u;
        __syncthreads();
        const int t0 = grp * 128 + wave * 16;
        f32x4 a0 = (f32x4){0.f, 0.f, 0.f, 0.f}, a1 = a0, a2 = a0; float ss = 0.f;
        const bf16* xa = X + (size_t)(t0 + fr) * D + 8 * fq; const bf16* wb = WRl + (size_t)fr * D + 8 * fq;
#pragma unroll 4
        for (int s = 0; s < 32; ++s) {
            const bf16x8 a = *(const bf16x8*)(xa + 32 * s), b0 = *(const bf16x8*)(wb + 32 * s), b1 = *(const bf16x8*)(wb + 16 * D + 32 * s), b2 = *(const bf16x8*)(wb + 32 * D + 32 * s);
#pragma unroll
            for (int j = 0; j < 8; ++j) { const float v = bf2f((bf16)a[j]); ss += v * v; }
            a0 = __builtin_amdgcn_mfma_f32_16x16x32_bf16(a, b0, a0, 0, 0, 0); a1 = __builtin_amdgcn_mfma_f32_16x16x32_bf16(a, b1, a1, 0, 0, 0); a2 = __builtin_amdgcn_mfma_f32_16x16x32_bf16(a, b2, a2, 0, 0, 0);
        }
        ss += __shfl_xor(ss, 16); ss += __shfl_xor(ss, 32);
        const float rstd = rsqrtf(ss * (1.f / D) + EPS);
        if (fq == 0) { rsl[fr] = rstd; RS[t0 + fr] = rstd; }
#pragma unroll
        for (int r = 0; r < 4; ++r) { lg[(4 * fq + r) * 48 + fr] = a0[r]; lg[(4 * fq + r) * 48 + 16 + fr] = a1[r]; lg[(4 * fq + r) * 48 + 32 + fr] = a2[r]; }
        asm volatile("s_waitcnt lgkmcnt(0)" ::: "memory");
        int e0g = 0, e1g = 0; float w0 = 0.f, w1 = 0.f; unsigned rk0 = 0u, rk1 = 0u;
        if (lane < 16) {
            const LAS float* l = lg + lane * 48; const float rs = rsl[lane];
            int g = 0; float gm = l[0] * rs;
            for (int i = 1; i < 4; ++i) { const float v = l[i] * rs; if (v > gm) { gm = v; g = i; } }
            float gs = 0.f; for (int i = 0; i < 4; ++i) gs += fexp(l[i] * rs - gm);
            const float pg = 1.f / gs;
            const LAS float* el = l + 4 + g * 8; int e0 = 0; float m0 = el[0] * rs;
            for (int i = 1; i < 8; ++i) { const float v = el[i] * rs; if (v > m0) { m0 = v; e0 = i; } }
            int e1 = 0; float m1 = -3.0e38f;
            for (int i = 0; i < 8; ++i) { const float v = el[i] * rs; if (i != e0 && v > m1) { m1 = v; e1 = i; } }
            const float p1 = fexp(m1 - m0), den = 1.f / (1.f + p1);
            e0g = g * 8 + e0; e1g = g * 8 + e1; w0 = pg * den; w1 = pg * p1 * den;
            rk0 = __hip_atomic_fetch_add(cnt_l + e0g, 1u, __ATOMIC_RELAXED, __HIP_MEMORY_SCOPE_WORKGROUP);
            rk1 = __hip_atomic_fetch_add(cnt_l + e1g, 1u, __ATOMIC_RELAXED, __HIP_MEMORY_SCOPE_WORKGROUP);
        }
        __syncthreads();
        if (tid < 32) base_l[tid] = xb_add(CNT + tid, cnt_l[tid]);
        __syncthreads();
        if (lane < 16) { const int tok = t0 + lane; const int s0 = e0g * CAP + (int)(base_l[e0g] + rk0), s1 = e1g * CAP + (int)(base_l[e1g] + rk1);
            LIST[s0] = tok; LW[s0] = w0; LIST[s1] = tok; LW[s1] = w1; POS[2 * tok] = s0; POS[2 * tok + 1] = s1; }
        __syncthreads();
    }
}
__device__ __forceinline__ void combine_phase(const LAS int* ts, const bf16* X, const bf16* Y, const int* POS, bf16* Xn, float* RSn, const float* fw, float* out, int bx, int G, int lane, int wave) {
    for (int t = bx * NWAVES + wave; t < T; t += G * NWAVES) {
        const int p0 = POS[2 * t], p1 = POS[2 * t + 1];
        const size_t r0 = (size_t)ts[p0 >> 15] * 256 + (p0 & (CAP - 1)), r1 = (size_t)ts[p1 >> 15] * 256 + (p1 & (CAP - 1));
        f32x4 v[4]; float ss = 0.f;
#pragma unroll
        for (int h = 0; h < 2; ++h) { f32x4 x0, x1, y0, y1, z0, z1; const int c = h * 512 + lane * 8;
            unpack8(*(const u32x4*)(X + (size_t)t * D + c), x0, x1); unpack8(*(const u32x4*)(Y + r0 * D + c), y0, y1); unpack8(*(const u32x4*)(Y + r1 * D + c), z0, z1);
            v[2 * h] = x0 + y0 + z0; v[2 * h + 1] = x1 + y1 + z1;
#pragma unroll
            for (int j = 0; j < 4; ++j) ss += v[2 * h][j] * v[2 * h][j] + v[2 * h + 1][j] * v[2 * h + 1][j]; }
        ss = wave_sum(ss); const float rstd = rsqrtf(ss * (1.f / D) + EPS);
        if (out) {
#pragma unroll
            for (int h = 0; h < 2; ++h) { const int c = h * 512 + lane * 8; const f32x4 f0 = *(const f32x4*)(fw + c), f1 = *(const f32x4*)(fw + c + 4);
                *(f32x4*)(out + (size_t)t * D + c) = v[2 * h] * rstd * f0; *(f32x4*)(out + (size_t)t * D + c + 4) = v[2 * h + 1] * rstd * f1; }
        } else {
#pragma unroll
            for (int h = 0; h < 2; ++h) *(u32x4*)(Xn + (size_t)t * D + h * 512 + lane * 8) = pack8(v[2 * h], v[2 * h + 1]);
            if (lane == 0) RSn[t] = rstd;
        }
    }
}
__device__ __forceinline__ void conv_phase(const bf16* XBR, const float* cw, const float* cb, bf16* XC, int bx, int G, int tid) {
    for (int item = bx * NTHR + tid; item < (T / 32) * 128; item += G * NTHR) {
        const int cg = item & 127, run = item >> 7, c = cg * 8, t0 = run * 32;
        f32x4 w[4][2], b[2];
#pragma unroll
        for (int k = 0; k < 4; ++k) { w[k][0] = *(const f32x4*)(cw + k * D + c); w[k][1] = *(const f32x4*)(cw + k * D + c + 4); }
        b[0] = *(const f32x4*)(cb + c); b[1] = *(const f32x4*)(cb + c + 4);
        f32x4 h0[2], h1[2], h2[2];
        const bool first = (t0 & (SEQ - 1)) == 0;
        if (first) { h0[0] = h0[1] = h1[0] = h1[1] = h2[0] = h2[1] = (f32x4){0.f, 0.f, 0.f, 0.f}; }
        else { unpack8(*(const u32x4*)(XBR + (size_t)(t0 - 3) * D + c), h0[0], h0[1]); unpack8(*(const u32x4*)(XBR + (size_t)(t0 - 2) * D + c), h1[0], h1[1]); unpack8(*(const u32x4*)(XBR + (size_t)(t0 - 1) * D + c), h2[0], h2[1]); }
#pragma unroll 4
        for (int i = 0; i < 32; ++i) { f32x4 x[2]; unpack8(*(const u32x4*)(XBR + (size_t)(t0 + i) * D + c), x[0], x[1]); f32x4 o[2];
#pragma unroll
            for (int q = 0; q < 2; ++q) { o[q] = b[q] + w[0][q] * h0[q] + w[1][q] * h1[q] + w[2][q] * h2[q] + w[3][q] * x[q]; h0[q] = h1[q]; h1[q] = h2[q]; h2[q] = x[q]; }
            *(u32x4*)(XC + (size_t)(t0 + i) * D + c) = pack8(o[0], o[1]); }
    }
}
__device__ __forceinline__ void scan_a_phase(LAS unsigned char* lds, const bf16* LOGA, const bf16* XN, float* AGG, float* CARRY, int bx, int G, int tid) {
    LAS float* sA = (LAS float*)lds; LAS float* sH = sA + 64 * 64;
    for (int item = bx; item < 256; item += G) {
        const int b = item >> 5, slab = (item >> 1) & 15, half = item & 1, seg = tid >> 3, cg = tid & 7, c = slab * 64 + cg * 8;
        const size_t row0 = (size_t)b * SEQ + half * 2048 + seg * 32;
        f32x4 A[2], H[2]; A[0] = A[1] = (f32x4){0.f, 0.f, 0.f, 0.f}; H[0] = H[1] = A[0];
#pragma unroll 4
        for (int i = 0; i < 32; ++i) { f32x4 la[2], xn[2]; unpack8(*(const u32x4*)(LOGA + (row0 + i) * D + c), la[0], la[1]); unpack8(*(const u32x4*)(XN + (row0 + i) * D + c), xn[0], xn[1]);
#pragma unroll
            for (int q = 0; q < 2; ++q) { A[q] += la[q];
#pragma unroll
                for (int j = 0; j < 4; ++j) H[q][j] = fexp(la[q][j]) * H[q][j] + xn[q][j]; } }
        __syncthreads();
#pragma unroll
        for (int q = 0; q < 2; ++q) { *(LAS f32x4*)(sA + seg * 64 + cg * 8 + 4 * q) = A[q]; *(LAS f32x4*)(sH + seg * 64 + cg * 8 + 4 * q) = H[q]; }
        __syncthreads();
        if (tid < 64) { float pl = 0.f, h = 0.f; float* cr = CARRY + (size_t)item * 64 * 128;
            for (int sgi = 0; sgi < 64; ++sgi) { cr[sgi * 128 + tid] = pl; cr[sgi * 128 + 64 + tid] = h; const float a = sA[sgi * 64 + tid]; h = fexp(a) * h + sH[sgi * 64 + tid]; pl += a; }
            AGG[item * 128 + tid] = pl; AGG[item * 128 + 64 + tid] = h; }
    }
}
__device__ __forceinline__ void scan_c_phase(const bf16* LOGA, const bf16* XN, const bf16* GATE, const float* AGG, const float* CARRY, bf16* YL, int bx, int G, int tid) {
    for (int item = bx; item < 256; item += G) {
        const int b = item >> 5, slab = (item >> 1) & 15, half = item & 1, seg = tid >> 3, cg = tid & 7, c = slab * 64 + cg * 8;
        const size_t row0 = (size_t)b * SEQ + half * 2048 + seg * 32;
        const float* cr = CARRY + (size_t)item * 64 * 128 + seg * 128 + cg * 8;
        f32x4 h[2];
#pragma unroll
        for (int q = 0; q < 2; ++q) { const f32x4 pl = *(const f32x4*)(cr + 4 * q), hl = *(const f32x4*)(cr + 64 + 4 * q);
            f32x4 hw = (f32x4){0.f, 0.f, 0.f, 0.f}; if (half) hw = *(const f32x4*)(AGG + (item - 1) * 128 + 64 + cg * 8 + 4 * q);
#pragma unroll
            for (int j = 0; j < 4; ++j) h[q][j] = hl[j] + fexp(pl[j]) * hw[j]; }
#pragma unroll 4
        for (int i = 0; i < 32; ++i) { f32x4 la[2], xn[2], g[2], y[2]; const size_t o = (row0 + i) * D + c;
            unpack8(*(const u32x4*)(LOGA + o), la[0], la[1]); unpack8(*(const u32x4*)(XN + o), xn[0], xn[1]); unpack8(*(const u32x4*)(GATE + o), g[0], g[1]);
#pragma unroll
            for (int q = 0; q < 2; ++q)
#pragma unroll
                for (int j = 0; j < 4; ++j) { h[q][j] = fexp(la[q][j]) * h[q][j] + xn[q][j]; y[q][j] = h[q][j] * g[q][j]; }
            *(u32x4*)(YL + o) = pack8(y[0], y[1]); }
    }
}


__device__ __forceinline__ void gla_core_ref_phase(LAS unsigned char* lds, const bf16* Q, const bf16* Kb, const bf16* V, const bf16* SG, const float* AF, const float* hn, bf16* OG, int bx, int G, int tid) {
    LAS float* part = (LAS float*)lds;
    LAS float* red = part + 512;
    const int e = tid & 255, hf = tid >> 8, lane = tid & 63, w4 = (tid >> 6) & 3;
    for (int bh = bx; bh < 32; bh += G) {
        const int b = bh >> 2, h = bh & 3;
        float S[64];
#pragma unroll
        for (int d = 0; d < 64; ++d) S[d] = 0.f;
        const float hw = hn[e];
        for (int t = 0; t < SEQ; ++t) {
            const size_t row = (size_t)b * SEQ + t;
            const float v = bf2f(V[row * 1024 + h * 256 + e]);
            const float* a = AF + row * 512 + h * 128 + hf * 64; const bf16* k = Kb + row * 512 + h * 128 + hf * 64; const bf16* q = Q + row * 512 + h * 128 + hf * 64;
            float o = 0.f;
#pragma unroll
            for (int d = 0; d < 64; ++d) { S[d] = a[d] * S[d] + bf2f(k[d]) * v; o += bf2f(q[d]) * S[d]; }
            part[hf * 256 + e] = o;
            __syncthreads();
            o = (part[e] + part[256 + e]) * QSCALE;
            float ss = wave_sum(o * o);
            if (hf == 0 && lane == 0) red[w4] = ss;
            __syncthreads();
            ss = red[0] + red[1] + red[2] + red[3];
            const float rstd = rsqrtf(ss * (1.f / 256.f) + EPS);
            if (hf == 0) OG[row * 1024 + h * 256 + e] = f2bf(o * rstd * hw * bf2f(SG[row * 1024 + h * 256 + e]));
        }
        __syncthreads();
    }
}

struct MArgs { const float* in[24]; float* out; unsigned char* ws; int ph_lo, ph_hi, li, pad; };

__global__ void __launch_bounds__(NTHR, 2) mega(MArgs args) {
    extern __shared__ __attribute__((aligned(16))) unsigned char lds_raw[];
    LAS unsigned char* lds = (LAS unsigned char*)lds_raw;
    volatile LAS unsigned* MISC = (volatile LAS unsigned*)(lds + LDS_MISC);
    const int wave = __builtin_amdgcn_readfirstlane((int)(threadIdx.x >> 6));
    const int G = gridDim.x, bx = blockIdx.x;
    unsigned char* ws = args.ws;
    unsigned* ctl = (unsigned*)(ws + WS_CTL);
    { const int tid0 = wave * 64 + lane_id_v();
      for (int u = tid0; u < (LDS_BYTES - LDS_MISC) / 4; u += NTHR) ((LAS unsigned*)(lds + LDS_MISC))[u] = 0u;
      __syncthreads(); }
    XcdBarrier bar = xcd_barrier_post(ctl + CW_BAR + args.li * XCD_BAR_WORDS, MISC + 8, wave == 0 && lane_id_v() == 0);
#define TIDLANE const int lane = lane_id_v(), tid = wave * 64 + lane; (void)tid; (void)lane;
    const int lo = args.ph_lo, hi = args.ph_hi;
#define IN(k) (lo <= (k) && (k) < hi)
#define BOTH(k) (IN(k) && IN((k) + 1))
    const float* const* in = args.in;
#define PH_PTRS unsigned char* wsp = args.ws; asm volatile("" : "+s"(wsp)); \
    float *RS0 = (float*)(wsp + WS_RS0), *RS1 = (float*)(wsp + WS_RS1), *RS2 = (float*)(wsp + WS_RS2), *RS3 = (float*)(wsp + WS_RS3); \
    float *EREF = (float*)(wsp + WS_EREF), *ELAST = (float*)(wsp + WS_ELAST), *ELR = (float*)(wsp + WS_ELR); \
    bf16 *S0 = (bf16*)(wsp + WS_S0), *S1 = (bf16*)(wsp + WS_S1), *S2 = (bf16*)(wsp + WS_S2), *S3 = (bf16*)(wsp + WS_S3), *S4 = (bf16*)(wsp + WS_S4), *S5 = (bf16*)(wsp + WS_S5); \
    bf16 *W1 = (bf16*)(wsp + WS_W1), *WO = (bf16*)(wsp + WS_WO), *WLI = (bf16*)(wsp + WS_WLI), *WLO = (bf16*)(wsp + WS_WLO), *WG = (bf16*)(wsp + WS_WG), *WGU = (bf16*)(wsp + WS_WGU), *WD = (bf16*)(wsp + WS_WD); \
    int* LIST = (int*)(wsp + WS_LIST); float* LW = (float*)(wsp + WS_LW); int* POS = (int*)(wsp + WS_POS); const bf16* WR = (const bf16*)(wsp + WS_WR); unsigned* ctlp = (unsigned*)(wsp + WS_CTL); \
    (void)RS0; (void)RS1; (void)RS2; (void)RS3; (void)EREF; (void)ELAST; (void)ELR; (void)S0; (void)S1; (void)S2; (void)S3; (void)S4; (void)S5; \
    (void)W1; (void)WO; (void)WLI; (void)WLO; (void)WG; (void)WGU; (void)WD; (void)LIST; (void)LW; (void)POS; (void)WR; (void)ctlp;

    if (IN(0)) { PH_PTRS TIDLANE
        const int gw = bx * NWAVES + wave, NGW = G * NWAVES;
        bf16* XB = S0;
        for (int row = gw; row < T; row += NGW) {
            const f32x4* xr = (const f32x4*)(in[0] + (size_t)row * D) + lane; f32x4 v[4]; float s = 0.f;
#pragma unroll
            for (int j = 0; j < 4; ++j) { v[j] = xr[64 * j]; s += (v[j].x * v[j].x + v[j].y * v[j].y) + (v[j].z * v[j].z + v[j].w * v[j].w); }
            s = wave_sum(s);
            u32x2* o8 = (u32x2*)(XB + (size_t)row * D) + lane;
#pragma unroll
            for (int j = 0; j < 4; ++j) { u32x2 w; w.x = cvt_pk_bf16(v[j].x, v[j].y); w.y = cvt_pk_bf16(v[j].z, v[j].w); o8[64 * j] = w; }
            if (lane == 0) RS0[row] = rsqrtf(s * (1.f / D) + EPS);
        }
        LAS float* scr = (LAS float*)(lds + wave * 16384);
        constexpr int I_A = 1536, I_B = 256, I_C = 512, I_D = 1024, I_E = 512, I_F = 256, I_G = 16384, I_H = 8192, NITEMS = I_A + I_B + I_C + I_D + I_E + I_F + I_G + I_H;
        for (int it = gw; it < NITEMS; it += NGW) {
            int r = it;
            if (r < I_A) { cvt_item(in[2], 3088, 0, in[1], W1, 1024, 0, r / 96, r % 96, scr, lane); continue; } r -= I_A;
            if (r < I_B) { cvt_item_la(in[2], in[3], in[1], W1, r / 16, r % 16, scr, lane); continue; } r -= I_B;
            if (r < I_C) { cvt_item(in[6], 1024, 0, nullptr, WO, 1024, 0, r / 32, r % 32, scr, lane); continue; } r -= I_C;
            if (r < I_D) { cvt_item(in[8], 2048, 0, in[7], WLI, 1024, 0, r / 64, r % 64, scr, lane); continue; } r -= I_D;
            if (r < I_E) { cvt_item(in[16], 1024, 0, nullptr, WLO, 1024, 0, r / 32, r % 32, scr, lane); continue; } r -= I_E;
            if (r < I_F) { const int seg = r / 16, q = r % 16, nb4 = seg >> 2, half = (seg >> 1) & 1, pn = seg & 1;
                cvt_item((half ? in[13] : in[11]) + (size_t)nb4 * 65536, 256, pn * 128, nullptr, WG + (size_t)nb4 * 512 * 256, 256, pn * 256 + half * 128, q / 4, q % 4, scr, lane); continue; } r -= I_F;
            if (r < I_G) { const int seg = r / 64, q = r % 64, le = seg >> 2, half = (seg >> 1) & 1, pn = seg & 1;
                cvt_item((half ? in[21] : in[20]) + (size_t)le * 1024 * 256, 256, pn * 128, in[17] + (le >> 5) * D, WGU + (size_t)le * 512 * 1024, 1024, pn * 256 + half * 128, q / 4, q % 4, scr, lane); continue; } r -= I_G;
            { const int le = r / 128, q = r % 128; cvt_item(in[22] + (size_t)le * 256 * 1024, 1024, 0, nullptr, WD + (size_t)le * 1024 * 256, 256, 0, q / 32, q % 32, scr, lane); }
        }
        float* SP = (float*)(wsp + WS_SP); bf16* WRw = (bf16*)(wsp + WS_WR);
        for (int i = bx * NTHR + tid; i < 1024; i += G * NTHR) { const float l = -in[15][i]; SP[i] = fmaxf(l, 0.f) + log1pf(__expf(-fabsf(l))); }
        for (int i = bx * NTHR + tid; i < 2 * 48 * 1024; i += G * NTHR) { const int l = i / (48 * 1024), n = (i / 1024) % 48, k = i % 1024; float v = 0.f;
            if (n < 4) v = in[18][(size_t)l * D * 4 + k * 4 + n]; else if (n < 36) v = in[19][(size_t)l * D * 32 + k * 32 + n - 4];
            WRw[i] = f2bf(v * in[17][l * D + k]); }
        if (BOTH(0)) xcd_barrier(bar, wave);
    }
    if (IN(1)) { PH_PTRS
        pg8::SchedDense S{128, 14, G, bx, (const char*)S0, (const char*)W1, (size_t)256 * 1024 * 2, (size_t)256 * 1024 * 2, 1, 0};
        EpiG1 E{S1, S1 + (size_t)T * 512, S2, S3, S4, S4 + (size_t)T * 512, EREF, ELAST, ELR, (float*)S5, RS0, in[4]};
        pg8::gemm_phase<EpiG1, pg8::SchedDense, false>(lds, 1024, 1024, 1024, S, E, wave);
        if (BOTH(1)) xcd_barrier(bar, wave);
    }
    if (IN(2)) { PH_PTRS TIDLANE
        gla_core_ref_phase(lds, S1, S1 + (size_t)T * 512, S2, S3, (const float*)S5, in[5], S0, bx, G, tid);
        if (BOTH(2)) xcd_barrier(bar, wave);
    }
    if (IN(3)) { PH_PTRS
        pg8::SchedDense S{128, 4, G, bx, (const char*)S0, (const char*)WO, (size_t)256 * 1024 * 2, (size_t)256 * 1024 * 2, 1, 0};
        EpiResidF E{in[0], nullptr, S1};
        pg8::gemm_phase<EpiResidF, pg8::SchedDense, false>(lds, 1024, 1024, 1024, S, E, wave);
        if (BOTH(3)) xcd_barrier(bar, wave);
    }

    LAS int* ts = (LAS int*)(lds + LDS_MISC + TS_OFF);
#define MOE_PHASES(P, LAYER, XIN, RSX, ACTB, YB, XOUT, RSOUT, FW, OUTP) \
    if (IN(P)) { PH_PTRS TIDLANE router_phase(lds, XIN, WR + (size_t)(LAYER) * 48 * 1024, RSX, ctlp + CW_CNT + 64 * (LAYER), LIST, LW, POS, bx, G, tid, lane, wave); if (BOTH(P)) xcd_barrier(bar, wave); } \
    if (IN(P + 1)) { PH_PTRS TIDLANE build_ts(ctlp + CW_CNT + 64 * (LAYER), ts, tid); \
        pg8::SchedMoe S{ts, G, bx, 2, (const char*)(XIN), (const char*)(WGU + (size_t)(LAYER) * 32 * 512 * 1024), LIST, (size_t)512 * 1024 * 2, (size_t)256 * 1024 * 2, 0, true}; \
        EpiM1 E{ACTB, LIST, LW, RSX}; \
        pg8::gemm_phase<EpiM1, pg8::SchedMoe, true>(lds, 1024, 1024, 1024, S, E, wave); if (BOTH(P + 1)) xcd_barrier(bar, wave); } \
    if (IN(P + 2)) { PH_PTRS TIDLANE build_ts(ctlp + CW_CNT + 64 * (LAYER), ts, tid); \
        pg8::SchedMoe S{ts, G, bx, 4, (const char*)(ACTB), (const char*)(WD + (size_t)(LAYER) * 32 * 1024 * 256), LIST, (size_t)1024 * 256 * 2, (size_t)256 * 256 * 2, (size_t)256 * 256 * 2, false}; \
        EpiStore E{YB, 1024, 0}; \
        pg8::gemm_phase<EpiStore, pg8::SchedMoe, false>(lds, 256, 256, 256, S, E, wave); if (BOTH(P + 2)) xcd_barrier(bar, wave); } \
    if (IN(P + 3)) { PH_PTRS TIDLANE build_ts(ctlp + CW_CNT + 64 * (LAYER), ts, tid); \
        combine_phase(ts, XIN, YB, POS, XOUT, RSOUT, FW, OUTP, bx, G, lane, wave); if (BOTH(P + 3)) xcd_barrier(bar, wave); }

    MOE_PHASES(4, 0, S1, RS1, S2, S3, S0, RS2, nullptr, nullptr)
    if (IN(8)) { PH_PTRS
        pg8::SchedDense S{128, 8, G, bx, (const char*)S0, (const char*)WLI, (size_t)256 * 1024 * 2, (size_t)256 * 1024 * 2, 1, 0};
        EpiL1 E{S1, S2, RS2};
        pg8::gemm_phase<EpiL1, pg8::SchedDense, false>(lds, 1024, 1024, 1024, S, E, wave);
        if (BOTH(8)) xcd_barrier(bar, wave);
    }
    if (IN(9)) { PH_PTRS TIDLANE conv_phase(S1, in[9], in[10], S3, bx, G, tid); if (BOTH(9)) xcd_barrier(bar, wave); }
    if (IN(10)) { PH_PTRS
        pg8::SchedDense S{128, 8, G, bx, (const char*)S3, (const char*)WG, (size_t)256 * 1024 * 2, (size_t)256 * 256 * 2, 2, (size_t)512};
        EpiL2 E{S3, S4, S5, in[12], in[14], (const float*)(wsp + WS_SP)};
        pg8::gemm_phase<EpiL2, pg8::SchedDense, false>(lds, 1024, 256, 256, S, E, wave);
        if (BOTH(10)) xcd_barrier(bar, wave);
    }
    if (IN(11)) { PH_PTRS TIDLANE scan_a_phase(lds, S4, S5, (float*)(wsp + WS_AGG), (float*)(wsp + WS_CARRY), bx, G, tid); if (BOTH(11)) xcd_barrier(bar, wave); }
    if (IN(12)) { PH_PTRS TIDLANE scan_c_phase(S4, S5, S2, (const float*)(wsp + WS_AGG), (const float*)(wsp + WS_CARRY), S1, bx, G, tid); if (BOTH(12)) xcd_barrier(bar, wave); }
    if (IN(13)) { PH_PTRS
        pg8::SchedDense S{128, 4, G, bx, (const char*)S1, (const char*)WLO, (size_t)256 * 1024 * 2, (size_t)256 * 1024 * 2, 1, 0};
        EpiResidF E{nullptr, S0, S5};
        pg8::gemm_phase<EpiResidF, pg8::SchedDense, false>(lds, 1024, 1024, 1024, S, E, wave);
        if (BOTH(13)) xcd_barrier(bar, wave);
    }
    MOE_PHASES(14, 1, S5, RS3, S3, S0, (bf16*)nullptr, (float*)nullptr, in[23], args.out)
#undef MOE_PHASES
#undef PH_PTRS
#undef TIDLANE
#undef IN
#undef BOTH
}

static int mega_grid() {
    static int grid = 0;
    if (grid == 0) {
        int dev = 0, cus = 0;
        if (hipGetDevice(&dev) != hipSuccess || hipDeviceGetAttribute(&cus, hipDeviceAttributeMultiprocessorCount, dev) != hipSuccess) { grid = -1; return grid; }
        if (hipFuncSetAttribute((const void*)mega, hipFuncAttributeMaxDynamicSharedMemorySize, LDS_BYTES) != hipSuccess) { fprintf(stderr, "hipFuncSetAttribute failed\n"); grid = -1; return grid; }
        int per_cu = 0;
        if (hipOccupancyMaxActiveBlocksPerMultiprocessor(&per_cu, (const void*)mega, NTHR, LDS_BYTES) != hipSuccess || per_cu < 1) { fprintf(stderr, "occupancy query: %d\n", per_cu); (void)hipGetLastError(); }
        grid = cus;
    }
    return grid;
}
static void launch_mega(const MArgs& base, int lo, int hi, int li, hipStream_t stream) {
    MArgs a = base; a.ph_lo = lo; a.ph_hi = hi; a.li = li; a.pad = 0;
    hipLaunchKernelGGL(mega, dim3(mega_grid()), dim3(NTHR), LDS_BYTES, stream, a);
}
extern "C" void kernel_launch(void* const* d_in, const int* in_sizes, int n_in, void* d_out, int out_size, void* d_ws, size_t ws_size, hipStream_t stream) {
    if (n_in != 24 || out_size != T * D || ws_size < WS_END) { fprintf(stderr, "kernel_launch: unexpected shapes (n_in %d out %d ws %zu)\n", n_in, out_size, ws_size); return; }
    if (mega_grid() <= 0) return;
    const float* const* in = (const float* const*)d_in; unsigned char* ws = (unsigned char*)d_ws;
    (void)hipMemsetAsync(ws + WS_CTL, 0, 1 * MiB, stream);
    MArgs base{}; for (int i = 0; i < 24; ++i) base.in[i] = in[i]; base.out = (float*)d_out; base.ws = ws;
    launch_mega(base, 0, 18, 0, stream);
}
```

```cpp
#include <hip/hip_runtime.h>
#include <cstdio>
#include <cstdint>

typedef unsigned short bf16;
constexpr int T = 32768, D = 1024, SEQ = 4096, NB = 8;
constexpr float EPS = 1e-6f;
constexpr size_t MiB = 1u << 20;
constexpr size_t WS_CTL = 0;
constexpr size_t WS_RS0 = 1 * MiB, WS_RS1 = WS_RS0 + 128 * 1024, WS_RS2 = WS_RS1 + 128 * 1024, WS_RS3 = WS_RS2 + 128 * 1024;
constexpr size_t WS_EREF = 2 * MiB, WS_ELAST = 3 * MiB, WS_ELR = 4 * MiB;
constexpr size_t WS_S0 = 128 * MiB, WS_S1 = 192 * MiB, WS_S2 = 256 * MiB, WS_S3 = 320 * MiB, WS_S4 = 384 * MiB, WS_S5 = 448 * MiB, WS_END = 512 * MiB;

__device__ __forceinline__ float bf2f(bf16 b) { return __uint_as_float(((unsigned)b) << 16); }
__device__ __forceinline__ bf16 f2bf(float f) { unsigned u = __float_as_uint(f); u += 0x7fffu + ((u >> 16) & 1u); return (bf16)(u >> 16); }
__device__ __forceinline__ float wave_sum(float v) {
#pragma unroll
    for (int o = 1; o < 64; o <<= 1) v += __shfl_xor(v, o);
    return v;
}
__device__ __forceinline__ float sigmoidf_(float x) { return 1.f / (1.f + __expf(-x)); }
__device__ __forceinline__ float siluf_(float x) { return x / (1.f + __expf(-x)); }
__device__ __forceinline__ float logsigmoidf_(float x) { return fminf(x, 0.f) - log1pf(__expf(-fabsf(x))); }
__device__ __forceinline__ float softplusf_(float x) { return fmaxf(x, 0.f) + log1pf(__expf(-fabsf(x))); }
__device__ __forceinline__ float gelu_tanhf_(float x) { const float u = 0.7978845608028654f * (x + 0.044715f * x * x * x); return 0.5f * x * (1.f + tanhf(u)); }

__global__ void __launch_bounds__(256) n_prologue(const float* x, bf16* XB, float* RS) {
    const int row = blockIdx.x * 4 + (threadIdx.x >> 6), lane = threadIdx.x & 63;
    const float* xr = x + (size_t)row * D; float s = 0.f;
    for (int i = lane; i < D; i += 64) { const float v = xr[i]; s += v * v; XB[(size_t)row * D + i] = f2bf(v); }
    s = wave_sum(s);
    if (lane == 0) RS[row] = rsqrtf(s * (1.f / D) + EPS);
}

template <class Epi>
__global__ void __launch_bounds__(256) n_gemm(const bf16* A, int lda, const float* rs, const float* nw, const float* W, int ldw, int M, int N, int K, Epi epi) {
    __shared__ float As[16][65], Ws[16][64];
    const int tid = threadIdx.x, tx = tid & 15, ty = tid >> 4, m0 = blockIdx.y * 64, n0 = blockIdx.x * 64;
    float acc[4][4];
#pragma unroll
    for (int i = 0; i < 4; ++i)
#pragma unroll
        for (int j = 0; j < 4; ++j) acc[i][j] = 0.f;
    for (int k0 = 0; k0 < K; k0 += 16) {
#pragma unroll
        for (int i = 0; i < 4; ++i) { const int idx = tid + 256 * i, r = idx >> 4, kk = idx & 15; As[kk][r] = bf2f(A[(size_t)(m0 + r) * lda + k0 + kk]) * (nw ? nw[k0 + kk] : 1.f); }
#pragma unroll
        for (int i = 0; i < 4; ++i) { const int idx = tid + 256 * i, kk = idx >> 6, n = idx & 63; Ws[kk][n] = (n0 + n < N) ? W[(size_t)(k0 + kk) * ldw + n0 + n] : 0.f; }
        __syncthreads();
#pragma unroll
        for (int kk = 0; kk < 16; ++kk) {
            float a[4], b[4];
#pragma unroll
            for (int i = 0; i < 4; ++i) a[i] = As[kk][ty * 4 + i];
#pragma unroll
            for (int j = 0; j < 4; ++j) b[j] = Ws[kk][tx + 16 * j];
#pragma unroll
            for (int i = 0; i < 4; ++i)
#pragma unroll
                for (int j = 0; j < 4; ++j) acc[i][j] += a[i] * b[j];
        }
        __syncthreads();
    }
#pragma unroll
    for (int i = 0; i < 4; ++i) { const int r = m0 + ty * 4 + i; const float sc = rs ? rs[r] : 1.f;
#pragma unroll
        for (int j = 0; j < 4; ++j) { const int c = n0 + tx + 16 * j; if (c < N) epi(r, c, acc[i][j] * sc); } }
}
struct EpiGlaProj { bf16 *Q, *Kb, *V, *SG; float* LR;
    __device__ void operator()(int r, int c, float v) const {
        if (c < 512) Q[(size_t)r * 512 + c] = f2bf(v);
        else if (c < 1024) Kb[(size_t)r * 512 + c - 512] = f2bf(v);
        else if (c < 2048) V[(size_t)r * 1024 + c - 1024] = f2bf(v);
        else if (c < 3072) SG[(size_t)r * 1024 + c - 2048] = f2bf(siluf_(v));
        else LR[(size_t)r * 16 + c - 3072] = v; } };
struct EpiResid { const float* xf; const bf16* xb; bf16* out;
    __device__ void operator()(int r, int c, float v) const { const size_t i = (size_t)r * D + c; out[i] = f2bf((xf ? xf[i] : bf2f(xb[i])) + v); } };
struct EpiLruIn { bf16 *XBR, *GATE;
    __device__ void operator()(int r, int c, float v) const { if (c < 1024) XBR[(size_t)r * D + c] = f2bf(v); else GATE[(size_t)r * D + c - 1024] = f2bf(gelu_tanhf_(v)); } };
struct EpiGate { bf16* O; const float* bias; int coff; int pad;
    __device__ void operator()(int r, int c, float v) const { O[(size_t)r * D + coff + c] = f2bf(sigmoidf_(v + bias[coff + c])); } };

__global__ void __launch_bounds__(256) n_gla_prep(const float* LR, const float* w_alpha, const float* b_alpha, bf16* EQ, bf16* EK, float* EREF, float* ELAST, float* ELR, float* AF) {
    const int gi = blockIdx.x * 256 + threadIdx.x, chunk = gi >> 9, col = gi & 511;
    float wa[16];
#pragma unroll
    for (int r = 0; r < 16; ++r) wa[r] = w_alpha[r * 512 + col];
    const float ba = b_alpha[col];
    float cum = 0.f, ref = 0.f;
    for (int i = 0; i < 64; ++i) { const float* lr = LR + (size_t)(chunk * 64 + i) * 16; float z = ba;
#pragma unroll
        for (int r = 0; r < 16; ++r) z += lr[r] * wa[r];
        const float la = logsigmoidf_(z) * (1.f / 16.f); cum += la; if (i == 32) ref = cum; AF[(size_t)(chunk * 64 + i) * 512 + col] = __expf(la); }
    const float last = cum;
    EREF[chunk * 512 + col] = __expf(ref); ELAST[chunk * 512 + col] = __expf(last); ELR[chunk * 512 + col] = __expf(last - ref);
    cum = 0.f;
    for (int i = 0; i < 64; ++i) { const float* lr = LR + (size_t)(chunk * 64 + i) * 16; float z = ba;
#pragma unroll
        for (int r = 0; r < 16; ++r) z += lr[r] * wa[r];
        cum += logsigmoidf_(z) * (1.f / 16.f);
        const size_t o = (size_t)(chunk * 64 + i) * 512 + col;
        EQ[o] = f2bf(0.08838834764831845f * __expf(cum - ref)); EK[o] = f2bf(__expf(ref - cum)); }
}
__global__ void __launch_bounds__(256) n_gla_core(const bf16* Q, const bf16* Kb, const bf16* V, const bf16* SG, const float* AF, const float* hn, bf16* OG) {
    __shared__ float red[4];
    const int bh = blockIdx.x, b = bh >> 2, h = bh & 3, e = threadIdx.x, lane = e & 63, w = e >> 6;
    float S[128];
#pragma unroll
    for (int d = 0; d < 128; ++d) S[d] = 0.f;
    const float hw = hn[e];
    for (int t = 0; t < SEQ; ++t) {
        const size_t row = (size_t)b * SEQ + t;
        const float v = bf2f(V[row * 1024 + h * 256 + e]);
        const float* a = AF + row * 512 + h * 128; const bf16* k = Kb + row * 512 + h * 128; const bf16* q = Q + row * 512 + h * 128;
        float o = 0.f;
#pragma unroll
        for (int d = 0; d < 128; ++d) { S[d] = a[d] * S[d] + bf2f(k[d]) * v; o += bf2f(q[d]) * S[d]; }
        o *= 0.08838834764831845f;
        float ss = wave_sum(o * o);
        __syncthreads();
        if (lane == 0) red[w] = ss;
        __syncthreads();
        ss = red[0] + red[1] + red[2] + red[3];
        const float rstd = rsqrtf(ss * (1.f / 256.f) + EPS);
        OG[row * 1024 + h * 256 + e] = f2bf(o * rstd * hw * bf2f(SG[row * 1024 + h * 256 + e]));
    }
}
__global__ void __launch_bounds__(256) n_moe(const bf16* Xin, const float* nw, const float* wg, const float* we, const float* Wgate, const float* Wup, const float* Wdown,
                                             bf16* Xout, float* RSout, const float* final_w, float* out) {
    __shared__ float hs[1024], logit[36], act[256], red[4]; __shared__ int sel[2]; __shared__ float selw[2];
    const int t = blockIdx.x, tid = threadIdx.x, lane = tid & 63, w = tid >> 6;
    float xv[4]; float s = 0.f;
#pragma unroll
    for (int i = 0; i < 4; ++i) { xv[i] = bf2f(Xin[(size_t)t * D + tid + 256 * i]); s += xv[i] * xv[i]; }
    s = wave_sum(s); if (lane == 0) red[w] = s; __syncthreads();
    const float rstd = rsqrtf((red[0] + red[1] + red[2] + red[3]) * (1.f / D) + EPS);
#pragma unroll
    for (int i = 0; i < 4; ++i) hs[tid + 256 * i] = xv[i] * rstd * nw[tid + 256 * i];
    __syncthreads();
    for (int li = w * 9; li < w * 9 + 9; ++li) { float p = 0.f;
        for (int k = lane; k < D; k += 64) p += hs[k] * (li < 4 ? wg[k * 4 + li] : we[k * 32 + li - 4]);
        p = wave_sum(p); if (lane == 0) logit[li] = p; }
    __syncthreads();
    if (tid == 0) {
        int g = 0; float gm = logit[0];
        for (int i = 1; i < 4; ++i) if (logit[i] > gm) { gm = logit[i]; g = i; }
        float gs = 0.f; for (int i = 0; i < 4; ++i) gs += __expf(logit[i] - gm);
        const float pg = 1.f / gs;
        const float* el = logit + 4 + g * 8; int e0 = 0; float m0 = el[0];
        for (int i = 1; i < 8; ++i) if (el[i] > m0) { m0 = el[i]; e0 = i; }
        int e1 = -1; float m1 = -3.0e38f;
        for (int i = 0; i < 8; ++i) if (i != e0 && el[i] > m1) { m1 = el[i]; e1 = i; }
        const float p1 = __expf(m1 - m0), den = 1.f + p1;
        sel[0] = g * 8 + e0; sel[1] = g * 8 + e1; selw[0] = pg / den; selw[1] = pg * p1 / den;
    }
    __syncthreads();
    float oacc[4] = {0.f, 0.f, 0.f, 0.f};
    for (int kk = 0; kk < 2; ++kk) {
        const int e = sel[kk]; const float wt = selw[kk];
        const float* G = Wgate + (size_t)e * D * 256; const float* U = Wup + (size_t)e * D * 256; const float* Dn = Wdown + (size_t)e * 256 * D;
        float ga = 0.f, ua = 0.f;
        for (int k = 0; k < D; ++k) { const float hv = hs[k]; ga += hv * G[k * 256 + tid]; ua += hv * U[k * 256 + tid]; }
        __syncthreads();
        act[tid] = siluf_(ga) * ua;
        __syncthreads();
        float o4[4] = {0.f, 0.f, 0.f, 0.f};
        for (int f = 0; f < 256; ++f) { const float av = act[f];
#pragma unroll
            for (int i = 0; i < 4; ++i) o4[i] += av * Dn[(size_t)f * D + tid + 256 * i]; }
#pragma unroll
        for (int i = 0; i < 4; ++i) oacc[i] += wt * o4[i];
    }
    float s2 = 0.f;
#pragma unroll
    for (int i = 0; i < 4; ++i) { xv[i] += oacc[i]; s2 += xv[i] * xv[i]; }
    s2 = wave_sum(s2); __syncthreads(); if (lane == 0) red[w] = s2; __syncthreads();
    const float rstd2 = rsqrtf((red[0] + red[1] + red[2] + red[3]) * (1.f / D) + EPS);
    if (out) {
#pragma unroll
        for (int i = 0; i < 4; ++i) out[(size_t)t * D + tid + 256 * i] = xv[i] * rstd2 * final_w[tid + 256 * i];
    } else {
#pragma unroll
        for (int i = 0; i < 4; ++i) Xout[(size_t)t * D + tid + 256 * i] = f2bf(xv[i]);
        if (tid == 0) RSout[t] = rstd2;
    }
}
__global__ void __launch_bounds__(256) n_conv(const bf16* XBR, const float* cw, const float* cb, bf16* XC) {
    const size_t i = (size_t)blockIdx.x * 256 + threadIdx.x; const int c = (int)(i & 1023); const int row = (int)(i >> 10), s = row & (SEQ - 1);
    float v = cb[c];
#pragma unroll
    for (int tap = 0; tap < 4; ++tap) { const int ss = s - 3 + tap; if (ss >= 0) v += cw[tap * 1024 + c] * bf2f(XBR[(size_t)(row - 3 + tap) * D + c]); }
    XC[i] = f2bf(v);
}
__global__ void __launch_bounds__(256) n_lru_scan(const bf16* XC, const bf16* RG, const bf16* IG, const bf16* GATE, const float* lam, bf16* YL) {
    const int gi = blockIdx.x * 256 + threadIdx.x, b = gi >> 10, c = gi & 1023;
    const float sp = softplusf_(-lam[c]); float h = 0.f;
    for (int t = 0; t < SEQ; ++t) { const size_t i = ((size_t)b * SEQ + t) * D + c;
        const float la = -8.f * bf2f(RG[i]) * sp, a = __expf(la), mult = sqrtf(-expm1f(2.f * la));
        h = a * h + bf2f(XC[i]) * bf2f(IG[i]) * mult;
        YL[i] = f2bf(h * bf2f(GATE[i])); }
}


#define LAS __attribute__((address_space(3)))
#define GAS __attribute__((address_space(1)))
typedef short bf16x8 __attribute__((ext_vector_type(8)));
typedef float f32x4 __attribute__((ext_vector_type(4)));
typedef float f32x2 __attribute__((ext_vector_type(2)));
typedef unsigned u32x4 __attribute__((ext_vector_type(4)));
typedef unsigned u32x2 __attribute__((ext_vector_type(2)));
typedef GAS unsigned gu32;
#define RLX_AGENT __ATOMIC_RELAXED, __HIP_MEMORY_SCOPE_AGENT
constexpr int NWAVES = 8, NTHR = 512;
constexpr int LDS_STAGE = 131072, LDS_MISC = LDS_STAGE, LDS_BYTES = 147456;
constexpr float QSCALE = 0.08838834764831845f;

constexpr size_t WS_SP = 1 * MiB + 512 * 1024;
constexpr size_t WS_WR = 14 * MiB;
constexpr size_t WS_W1 = 16 * MiB;
constexpr size_t WS_WO = WS_W1 + (size_t)3584 * 1024 * 2;
constexpr size_t WS_WLI = WS_WO + (size_t)1024 * 1024 * 2;
constexpr size_t WS_WLO = WS_WLI + (size_t)2048 * 1024 * 2;
constexpr size_t WS_WG = WS_WLO + (size_t)1024 * 1024 * 2;
constexpr size_t WS_WGU = WS_WG + (size_t)4 * 512 * 256 * 2;
constexpr size_t WS_WD = WS_WGU + (size_t)64 * 512 * 1024 * 2;
static_assert(WS_WD + (size_t)64 * 1024 * 256 * 2 <= WS_S0, "weights fit below the activation slots");
constexpr int CW_TMO = 0, CW_BAR = 4096;

__device__ __forceinline__ unsigned cvt_pk_bf16(float lo, float hi) { unsigned r; asm volatile("v_cvt_pk_bf16_f32 %0, %1, %2" : "=v"(r) : "v"(lo), "v"(hi)); return r; }
__device__ __forceinline__ float fexp(float x) { return __builtin_amdgcn_exp2f(x * 1.4426950408889634f); }
__device__ __forceinline__ float flog(float x) { return __builtin_amdgcn_logf(x) * 0.6931471805599453f; }
__device__ __forceinline__ float frcp(float x) { return __builtin_amdgcn_rcpf(x); }
__device__ __forceinline__ float fsilu(float x) { return x * frcp(1.f + fexp(-x)); }
__device__ __forceinline__ float fsigmoid(float x) { return frcp(1.f + fexp(-x)); }
__device__ __forceinline__ float flogsigmoid(float x) { return fminf(x, 0.f) - flog(1.f + fexp(-fabsf(x))); }
__device__ __forceinline__ float fgelu_tanh(float x) { const float u = 1.5957691216057308f * (x + 0.044715f * x * x * x); return x * frcp(1.f + fexp(-u)); }
__device__ __forceinline__ int lane_id_v() { int l; asm volatile("v_mbcnt_lo_u32_b32 %0, -1, 0\n\tv_mbcnt_hi_u32_b32 %0, -1, %0" : "=v"(l)); return l; }
template <int N> __device__ __forceinline__ float dpp_shr(float v) {
    return __builtin_bit_cast(float, __builtin_amdgcn_update_dpp(0, __builtin_bit_cast(int, v), 0x110 + N, 0xf, 0xf, true)); }

#define XB_TMO      128
#define XB_XCNT(j)  (256  + 64 * (j))
#define XB_XSUB(j)  (1280 + 64 * (j))
#define XB_XGEN(j)  (2304 + 64 * (j))
#define XB_TOP      3328
#define XB_TOPGEN   3392
#define XCD_BAR_WORDS 3456
#define XB_SPIN_CAP (1u << 18)
__device__ __forceinline__ unsigned xb_ld(unsigned* p)              { return __hip_atomic_load(p, __ATOMIC_RELAXED, __HIP_MEMORY_SCOPE_AGENT); }
__device__ __forceinline__ unsigned xb_add(unsigned* p, unsigned v) { return __hip_atomic_fetch_add(p, v, __ATOMIC_RELAXED, __HIP_MEMORY_SCOPE_AGENT); }
__device__ __forceinline__ unsigned xb_xcc_id() { return (unsigned)__builtin_amdgcn_s_getreg((3 << 11) | 20) & 0xFu; }
#define XB_SPIN(cond, bar) do { unsigned _sp = 0; while (cond) { __builtin_amdgcn_s_sleep(1); \
    if ((++_sp & 255u) == 0u) { if (xb_ld(&(bar)[XB_TMO])) break; if (_sp > XB_SPIN_CAP) { atomicAdd(&(bar)[XB_TMO], 1u); break; } } } } while (0)
struct XcdBarrier { unsigned* bar; unsigned x; volatile LAS unsigned* st; };
__device__ __forceinline__ XcdBarrier xcd_barrier_post(unsigned* bar, volatile LAS unsigned* st, bool t0) {
    XcdBarrier b; b.bar = bar; b.x = xb_xcc_id(); b.st = st;
    if (t0) (void)xb_add(&bar[XB_XCNT(b.x)], 1u);
    return b;
}
__device__ __forceinline__ void xcd_barrier_complete(unsigned* bar, unsigned x, unsigned& nloc, unsigned& nx) {
    const unsigned G = gridDim.x * gridDim.y * gridDim.z;
    unsigned sum, cnt, mine, sp = 0u;
    for (;;) {
        sum = 0u; cnt = 0u; mine = 0u;
#pragma unroll
        for (unsigned j = 0; j < 16; ++j) { const unsigned c = xb_ld(&bar[XB_XCNT(j)]); sum += c; cnt += (c > 0u) ? 1u : 0u; mine = (j == x) ? c : mine; }
        if (sum == G) break;
        __builtin_amdgcn_s_sleep(1);
        if ((++sp & 255u) == 0u) { if (xb_ld(&bar[XB_TMO])) break; if (sp > XB_SPIN_CAP) { atomicAdd(&bar[XB_TMO], 1u); break; } }
    }
    nloc = mine > 0u ? mine : 1u; nx = cnt > 0u ? cnt : 1u;
}
__device__ __forceinline__ void xcd_barrier(const XcdBarrier& b, int wave_) {
    asm volatile("s_waitcnt vmcnt(0)" ::: "memory");
    __syncthreads();
    if (wave_ == 0 && lane_id_v() == 0) {
        unsigned* bar = b.bar;
        __builtin_amdgcn_s_waitcnt(0);
        unsigned nloc = b.st[0], nx = b.st[1];
        if (nloc == 0u) { xcd_barrier_complete(bar, b.x, nloc, nx); b.st[0] = nloc; b.st[1] = nx; }
        const unsigned old = xb_add(&bar[XB_XSUB(b.x)], 1u);
        const unsigned gen = old / nloc;
        if (old + 1u == (gen + 1u) * nloc) {
            __builtin_amdgcn_fence(__ATOMIC_RELEASE, "agent");
            asm volatile("s_waitcnt vmcnt(0)" ::: "memory");
            const unsigned og = xb_add(&bar[XB_TOP], 1u);
            const unsigned tg = og / nx;
            if (og + 1u == (tg + 1u) * nx) xb_add(&bar[XB_TOPGEN], 1u);
            else XB_SPIN(xb_ld(&bar[XB_TOPGEN]) == tg, bar);
            __builtin_amdgcn_fence(__ATOMIC_ACQUIRE, "agent");
            xb_add(&bar[XB_XGEN(b.x)], 1u);
            asm volatile("s_waitcnt vmcnt(0)" ::: "memory");
        } else {
            XB_SPIN(xb_ld(&bar[XB_XGEN(b.x)]) == gen, bar);
            __builtin_amdgcn_fence(__ATOMIC_ACQUIRE, "agent");
            asm volatile("s_waitcnt vmcnt(0)" ::: "memory");
        }
    }
    __syncthreads();
}

namespace pg8 {
constexpr int BM = 256, BK = 64, HALF = 128, HTB = HALF * BK * 2, NXCD = 8, WGM = 8;
__device__ __forceinline__ int lds_byte(int r, int c) { const int st = (r >> 4) * 2 + (c >> 5), rr = r & 15, cc = c & 31, ob = rr * 64 + cc * 2; return st * 1024 + (ob ^ (((ob >> 9) & 1) << 5)); }
__device__ __forceinline__ void stage_rc(int b, int& R, int& C) { const int st = b / 1024, sb = b % 1024, swz = sb ^ (((sb >> 9) & 1) << 5); R = (st >> 1) * 16 + swz / 64; C = (st & 1) * 32 + (swz % 64) / 2; }
__device__ __forceinline__ int perm32(int rho) { const int n = rho >> 4, i = rho & 15; return 8 * (i >> 2) + 4 * n + (i & 3); }
__device__ __forceinline__ void tile_order(int L, int nM, int nN, int& pm, int& pn) {
    const int nwg = nM * nN; int wgid = L; { const int q = nwg / NXCD, r = nwg % NXCD, xcd = wgid % NXCD, off = wgid / NXCD; wgid = (xcd < r ? xcd * (q + 1) : r * (q + 1) + (xcd - r) * q) + off; }
    const int nig = WGM * nN, gid = wgid / nig, fm = gid * WGM, gsz = (nM - fm) < WGM ? (nM - fm) : WGM;
    pm = fm + ((wgid % nig) % gsz); pn = (wgid % nig) / gsz;
}
struct Unit { const char* a; const char* b; const int* rows; int pm, pn, e; };

template <class Epi, class Sched, bool GATHER>
__device__ __forceinline__ void gemm_phase(LAS unsigned char* lds, const int lda, const int ldb, const int K, const Sched& S, const Epi& E, const int wid) {
    const int lane = lane_id_v(), tid = wid * 64 + lane, wr = wid >> 2, wc = wid & 3, fr = lane & 15, fq = lane >> 4;
    int nt = K / BK; asm volatile("" : "+s"(nt));
    int Rr[2], Cc[2]; unsigned voffB[2];
#pragma unroll
    for (int i = 0; i < 2; ++i) { int R, C; stage_rc(tid * 16 + i * 8192, R, C); Rr[i] = R; Cc[i] = C; const int Rb = (R & ~31) + perm32(R & 31); voffB[i] = (unsigned)(Rb * ldb + C) * 2u; }
    const size_t kstep = (size_t)(BK * 2);
    const size_t hstepB = (size_t)HALF * ldb * 2;
    const unsigned ldsw = (unsigned)wid * 1024u;
    const int aoff = lds_byte(wr * 64 + fr, fq * 8), boff = lds_byte(wc * 32 + fr, fq * 8);
#define PG8_SA(b, h) (((b) * 2 + (h)) * HTB)
#define PG8_SB(b, h) ((4 + (b) * 2 + (h)) * HTB)
#define PG8_STAGE(bufoff, gbase, voff) do { _Pragma("unroll") for (int _i = 0; _i < 2; ++_i) \
        __builtin_amdgcn_global_load_lds((const unsigned*)((const char*)(gbase) + (voff)[_i]), (LAS unsigned*)(lds + (bufoff) + ldsw + _i * 8192), 16, 0, 0); } while (0)
#define PG8_LDA(dst, b, h) do { _Pragma("unroll") for (int m = 0; m < 4; ++m) _Pragma("unroll") for (int k = 0; k < 2; ++k) dst[m][k] = *(const LAS bf16x8*)(lds + PG8_SA(b, h) + aoff + m * 2048 + k * 1024); } while (0)
#define PG8_LDB(dst, b, h) do { _Pragma("unroll") for (int n = 0; n < 2; ++n) _Pragma("unroll") for (int k = 0; k < 2; ++k) dst[n][k] = *(const LAS bf16x8*)(lds + PG8_SB(b, h) + boff + n * 2048 + k * 1024); } while (0)
#define PG8_MMA(ai, bj, At, Bt) do { __builtin_amdgcn_s_setprio(1); _Pragma("unroll") for (int m = 0; m < 4; ++m) _Pragma("unroll") for (int n = 0; n < 2; ++n) _Pragma("unroll") for (int k = 0; k < 2; ++k) \
        acc[ai][bj][m][n] = __builtin_amdgcn_mfma_f32_16x16x32_bf16(Bt[n][k], At[m][k], acc[ai][bj][m][n], 0, 0, 0); __builtin_amdgcn_s_setprio(0); } while (0)
#define PG8_WAIT_V(n) asm volatile("s_waitcnt vmcnt(" #n ")" ::: "memory")
#define PG8_WAIT_L(n) asm volatile("s_waitcnt lgkmcnt(" #n ")" ::: "memory")
#define PG8_BAR __builtin_amdgcn_s_barrier()
#define PG8_SCHED __builtin_amdgcn_sched_barrier(0)
#define PG8_SETVOFF(v, u) do { _Pragma("unroll") for (int _h = 0; _h < 2; ++_h) _Pragma("unroll") for (int _i = 0; _i < 2; ++_i) { \
        if (GATHER) { unsigned _tk = (unsigned)(u).rows[_h * HALF + Rr[_i]]; _tk = _tk < (unsigned)T ? _tk : 0u; (v)[_h][_i] = (_tk * (unsigned)lda + (unsigned)Cc[_i]) * 2u; } else (v)[_h][_i] = (unsigned)(((_h * HALF + Rr[_i]) * lda + Cc[_i]) * 2); } } while (0)
    Unit cur, nxt; int ui = 0;
    if (!S.next(0, cur)) return;
    f32x4 acc[2][2][4][2];
#pragma unroll
    for (int a = 0; a < 2; ++a)
#pragma unroll
        for (int b = 0; b < 2; ++b)
#pragma unroll
            for (int m = 0; m < 4; ++m)
#pragma unroll
                for (int n = 0; n < 2; ++n) acc[a][b][m][n] = (f32x4){0.f, 0.f, 0.f, 0.f};
    bf16x8 At[4][2], B0[2][2], B1[2][2];
    unsigned vA[2][2], vN[2][2];
    PG8_SETVOFF(vA, cur);
    if (GATHER) asm volatile("" :: "v"(vA[0][0]), "v"(vA[0][1]), "v"(vA[1][0]), "v"(vA[1][1]));
    const char* cA = cur.a; const char* cB = cur.b;
    PG8_STAGE(PG8_SB(0, 0), cB, voffB); PG8_STAGE(PG8_SB(0, 1), cB + hstepB, voffB); PG8_STAGE(PG8_SA(0, 0), cA, vA[0]); PG8_STAGE(PG8_SA(0, 1), cA, vA[1]);
    if (wr == 1) PG8_BAR;
    PG8_WAIT_V(2); PG8_BAR;
    PG8_STAGE(PG8_SB(1, 0), cB + kstep, voffB); PG8_STAGE(PG8_SA(1, 0), cA + kstep, vA[0]); PG8_STAGE(PG8_SB(1, 1), cB + hstepB + kstep, voffB);
    PG8_WAIT_V(6); PG8_BAR;
    for (;;) {
        const bool has_next = S.next(ui + 1, nxt);
        const char* nA = has_next ? nxt.a : cA; const char* nB = has_next ? nxt.b : cB;
        if (GATHER) {
            if (has_next) { PG8_SETVOFF(vN, nxt); } else {
#pragma unroll
                for (int h = 0; h < 2; ++h)
#pragma unroll
                    for (int i = 0; i < 2; ++i) vN[h][i] = vA[h][i]; }
            asm volatile("" :: "v"(vN[0][0]), "v"(vN[0][1]), "v"(vN[1][0]), "v"(vN[1][1]));
        }
#pragma nounroll
        for (int t = 0; t < nt; t += 2) {
            const bool last = (t == nt - 2);
            const char* a1 = cA + (size_t)(t + 1) * kstep;
            const char* a2 = last ? nA : cA + (size_t)(t + 2) * kstep; const char* b2 = last ? nB : cB + (size_t)(t + 2) * kstep;
            const char* a3 = a2 + kstep; const char* b3 = b2 + kstep;
            PG8_LDB(B0, 0, 0); PG8_LDB(B1, 0, 1); PG8_SCHED; PG8_LDA(At, 0, 0); PG8_STAGE(PG8_SA(1, 1), a1, vA[1]);
            if (GATHER && last) {
#pragma unroll
                for (int h = 0; h < 2; ++h)
#pragma unroll
                    for (int i = 0; i < 2; ++i) vA[h][i] = vN[h][i]; }
            PG8_WAIT_V(8); PG8_WAIT_L(0); PG8_BAR; PG8_MMA(0, 0, At, B0); PG8_MMA(0, 1, At, B1); PG8_BAR; PG8_SCHED;
            PG8_LDA(At, 0, 1); PG8_STAGE(PG8_SB(0, 0), b2, voffB); PG8_STAGE(PG8_SB(0, 1), b2 + hstepB, voffB); PG8_STAGE(PG8_SA(0, 0), a2, vA[0]);
            PG8_WAIT_V(8); PG8_WAIT_L(0); PG8_BAR; PG8_MMA(1, 0, At, B0); PG8_MMA(1, 1, At, B1); PG8_BAR; PG8_SCHED;
            PG8_LDB(B0, 1, 0); PG8_LDB(B1, 1, 1); PG8_SCHED; PG8_LDA(At, 1, 0); PG8_STAGE(PG8_SA(0, 1), a2, vA[1]);
            PG8_WAIT_V(8); PG8_WAIT_L(0); PG8_BAR; PG8_MMA(0, 0, At, B0); PG8_MMA(0, 1, At, B1); PG8_BAR; PG8_SCHED;
            PG8_LDA(At, 1, 1); PG8_STAGE(PG8_SB(1, 0), b3, voffB); PG8_STAGE(PG8_SB(1, 1), b3 + hstepB, voffB); PG8_STAGE(PG8_SA(1, 0), a3, vA[0]);
            PG8_WAIT_V(8); PG8_WAIT_L(0); PG8_BAR; PG8_MMA(1, 0, At, B0); PG8_MMA(1, 1, At, B1); PG8_BAR; PG8_SCHED;
        }
        if (wr == 0) PG8_BAR;
        E(acc, cur, wr, wc, fr, fq, lane);
        if (!has_next) break;
#pragma unroll
        for (int a = 0; a < 2; ++a)
#pragma unroll
            for (int b = 0; b < 2; ++b)
#pragma unroll
                for (int m = 0; m < 4; ++m)
#pragma unroll
                    for (int n = 0; n < 2; ++n) acc[a][b][m][n] = (f32x4){0.f, 0.f, 0.f, 0.f};
        cur = nxt; cA = nA; cB = nB; ++ui;
        if (wr == 1) PG8_BAR;
    }
    PG8_WAIT_V(0);
    PG8_BAR;
#undef PG8_SA
#undef PG8_SB
#undef PG8_STAGE
#undef PG8_LDA
#undef PG8_LDB
#undef PG8_MMA
#undef PG8_WAIT_V
#undef PG8_WAIT_L
#undef PG8_BAR
#undef PG8_SCHED
#undef PG8_SETVOFF
}
struct SchedDense {
    int nM, nN, G, c; const char* A; const char* B; size_t a_tile, b_tile; int pn_div; size_t a_pn_step;
    __device__ __forceinline__ bool next(int i, Unit& u) const {
        const long L = (long)i * G + c; if (L >= (long)nM * nN) return false;
        int pm, pn; tile_order((int)L, nM, nN, pm, pn);
        u.pm = pm; u.pn = pn; u.e = 0; u.rows = nullptr; u.a = A + (size_t)pm * a_tile + (size_t)(pn / pn_div) * a_pn_step; u.b = B + (size_t)pn * b_tile; return true;
    }
};
}

__device__ __forceinline__ void unpack8(const u32x4 p, f32x4& r0, f32x4& r1) {
    r0 = (f32x4){__uint_as_float(p.x << 16), __uint_as_float(p.x & 0xffff0000u), __uint_as_float(p.y << 16), __uint_as_float(p.y & 0xffff0000u)};
    r1 = (f32x4){__uint_as_float(p.z << 16), __uint_as_float(p.z & 0xffff0000u), __uint_as_float(p.w << 16), __uint_as_float(p.w & 0xffff0000u)}; }
__device__ __forceinline__ u32x4 pack8(const f32x4 v0, const f32x4 v1) { u32x4 w; w.x = cvt_pk_bf16(v0[0], v0[1]); w.y = cvt_pk_bf16(v0[2], v0[3]); w.z = cvt_pk_bf16(v1[0], v1[1]); w.w = cvt_pk_bf16(v1[2], v1[3]); return w; }

struct EpiG1 {
    bf16 *Q, *Kb, *V, *SG, *EQ, *EK; float *EREF, *ELAST, *ELR, *AF; const float* RS; const float* b_alpha;
    __device__ __forceinline__ void operator()(f32x4 (&acc)[2][2][4][2], const pg8::Unit& u, int wr, int wc, int fr, int fq, int lane) const {
        const int row0 = u.pm * 256 + wr * 64 + fr, pn = u.pn;
        if (pn < 12) {
            bf16* base; int ldc, colt; const bool act = pn >= 8;
            if (pn < 2) { base = Q; ldc = 512; colt = pn * 256; } else if (pn < 4) { base = Kb; ldc = 512; colt = (pn - 2) * 256; }
            else if (pn < 8) { base = V; ldc = 1024; colt = (pn - 4) * 256; } else { base = SG; ldc = 1024; colt = (pn - 8) * 256; }
            const int col0 = colt + wc * 32 + 8 * fq;
#pragma unroll
            for (int ai = 0; ai < 2; ++ai)
#pragma unroll
                for (int m = 0; m < 4; ++m) { const int row = row0 + ai * 128 + m * 16; const float rs = RS[row]; bf16* rowp = base + (size_t)row * ldc + col0;
#pragma unroll
                    for (int bj = 0; bj < 2; ++bj) { f32x4 v0 = acc[ai][bj][m][0] * rs, v1 = acc[ai][bj][m][1] * rs;
                        if (act) {
#pragma unroll
                            for (int j = 0; j < 4; ++j) { v0[j] = fsilu(v0[j]); v1[j] = fsilu(v1[j]); } }
                        u32x4 w; w.x = cvt_pk_bf16(v0[0], v0[1]); w.y = cvt_pk_bf16(v0[2], v0[3]); w.z = cvt_pk_bf16(v1[0], v1[1]); w.w = cvt_pk_bf16(v1[2], v1[3]);
                        *(u32x4*)(rowp + bj * 128) = w; } }
        } else {
            const int colt = (pn - 12) * 256;
#pragma unroll
            for (int ai = 0; ai < 2; ++ai) {
                const int chunk = u.pm * 4 + ai * 2 + wr; float rsv[4];
#pragma unroll
                for (int m = 0; m < 4; ++m) rsv[m] = RS[row0 + ai * 128 + m * 16];
#pragma unroll
                for (int bj = 0; bj < 2; ++bj)
#pragma unroll
                    for (int n = 0; n < 2; ++n) {
                        const int c = colt + bj * 128 + wc * 32 + 8 * fq + 4 * n;
                        const f32x4 ba = *(const f32x4*)(b_alpha + c);
                        f32x4 cum[4]; f32x4 run = (f32x4){0.f, 0.f, 0.f, 0.f};
#pragma unroll
                        for (int m = 0; m < 4; ++m) { const f32x4 z = acc[ai][bj][m][n] * rsv[m] + ba; f32x4 la;
#pragma unroll
                            for (int j = 0; j < 4; ++j) la[j] = flogsigmoid(z[j]) * 0.0625f;
                            if (AF) { f32x4 ea;
#pragma unroll
                                for (int j = 0; j < 4; ++j) ea[j] = fexp(la[j]);
                                *(f32x4*)(AF + (size_t)(row0 + ai * 128 + m * 16) * 512 + c) = ea; }
                            f32x4 tot;
#pragma unroll
                            for (int j = 0; j < 4; ++j) { float v = la[j]; v += dpp_shr<1>(v); v += dpp_shr<2>(v); v += dpp_shr<4>(v); v += dpp_shr<8>(v); la[j] = v; tot[j] = __shfl(v, lane | 15); }
                            cum[m] = la + run; run += tot; }
                        f32x4 ref;
#pragma unroll
                        for (int j = 0; j < 4; ++j) ref[j] = __shfl(cum[2][j], lane & 48);
#pragma unroll
                        for (int m = 0; m < 4; ++m) { const size_t o = (size_t)(row0 + ai * 128 + m * 16) * 512 + c; float q[4], k[4];
#pragma unroll
                            for (int j = 0; j < 4; ++j) { q[j] = QSCALE * fexp(cum[m][j] - ref[j]); k[j] = fexp(ref[j] - cum[m][j]); }
                            u32x2 wq, wk; wq.x = cvt_pk_bf16(q[0], q[1]); wq.y = cvt_pk_bf16(q[2], q[3]); wk.x = cvt_pk_bf16(k[0], k[1]); wk.y = cvt_pk_bf16(k[2], k[3]);
                            *(u32x2*)(EQ + o) = wq; *(u32x2*)(EK + o) = wk; }
                        { f32x4 er, el, elr;
#pragma unroll
                            for (int j = 0; j < 4; ++j) { er[j] = fexp(ref[j]); el[j] = fexp(run[j]); elr[j] = fexp(run[j] - ref[j]); }
                            asm volatile("" : "+v"(er), "+v"(el), "+v"(elr));
                            if (fr == 0) { *(f32x4*)(EREF + chunk * 512 + c) = er; *(f32x4*)(ELAST + chunk * 512 + c) = el; *(f32x4*)(ELR + chunk * 512 + c) = elr; } }
                    }
            }
        }
    }
};
__device__ __forceinline__ unsigned opaque_u0(unsigned v) { asm volatile("" : "+v"(v)); return v; }
struct EpiResidF {
    const float* xf; const bf16* xb; bf16* out;
    __device__ __forceinline__ void operator()(f32x4 (&acc)[2][2][4][2], const pg8::Unit& u, int wr, int wc, int fr, int fq, int lane) const {
        const size_t uo = (size_t)u.pm * 256 * 1024 + u.pn * 256;
        const char* xfb = (const char*)(xf + uo); const char* xbb = (const char*)(xb + uo); char* ob = (char*)(out + uo);
        const unsigned lo = opaque_u0((unsigned)((wr * 64 + fr) * 1024 + wc * 32 + 8 * fq) * 2u);
#pragma unroll
        for (int ai = 0; ai < 2; ++ai)
#pragma unroll
            for (int m = 0; m < 4; ++m)
#pragma unroll
                for (int bj = 0; bj < 2; ++bj) { const unsigned o = lo + (unsigned)((ai * 128 + m * 16) * 1024 + bj * 128) * 2u; f32x4 r0, r1;
                    if (xf) { r0 = *(const f32x4*)(xfb + 2u * o); r1 = *(const f32x4*)(xfb + (2u * o + 16u)); }
                    else unpack8(*(const u32x4*)(xbb + o), r0, r1);
                    *(u32x4*)(ob + o) = pack8(acc[ai][bj][m][0] + r0, acc[ai][bj][m][1] + r1); }
    }
};

__device__ __forceinline__ void cvt_item(const float* W, int ldn, int scol0, const float* kscale, bf16* dst, int dstK, int drow0, int kb, int nb, LAS float* scr, int lane, int kmask = 0x7fffffff) {
    const int k0 = 64 * kb, n0 = 32 * nb;
#pragma unroll 8
    for (int i = 0; i < 32; ++i) { const int kk = 2 * i + (lane >> 5); float v = W[(size_t)(k0 + kk) * ldn + scol0 + n0 + (lane & 31)]; if (kscale) v *= kscale[(k0 + kk) & kmask]; scr[kk * 33 + (lane & 31)] = v; }
    asm volatile("s_waitcnt lgkmcnt(0)" ::: "memory");
    const int c = lane & 7;
#pragma unroll
    for (int j = 0; j < 4; ++j) { const int n = (lane >> 3) + 8 * j; const LAS float* s = scr + (8 * c) * 33 + n;
        u32x4 o; o.x = cvt_pk_bf16(s[0 * 33], s[1 * 33]); o.y = cvt_pk_bf16(s[2 * 33], s[3 * 33]); o.z = cvt_pk_bf16(s[4 * 33], s[5 * 33]); o.w = cvt_pk_bf16(s[6 * 33], s[7 * 33]);
        *(u32x4*)(dst + (size_t)(drow0 + n0 + n) * dstK + k0 + 8 * c) = o; }
    asm volatile("s_waitcnt lgkmcnt(0)" ::: "memory");
}
__device__ __forceinline__ void cvt_item_la(const float* Win, const float* wal, const float* kscale, bf16* dst, int kb, int nb, LAS float* scr, int lane) {
    const int k0 = 64 * kb, n0 = 32 * nb; float wa[16];
#pragma unroll
    for (int r = 0; r < 16; ++r) wa[r] = wal[r * 512 + n0 + (lane & 31)];
#pragma unroll 4
    for (int i = 0; i < 32; ++i) { const int kk = 2 * i + (lane >> 5); const float* lr = Win + (size_t)(k0 + kk) * 3088 + 3072; float v = 0.f;
#pragma unroll
        for (int r = 0; r < 16; ++r) v += lr[r] * wa[r];
        scr[kk * 33 + (lane & 31)] = v * kscale[k0 + kk]; }
    asm volatile("s_waitcnt lgkmcnt(0)" ::: "memory");
    const int c = lane & 7;
#pragma unroll
    for (int j = 0; j < 4; ++j) { const int n = (lane >> 3) + 8 * j; const LAS float* s = scr + (8 * c) * 33 + n;
        u32x4 o; o.x = cvt_pk_bf16(s[0 * 33], s[1 * 33]); o.y = cvt_pk_bf16(s[2 * 33], s[3 * 33]); o.z = cvt_pk_bf16(s[4 * 33], s[5 * 33]); o.w = cvt_pk_bf16(s[6 * 33], s[7 * 33]);
        *(u32x4*)(dst + (size_t)(3072 + n0 + n) * 1024 + k0 + 8 * c) = o; }
    asm volatile("s_waitcnt lgkmcnt(0)" ::: "memory");
}


constexpr int CAP = 32768;
constexpr size_t WS_LIST = 5 * MiB, WS_LW = 9 * MiB, WS_POS = 13 * MiB;
constexpr size_t WS_AGG = 13 * MiB + 512 * 1024;
constexpr size_t WS_CARRY = 5 * MiB;
constexpr int CW_CNT = 16384;
constexpr int TS_OFF = 256;

namespace pg8 {
struct SchedMoe {
    const LAS int* ts; int G, c, npn; const char* A; const char* B; const int* LIST; size_t b_exp, b_pn, a_tile; bool gather;
    __device__ __forceinline__ bool next(int i, Unit& u) const {
        const int NT = __builtin_amdgcn_readfirstlane(ts[32]); const long L = (long)i * G + c; if (L >= (long)NT * npn) return false;
        const int tg = (int)(L / npn), pn = (int)(L % npn);
        const int e = __builtin_amdgcn_readfirstlane(ts[64 + tg]);
        const int tile = tg - __builtin_amdgcn_readfirstlane(ts[e]);
        u.pm = tg; u.pn = pn; u.e = e; u.rows = LIST + (size_t)e * CAP + tile * 256; u.a = gather ? A : A + (size_t)tg * a_tile; u.b = B + (size_t)e * b_exp + (size_t)pn * b_pn; return true;
    }
};
}
__device__ __forceinline__ unsigned opaque_u(unsigned v) { asm volatile("" : "+v"(v)); return v; }
struct EpiM1 {
    bf16* ACT; const int* LIST; const float* LW; const float* RS;
    __device__ __forceinline__ void operator()(f32x4 (&acc)[2][2][4][2], const pg8::Unit& u, int wr, int wc, int fr, int fq, int lane) const {
        const char* rowsb = (const char*)u.rows; const char* lwb = (const char*)(LW + (u.rows - LIST)); const char* rsb = (const char*)RS;
        char* ob = (char*)(ACT + (size_t)u.pm * 256 * 256 + u.pn * 128);
        const unsigned r4 = opaque_u((unsigned)(wr * 64 + fr) * 4u), lo = opaque_u((unsigned)((wr * 64 + fr) * 256 + wc * 32 + 8 * fq) * 2u);
#pragma unroll
        for (int ai = 0; ai < 2; ++ai)
#pragma unroll
            for (int m = 0; m < 4; ++m) { const unsigned ro = r4 + (unsigned)(ai * 128 + m * 16) * 4u;
                unsigned tk = *(const unsigned*)(rowsb + ro); tk = tk < (unsigned)T ? tk : 0u;
                const float rs = *(const float*)(rsb + tk * 4u), w = *(const float*)(lwb + ro); f32x4 o[2];
#pragma unroll
                for (int n = 0; n < 2; ++n) { const f32x4 g = acc[ai][0][m][n] * rs, up = acc[ai][1][m][n] * rs;
#pragma unroll
                    for (int j = 0; j < 4; ++j) o[n][j] = fsilu(g[j]) * up[j] * w; }
                *(u32x4*)(ob + (lo + (unsigned)(ai * 128 + m * 16) * 512u)) = pack8(o[0], o[1]); }
    }
};
struct EpiStore {
    bf16* O; int ldc; int pad;
    __device__ __forceinline__ void operator()(f32x4 (&acc)[2][2][4][2], const pg8::Unit& u, int wr, int wc, int fr, int fq, int lane) const {
        char* ob = (char*)(O + (size_t)u.pm * 256 * 1024 + u.pn * 256);
        const unsigned lo = opaque_u((unsigned)((wr * 64 + fr) * 1024 + wc * 32 + 8 * fq) * 2u);
#pragma unroll
        for (int ai = 0; ai < 2; ++ai)
#pragma unroll
            for (int m = 0; m < 4; ++m)
#pragma unroll
                for (int bj = 0; bj < 2; ++bj) *(u32x4*)(ob + (lo + (unsigned)((ai * 128 + m * 16) * 1024 + bj * 128) * 2u)) = pack8(acc[ai][bj][m][0], acc[ai][bj][m][1]);
    }
};
struct EpiL1 {
    bf16 *XBR, *GATE; const float* RS;
    __device__ __forceinline__ void operator()(f32x4 (&acc)[2][2][4][2], const pg8::Unit& u, int wr, int wc, int fr, int fq, int lane) const {
        const bool act = u.pn >= 4; char* ob = (char*)((act ? GATE : XBR) + (size_t)u.pm * 256 * 1024 + (u.pn & 3) * 256); const char* rsb = (const char*)(RS + u.pm * 256);
        const unsigned r4 = opaque_u((unsigned)(wr * 64 + fr) * 4u), lo = opaque_u((unsigned)((wr * 64 + fr) * 1024 + wc * 32 + 8 * fq) * 2u);
#pragma unroll
        for (int ai = 0; ai < 2; ++ai)
#pragma unroll
            for (int m = 0; m < 4; ++m) { const float rs = *(const float*)(rsb + (r4 + (unsigned)(ai * 128 + m * 16) * 4u));
#pragma unroll
                for (int bj = 0; bj < 2; ++bj) { f32x4 v0 = acc[ai][bj][m][0] * rs, v1 = acc[ai][bj][m][1] * rs;
                    if (act) {
#pragma unroll
                        for (int j = 0; j < 4; ++j) { v0[j] = fgelu_tanh(v0[j]); v1[j] = fgelu_tanh(v1[j]); } }
                    *(u32x4*)(ob + (lo + (unsigned)((ai * 128 + m * 16) * 1024 + bj * 128) * 2u)) = pack8(v0, v1); } }
    }
};
struct EpiL2 {
    const bf16* XC; bf16 *LOGA, *XN; const float *br, *bi, *SP;
    __device__ __forceinline__ void operator()(f32x4 (&acc)[2][2][4][2], const pg8::Unit& u, int wr, int wc, int fr, int fq, int lane) const {
        const int cu = (u.pn >> 1) * 256 + (u.pn & 1) * 128; const size_t uo = (size_t)u.pm * 256 * 1024 + cu;
        const char* xcb = (const char*)(XC + uo); char* lab = (char*)(LOGA + uo); char* xnb = (char*)(XN + uo);
        const unsigned cl = opaque_u((unsigned)(wc * 32 + 8 * fq) * 4u), lo = opaque_u((unsigned)((wr * 64 + fr) * 1024 + wc * 32 + 8 * fq) * 2u);
        f32x4 vbr[2], vbi[2], vsp[2];
#pragma unroll
        for (int n = 0; n < 2; ++n) { vbr[n] = *(const f32x4*)((const char*)(br + cu) + (cl + 16u * n)); vbi[n] = *(const f32x4*)((const char*)(bi + cu) + (cl + 16u * n)); vsp[n] = *(const f32x4*)((const char*)(SP + cu) + (cl + 16u * n)); }
#pragma unroll
        for (int ai = 0; ai < 2; ++ai)
#pragma unroll
            for (int m = 0; m < 4; ++m) { const unsigned o = lo + (unsigned)((ai * 128 + m * 16) * 1024) * 2u;
                f32x4 xc[2]; unpack8(*(const u32x4*)(xcb + o), xc[0], xc[1]); f32x4 la[2], xn[2];
#pragma unroll
                for (int n = 0; n < 2; ++n)
#pragma unroll
                    for (int j = 0; j < 4; ++j) { const float r = fsigmoid(acc[ai][0][m][n][j] + vbr[n][j]), ig = fsigmoid(acc[ai][1][m][n][j] + vbi[n][j]);
                        const float l = -8.f * r * vsp[n][j]; la[n][j] = l; xn[n][j] = xc[n][j] * ig * sqrtf(fmaxf(1.f - fexp(2.f * l), 0.f)); }
                *(u32x4*)(lab + o) = pack8(la[0], la[1]); *(u32x4*)(xnb + o) = pack8(xn[0], xn[1]); }
    }
};

__device__ __forceinline__ void build_ts(unsigned* CNT, LAS int* ts, int tid) {
    __syncthreads();
    if (tid < 32) ts[400 + tid] = (int)((xb_ld(CNT + tid) + 255u) >> 8);
    __syncthreads();
    if (tid == 0) { int a = 0; for (int e = 0; e < 32; ++e) { ts[e] = a; a += ts[400 + e]; } ts[32] = a; }
    __syncthreads();
    if (tid < 32) { const int b = ts[tid], n = ts[tid + 1] - b; for (int k = 0; k < n; ++k) ts[64 + b + k] = tid; }
    __syncthreads();
}
__device__ __forceinline__ void router_phase(LAS unsigned char* lds, const bf16* X, const bf16* WRl, float* RS, unsigned* CNT, int* LIST, float* LW, int* POS, int bx, int G, int tid, int lane, int wave) {
    LAS float* lg = (LAS float*)lds + wave * (16 * 48);
    LAS float* rsl = (LAS float*)(lds + 24576) + wave * 16;
    LAS unsigned* cnt_l = (LAS unsigned*)(lds + 25600); LAS unsigned* base_l = cnt_l + 32;
    const int fr = lane & 15, fq = lane >> 4;
    for (int grp = bx; grp < T / 128; grp += G) {
        if (tid < 32) cnt_l[tid] = 0u;
        __syncthreads();
        const int t0 = grp * 128 + wave * 16;
        f32x4 a0 = (f32x4){0.f, 0.f, 0.f, 0.f}, a1 = a0, a2 = a0; float ss = 0.f;
        const bf16* xa = X + (size_t)(t0 + fr) * D + 8 * fq; const bf16* wb = WRl + (size_t)fr * D + 8 * fq;
#pragma unroll 4
        for (int s = 0; s < 32; ++s) {
            const bf16x8 a = *(const bf16x8*)(xa + 32 * s), b0 = *(const bf16x8*)(wb + 32 * s), b1 = *(const bf16x8*)(wb + 16 * D + 32 * s), b2 = *(const bf16x8*)(wb + 32 * D + 32 * s);
#pragma unroll
            for (int j = 0; j < 8; ++j) { const float v = bf2f((bf16)a[j]); ss += v * v; }
            a0 = __builtin_amdgcn_mfma_f32_16x16x32_bf16(a, b0, a0, 0, 0, 0); a1 = __builtin_amdgcn_mfma_f32_16x16x32_bf16(a, b1, a1, 0, 0, 0); a2 = __builtin_amdgcn_mfma_f32_16x16x32_bf16(a, b2, a2, 0, 0, 0);
        }
        ss += __shfl_xor(ss, 16); ss += __shfl_xor(ss, 32);
        const float rstd = rsqrtf(ss * (1.f / D) + EPS);
        if (fq == 0) { rsl[fr] = rstd; RS[t0 + fr] = rstd; }
#pragma unroll
        for (int r = 0; r < 4; ++r) { lg[(4 * fq + r) * 48 + fr] = a0[r]; lg[(4 * fq + r) * 48 + 16 + fr] = a1[r]; lg[(4 * fq + r) * 48 + 32 + fr] = a2[r]; }
        asm volatile("s_waitcnt lgkmcnt(0)" ::: "memory");
        int e0g = 0, e1g = 0; float w0 = 0.f, w1 = 0.f; unsigned rk0 = 0u, rk1 = 0u;
        if (lane < 16) {
            const LAS float* l = lg + lane * 48; const float rs = rsl[lane];
            int g = 0; float gm = l[0] * rs;
            for (int i = 1; i < 4; ++i) { const float v = l[i] * rs; if (v > gm) { gm = v; g = i; } }
            float gs = 0.f; for (int i = 0; i < 4; ++i) gs += fexp(l[i] * rs - gm);
            const float pg = 1.f / gs;
            const LAS float* el = l + 4 + g * 8; int e0 = 0; float m0 = el[0] * rs;
            for (int i = 1; i < 8; ++i) { const float v = el[i] * rs; if (v > m0) { m0 = v; e0 = i; } }
            int e1 = 0; float m1 = -3.0e38f;
            for (int i = 0; i < 8; ++i) { const float v = el[i] * rs; if (i != e0 && v > m1) { m1 = v; e1 = i; } }
            const float p1 = fexp(m1 - m0), den = 1.f / (1.f + p1);
            e0g = g * 8 + e0; e1g = g * 8 + e1; w0 = pg * den; w1 = pg * p1 * den;
            rk0 = __hip_atomic_fetch_add(cnt_l + e0g, 1u, __ATOMIC_RELAXED, __HIP_MEMORY_SCOPE_WORKGROUP);
            rk1 = __hip_atomic_fetch_add(cnt_l + e1g, 1u, __ATOMIC_RELAXED, __HIP_MEMORY_SCOPE_WORKGROUP);
        }
        __syncthreads();
        if (tid < 32) base_l[tid] = xb_add(CNT + tid, cnt_l[tid]);
        __syncthreads();
        if (lane < 16) { const int tok = t0 + lane; const int s0 = e0g * CAP + (int)(base_l[e0g] + rk0), s1 = e1g * CAP + (int)(base_l[e1g] + rk1);
            LIST[s0] = tok; LW[s0] = w0; LIST[s1] = tok; LW[s1] = w1; POS[2 * tok] = s0; POS[2 * tok + 1] = s1; }
        __syncthreads();
    }
}
__device__ __forceinline__ void combine_phase(const LAS int* ts, const bf16* X, const bf16* Y, const int* POS, bf16* Xn, float* RSn, const float* fw, float* out, int bx, int G, int lane, int wave) {
    for (int t = bx * NWAVES + wave; t < T; t += G * NWAVES) {
        const int p0 = POS[2 * t], p1 = POS[2 * t + 1];
        const size_t r0 = (size_t)ts[p0 >> 15] * 256 + (p0 & (CAP - 1)), r1 = (size_t)ts[p1 >> 15] * 256 + (p1 & (CAP - 1));
        f32x4 v[4]; float ss = 0.f;
#pragma unroll
        for (int h = 0; h < 2; ++h) { f32x4 x0, x1, y0, y1, z0, z1; const int c = h * 512 + lane * 8;
            unpack8(*(const u32x4*)(X + (size_t)t * D + c), x0, x1); unpack8(*(const u32x4*)(Y + r0 * D + c), y0, y1); unpack8(*(const u32x4*)(Y + r1 * D + c), z0, z1);
            v[2 * h] = x0 + y0 + z0; v[2 * h + 1] = x1 + y1 + z1;
#pragma unroll
            for (int j = 0; j < 4; ++j) ss += v[2 * h][j] * v[2 * h][j] + v[2 * h + 1][j] * v[2 * h + 1][j]; }
        ss = wave_sum(ss); const float rstd = rsqrtf(ss * (1.f / D) + EPS);
        if (out) {
#pragma unroll
            for (int h = 0; h < 2; ++h) { const int c = h * 512 + lane * 8; const f32x4 f0 = *(const f32x4*)(fw + c), f1 = *(const f32x4*)(fw + c + 4);
                *(f32x4*)(out + (size_t)t * D + c) = v[2 * h] * rstd * f0; *(f32x4*)(out + (size_t)t * D + c + 4) = v[2 * h + 1] * rstd * f1; }
        } else {
#pragma unroll
            for (int h = 0; h < 2; ++h) *(u32x4*)(Xn + (size_t)t * D + h * 512 + lane * 8) = pack8(v[2 * h], v[2 * h + 1]);
            if (lane == 0) RSn[t] = rstd;
        }
    }
}
__device__ __forceinline__ void conv_phase(const bf16* XBR, const float* cw, const float* cb, bf16* XC, int bx, int G, int tid) {
    for (int item = bx * NTHR + tid; item < (T / 32) * 128; item += G * NTHR) {
        const int cg = item & 127, run = item >> 7, c = cg * 8, t0 = run * 32;
        f32x4 w[4][2], b[2];
#pragma unroll
        for (int k = 0; k < 4; ++k) { w[k][0] = *(const f32x4*)(cw + k * D + c); w[k][1] = *(const f32x4*)(cw + k * D + c + 4); }
        b[0] = *(const f32x4*)(cb + c); b[1] = *(const f32x4*)(cb + c + 4);
        f32x4 h0[2], h1[2], h2[2];
        const bool first = (t0 & (SEQ - 1)) == 0;
        if (first) { h0[0] = h0[1] = h1[0] = h1[1] = h2[0] = h2[1] = (f32x4){0.f, 0.f, 0.f, 0.f}; }
        else { unpack8(*(const u32x4*)(XBR + (size_t)(t0 - 3) * D + c), h0[0], h0[1]); unpack8(*(const u32x4*)(XBR + (size_t)(t0 - 2) * D + c), h1[0], h1[1]); unpack8(*(const u32x4*)(XBR + (size_t)(t0 - 1) * D + c), h2[0], h2[1]); }
#pragma unroll 4
        for (int i = 0; i < 32; ++i) { f32x4 x[2]; unpack8(*(const u32x4*)(XBR + (size_t)(t0 + i) * D + c), x[0], x[1]); f32x4 o[2];
#pragma unroll
            for (int q = 0; q < 2; ++q) { o[q] = b[q] + w[0][q] * h0[q] + w[1][q] * h1[q] + w[2][q] * h2[q] + w[3][q] * x[q]; h0[q] = h1[q]; h1[q] = h2[q]; h2[q] = x[q]; }
            *(u32x4*)(XC + (size_t)(t0 + i) * D + c) = pack8(o[0], o[1]); }
    }
}
__device__ __forceinline__ void scan_a_phase(LAS unsigned char* lds, const bf16* LOGA, const bf16* XN, float* AGG, float* CARRY, int bx, int G, int tid) {
    LAS float* sA = (LAS float*)lds; LAS float* sH = sA + 64 * 64;
    for (int item = bx; item < 256; item += G) {
        const int b = item >> 5, slab = (item >> 1) & 15, half = item & 1, seg = tid >> 3, cg = tid & 7, c = slab * 64 + cg * 8;
        const size_t row0 = (size_t)b * SEQ + half * 2048 + seg * 32;
        f32x4 A[2], H[2]; A[0] = A[1] = (f32x4){0.f, 0.f, 0.f, 0.f}; H[0] = H[1] = A[0];
#pragma unroll 4
        for (int i = 0; i < 32; ++i) { f32x4 la[2], xn[2]; unpack8(*(const u32x4*)(LOGA + (row0 + i) * D + c), la[0], la[1]); unpack8(*(const u32x4*)(XN + (row0 + i) * D + c), xn[0], xn[1]);
#pragma unroll
            for (int q = 0; q < 2; ++q) { A[q] += la[q];
#pragma unroll
                for (int j = 0; j < 4; ++j) H[q][j] = fexp(la[q][j]) * H[q][j] + xn[q][j]; } }
        __syncthreads();
#pragma unroll
        for (int q = 0; q < 2; ++q) { *(LAS f32x4*)(sA + seg * 64 + cg * 8 + 4 * q) = A[q]; *(LAS f32x4*)(sH + seg * 64 + cg * 8 + 4 * q) = H[q]; }
        __syncthreads();
        if (tid < 64) { float pl = 0.f, h = 0.f; float* cr = CARRY + (size_t)item * 64 * 128;
            for (int sgi = 0; sgi < 64; ++sgi) { cr[sgi * 128 + tid] = pl; cr[sgi * 128 + 64 + tid] = h; const float a = sA[sgi * 64 + tid]; h = fexp(a) * h + sH[sgi * 64 + tid]; pl += a; }
            AGG[item * 128 + tid] = pl; AGG[item * 128 + 64 + tid] = h; }
    }
}
__device__ __forceinline__ void scan_c_phase(const bf16* LOGA, const bf16* XN, const bf16* GATE, const float* AGG, const float* CARRY, bf16* YL, int bx, int G, int tid) {
    for (int item = bx; item < 256; item += G) {
        const int b = item >> 5, slab = (item >> 1) & 15, half = item & 1, seg = tid >> 3, cg = tid & 7, c = slab * 64 + cg * 8;
        const size_t row0 = (size_t)b * SEQ + half * 2048 + seg * 32;
        const float* cr = CARRY + (size_t)item * 64 * 128 + seg * 128 + cg * 8;
        f32x4 h[2];
#pragma unroll
        for (int q = 0; q < 2; ++q) { const f32x4 pl = *(const f32x4*)(cr + 4 * q), hl = *(const f32x4*)(cr + 64 + 4 * q);
            f32x4 hw = (f32x4){0.f, 0.f, 0.f, 0.f}; if (half) hw = *(const f32x4*)(AGG + (item - 1) * 128 + 64 + cg * 8 + 4 * q);
#pragma unroll
            for (int j = 0; j < 4; ++j) h[q][j] = hl[j] + fexp(pl[j]) * hw[j]; }
#pragma unroll 4
        for (int i = 0; i < 32; ++i) { f32x4 la[2], xn[2], g[2], y[2]; const size_t o = (row0 + i) * D + c;
            unpack8(*(const u32x4*)(LOGA + o), la[0], la[1]); unpack8(*(const u32x4*)(XN + o), xn[0], xn[1]); unpack8(*(const u32x4*)(GATE + o), g[0], g[1]);
#pragma unroll
            for (int q = 0; q < 2; ++q)
#pragma unroll
                for (int j = 0; j < 4; ++j) { h[q][j] = fexp(la[q][j]) * h[q][j] + xn[q][j]; y[q][j] = h[q][j] * g[q][j]; }
            *(u32x4*)(YL + o) = pack8(y[0], y[1]); }
    }
}


__device__ __forceinline__ void gla_core_ref_phase(LAS unsigned char* lds, const bf16* Q, const bf16* Kb, const bf16* V, const bf16* SG, const float* AF, const float* hn, bf16* OG, int bx, int G, int tid) {
    LAS float* part = (LAS float*)lds;
    LAS float* red = part + 512;
    const int e = tid & 255, hf = tid >> 8, lane = tid & 63, w4 = (tid >> 6) & 3;
    for (int bh = bx; bh < 32; bh += G) {
        const int b = bh >> 2, h = bh & 3;
        float S[64];
#pragma unroll
        for (int d = 0; d < 64; ++d) S[d] = 0.f;
        const float hw = hn[e];
        for (int t = 0; t < SEQ; ++t) {
            const size_t row = (size_t)b * SEQ + t;
            const float v = bf2f(V[row * 1024 + h * 256 + e]);
            const float* a = AF + row * 512 + h * 128 + hf * 64; const bf16* k = Kb + row * 512 + h * 128 + hf * 64; const bf16* q = Q + row * 512 + h * 128 + hf * 64;
            float o = 0.f;
#pragma unroll
            for (int d = 0; d < 64; ++d) { S[d] = a[d] * S[d] + bf2f(k[d]) * v; o += bf2f(q[d]) * S[d]; }
            part[hf * 256 + e] = o;
            __syncthreads();
            o = (part[e] + part[256 + e]) * QSCALE;
            float ss = wave_sum(o * o);
            if (hf == 0 && lane == 0) red[w4] = ss;
            __syncthreads();
            ss = red[0] + red[1] + red[2] + red[3];
            const float rstd = rsqrtf(ss * (1.f / 256.f) + EPS);
            if (hf == 0) OG[row * 1024 + h * 256 + e] = f2bf(o * rstd * hw * bf2f(SG[row * 1024 + h * 256 + e]));
        }
        __syncthreads();
    }
}


typedef float f32x16 __attribute__((ext_vector_type(16)));
typedef short s16x4 __attribute__((ext_vector_type(4)));
typedef short v4i16_t __attribute__((ext_vector_type(4)));
typedef __bf16 bf16x2_t __attribute__((ext_vector_type(2)));
__device__ __forceinline__ unsigned cvtpk2(float lo, float hi) { f32x2 v = {lo, hi}; bf16x2_t b = __builtin_convertvector(v, bf16x2_t); return __builtin_bit_cast(unsigned, b); }
__device__ __forceinline__ s16x4 vtr(const LAS unsigned char* p) { return __builtin_bit_cast(s16x4, __builtin_amdgcn_ds_read_tr16_b64_v4i16((LAS v4i16_t*)p)); }
__device__ __forceinline__ bf16x8 tr_frag(const LAS unsigned char* a, int P) { const s16x4 lo = vtr(a), hi = vtr(a + 4 * P); return __builtin_shufflevector(lo, hi, 0, 1, 2, 3, 4, 5, 6, 7); }
__device__ __forceinline__ int crow(int r, int hh) { return (r & 3) + 8 * (r >> 2) + 4 * hh; }
#define MFMA32(a, b, c) __builtin_amdgcn_mfma_f32_32x32x16_bf16((a), (b), (c), 0, 0, 0)
#define CORE_BAR() asm volatile("s_waitcnt lgkmcnt(0)\n\ts_barrier" ::: "memory")

__device__ __forceinline__ void gla_core_phase(LAS unsigned char* lds, const bf16* Q, const bf16* Kb, const bf16* V, const bf16* SG, const bf16* EQ, const bf16* EK,
                                               const float* EREF, const float* ELAST, const float* ELR, bf16* OG, int bx, int G, int wave) {
    constexpr int TP = 272, VP = 80, PP = 144;
    constexpr int O_QP = 0, O_KP = 17408, O_QC = 34816, O_KST = 52224, O_V = 69632, O_P = 110592, O_PART = 119808, O_VEC = 121856;
    const int lane = lane_id_v(), tid = wave * 64 + lane, hh = lane >> 5, l31 = lane & 31;
    const int ptok = tid >> 3, pdp = tid & 7;
    LAS unsigned char* vsl = lds + O_V + wave * (64 * VP);
    const int troff = (8 * hh + ((lane & 15) >> 2)) * 1 ;
    const int trcol = 32 * ((lane >> 4) & 1) + 8 * (lane & 3);
    LAS float* part = (LAS float*)(lds + O_PART);
    for (int bh = bx; bh < 32; bh += G) {
        const int b = bh >> 2, h = bh & 3;
        const size_t seq0 = (size_t)b * SEQ;
        f32x16 S[4];
#pragma unroll
        for (int dt = 0; dt < 4; ++dt)
#pragma unroll
            for (int r = 0; r < 16; ++r) S[dt][r] = 0.f;
        u32x4 pq[2], pk[2], peq[2], pek[2], pv[4]; float ve[3] = {0.f, 0.f, 0.f};
#define CORE_LOAD(cc) do { const size_t rr = seq0 + (size_t)(cc) * 64; \
            { const size_t o = (rr + ptok) * 512 + h * 128 + pdp * 16; \
              pq[0] = *(const u32x4*)(Q + o); pq[1] = *(const u32x4*)(Q + o + 8); pk[0] = *(const u32x4*)(Kb + o); pk[1] = *(const u32x4*)(Kb + o + 8); \
              peq[0] = *(const u32x4*)(EQ + o); peq[1] = *(const u32x4*)(EQ + o + 8); pek[0] = *(const u32x4*)(EK + o); pek[1] = *(const u32x4*)(EK + o + 8); } \
            { const bf16* vp = V + (rr + lane) * 1024 + h * 256 + wave * 32; pv[0] = *(const u32x4*)vp; pv[1] = *(const u32x4*)(vp + 8); pv[2] = *(const u32x4*)(vp + 16); pv[3] = *(const u32x4*)(vp + 24); } \
            if (tid < 128) { const size_t vo = (rr >> 6) * 512 + h * 128 + tid; ve[0] = EREF[vo]; ve[1] = ELR[vo]; ve[2] = ELAST[vo]; } } while (0)
#define CORE_VEC(par) do { if (tid < 128) { LAS float* vv = (LAS float*)(lds + O_VEC) + (par) * 384; vv[tid] = ve[0]; vv[128 + tid] = ve[1]; vv[256 + tid] = ve[2]; } } while (0)
#define CORE_PREP(par) do { const LAS float* vv = (const LAS float*)(lds + O_VEC) + (par) * 384 + pdp * 16; \
            _Pragma("unroll") for (int q2 = 0; q2 < 2; ++q2) { f32x4 q0, q1, e0, e1, k0, k1, g0, g1; unpack8(pq[q2], q0, q1); unpack8(peq[q2], e0, e1); unpack8(pk[q2], k0, k1); unpack8(pek[q2], g0, g1); \
                const f32x4 er0 = *(const LAS f32x4*)(vv + q2 * 8), er1 = *(const LAS f32x4*)(vv + q2 * 8 + 4), lr0 = *(const LAS f32x4*)(vv + 128 + q2 * 8), lr1 = *(const LAS f32x4*)(vv + 128 + q2 * 8 + 4); \
                q0 = q0 * e0; q1 = q1 * e1; k0 = k0 * g0; k1 = k1 * g1; \
                const int lo_ = ptok * TP + (pdp * 16 + q2 * 8) * 2; \
                *(LAS u32x4*)(lds + O_QP + lo_) = pack8(q0, q1); *(LAS u32x4*)(lds + O_KP + lo_) = pack8(k0, k1); \
                *(LAS u32x4*)(lds + O_QC + lo_) = pack8(q0 * er0, q1 * er1); *(LAS u32x4*)(lds + O_KST + lo_) = pack8(k0 * lr0, k1 * lr1); } \
            _Pragma("unroll") for (int i_ = 0; i_ < 4; ++i_) *(LAS u32x4*)(vsl + lane * VP + i_ * 16) = pv[i_]; } while (0)
        CORE_LOAD(0); CORE_VEC(0);
        CORE_BAR();
        CORE_PREP(0);
        CORE_BAR();
        for (int c = 0; c < 64; ++c) {
            const int par = c & 1; const size_t row0 = seq0 + (size_t)c * 64;
            u32x2 psg[8];
#pragma unroll
            for (int it = 0; it < 2; ++it)
#pragma unroll
                for (int g = 0; g < 4; ++g) psg[it * 4 + g] = *(const u32x2*)(SG + (row0 + 32 * it + l31) * 1024 + h * 256 + wave * 32 + 8 * g + 4 * hh);
            CORE_LOAD(c < 63 ? c + 1 : 63);
            if (wave < 3) { const int jt = wave == 2 ? 1 : 0, it = wave >= 1 ? 1 : 0; f32x16 p;
#pragma unroll
                for (int r = 0; r < 16; ++r) p[r] = 0.f;
#pragma unroll
                for (int ks = 0; ks < 8; ++ks) { const bf16x8 a = *(const LAS bf16x8*)(lds + O_KP + (32 * jt + l31) * TP + (16 * ks + 8 * hh) * 2), bq = *(const LAS bf16x8*)(lds + O_QP + (32 * it + l31) * TP + (16 * ks + 8 * hh) * 2);
                    p = MFMA32(a, bq, p); }
                if (jt == it) {
#pragma unroll
                    for (int r = 0; r < 16; ++r) p[r] = crow(r, hh) <= l31 ? p[r] : 0.f; }
#pragma unroll
                for (int g = 0; g < 4; ++g) { u32x2 w; w.x = cvtpk2(p[4 * g], p[4 * g + 1]); w.y = cvtpk2(p[4 * g + 2], p[4 * g + 3]);
                    *(LAS u32x2*)(lds + O_P + (32 * it + l31) * PP + (32 * jt + 8 * g + 4 * hh) * 2) = w; }
            }
            f32x16 o[2];
#pragma unroll
            for (int it = 0; it < 2; ++it)
#pragma unroll
                for (int r = 0; r < 16; ++r) o[it][r] = 0.f;
#pragma unroll
            for (int ks = 0; ks < 8; ++ks) { const int dt = ks >> 1, s2 = ks & 1; u32x4 ap;
                ap.x = cvtpk2(S[dt][8 * s2 + 0], S[dt][8 * s2 + 1]); ap.y = cvtpk2(S[dt][8 * s2 + 2], S[dt][8 * s2 + 3]); ap.z = cvtpk2(S[dt][8 * s2 + 4], S[dt][8 * s2 + 5]); ap.w = cvtpk2(S[dt][8 * s2 + 6], S[dt][8 * s2 + 7]);
                const bf16x8 a = __builtin_bit_cast(bf16x8, ap);
#pragma unroll
                for (int it = 0; it < 2; ++it) { const LAS unsigned char* qa = lds + O_QC + (32 * it + l31) * TP + (32 * dt + 16 * s2 + 4 * hh) * 2;
                    const s16x4 lo = *(const LAS s16x4*)qa, hi = *(const LAS s16x4*)(qa + 16);
                    o[it] = MFMA32(a, __builtin_shufflevector(lo, hi, 0, 1, 2, 3, 4, 5, 6, 7), o[it]); } }
            CORE_BAR();
            bf16x8 vf[4];
#pragma unroll
            for (int s4 = 0; s4 < 4; ++s4) vf[s4] = tr_frag(vsl + (16 * s4 + troff) * VP + trcol, VP);
#pragma unroll
            for (int it = 0; it < 2; ++it)
#pragma unroll
                for (int s4 = 0; s4 < 4; ++s4) { if (it == 0 && s4 >= 2) continue;
                    const bf16x8 pb = *(const LAS bf16x8*)(lds + O_P + (32 * it + l31) * PP + (16 * s4 + 8 * hh) * 2);
                    o[it] = MFMA32(vf[s4], pb, o[it]); }
#pragma unroll
            for (int it = 0; it < 2; ++it) { float ss = 0.f;
#pragma unroll
                for (int r = 0; r < 16; ++r) ss += o[it][r] * o[it][r];
                ss += __shfl_xor(ss, 32);
                if (hh == 0) part[wave * 64 + 32 * it + l31] = ss; }
            { const LAS float* el = (const LAS float*)(lds + O_VEC) + par * 384 + 256;
#pragma unroll
              for (int dt = 0; dt < 4; ++dt)
#pragma unroll
                for (int g = 0; g < 4; ++g) { const f32x4 e4 = *(const LAS f32x4*)(el + 32 * dt + 8 * g + 4 * hh);
#pragma unroll
                    for (int j = 0; j < 4; ++j) S[dt][4 * g + j] *= e4[j]; }
#pragma unroll
              for (int dt = 0; dt < 4; ++dt)
#pragma unroll
                for (int s4 = 0; s4 < 4; ++s4) S[dt] = MFMA32(tr_frag(lds + O_KST + (16 * s4 + troff) * TP + 64 * dt + trcol, TP), vf[s4], S[dt]); }
            CORE_VEC(par ^ 1);
            CORE_BAR();
#pragma unroll
            for (int it = 0; it < 2; ++it) { float tot = 0.f;
#pragma unroll
                for (int w8 = 0; w8 < 8; ++w8) tot += part[w8 * 64 + 32 * it + l31];
                const float rstd = rsqrtf(tot * (1.f / 256.f) + EPS);
#pragma unroll
                for (int g = 0; g < 4; ++g) { const u32x2 sg = psg[it * 4 + g]; u32x2 w;
                    w.x = cvtpk2(o[it][4 * g] * rstd * __uint_as_float(sg.x << 16), o[it][4 * g + 1] * rstd * __uint_as_float(sg.x & 0xffff0000u));
                    w.y = cvtpk2(o[it][4 * g + 2] * rstd * __uint_as_float(sg.y << 16), o[it][4 * g + 3] * rstd * __uint_as_float(sg.y & 0xffff0000u));
                    *(u32x2*)(OG + (row0 + 32 * it + l31) * 1024 + h * 256 + wave * 32 + 8 * g + 4 * hh) = w; } }
            CORE_PREP(par ^ 1);
            CORE_BAR();
        }
#undef CORE_LOAD
#undef CORE_VEC
#undef CORE_PREP
    }
}

struct MArgs { const float* in[24]; float* out; unsigned char* ws; int ph_lo, ph_hi, li, pad; };

__global__ void __launch_bounds__(NTHR, 2) mega(MArgs args) {
    extern __shared__ __attribute__((aligned(16))) unsigned char lds_raw[];
    LAS unsigned char* lds = (LAS unsigned char*)lds_raw;
    volatile LAS unsigned* MISC = (volatile LAS unsigned*)(lds + LDS_MISC);
    const int wave = __builtin_amdgcn_readfirstlane((int)(threadIdx.x >> 6));
    const int G = gridDim.x, bx = blockIdx.x;
    unsigned char* ws = args.ws;
    unsigned* ctl = (unsigned*)(ws + WS_CTL);
    { const int tid0 = wave * 64 + lane_id_v();
      for (int u = tid0; u < (LDS_BYTES - LDS_MISC) / 4; u += NTHR) ((LAS unsigned*)(lds + LDS_MISC))[u] = 0u;
      __syncthreads(); }
    XcdBarrier bar = xcd_barrier_post(ctl + CW_BAR + args.li * XCD_BAR_WORDS, MISC + 8, wave == 0 && lane_id_v() == 0);
#define TIDLANE const int lane = lane_id_v(), tid = wave * 64 + lane; (void)tid; (void)lane;
    const int lo = args.ph_lo, hi = args.ph_hi;
#define IN(k) (lo <= (k) && (k) < hi)
#define BOTH(k) (IN(k) && IN((k) + 1))
    const float* const* in = args.in;
#define PH_PTRS unsigned char* wsp = args.ws; asm volatile("" : "+s"(wsp)); \
    float *RS0 = (float*)(wsp + WS_RS0), *RS1 = (float*)(wsp + WS_RS1), *RS2 = (float*)(wsp + WS_RS2), *RS3 = (float*)(wsp + WS_RS3); \
    float *EREF = (float*)(wsp + WS_EREF), *ELAST = (float*)(wsp + WS_ELAST), *ELR = (float*)(wsp + WS_ELR); \
    bf16 *S0 = (bf16*)(wsp + WS_S0), *S1 = (bf16*)(wsp + WS_S1), *S2 = (bf16*)(wsp + WS_S2), *S3 = (bf16*)(wsp + WS_S3), *S4 = (bf16*)(wsp + WS_S4), *S5 = (bf16*)(wsp + WS_S5); \
    bf16 *W1 = (bf16*)(wsp + WS_W1), *WO = (bf16*)(wsp + WS_WO), *WLI = (bf16*)(wsp + WS_WLI), *WLO = (bf16*)(wsp + WS_WLO), *WG = (bf16*)(wsp + WS_WG), *WGU = (bf16*)(wsp + WS_WGU), *WD = (bf16*)(wsp + WS_WD); \
    int* LIST = (int*)(wsp + WS_LIST); float* LW = (float*)(wsp + WS_LW); int* POS = (int*)(wsp + WS_POS); const bf16* WR = (const bf16*)(wsp + WS_WR); unsigned* ctlp = (unsigned*)(wsp + WS_CTL); \
    (void)RS0; (void)RS1; (void)RS2; (void)RS3; (void)EREF; (void)ELAST; (void)ELR; (void)S0; (void)S1; (void)S2; (void)S3; (void)S4; (void)S5; \
    (void)W1; (void)WO; (void)WLI; (void)WLO; (void)WG; (void)WGU; (void)WD; (void)LIST; (void)LW; (void)POS; (void)WR; (void)ctlp;

    if (IN(0)) { PH_PTRS TIDLANE
        const int gw = bx * NWAVES + wave, NGW = G * NWAVES;
        bf16* XB = S0;
        for (int row = gw; row < T; row += NGW) {
            const f32x4* xr = (const f32x4*)(in[0] + (size_t)row * D) + lane; f32x4 v[4]; float s = 0.f;
#pragma unroll
            for (int j = 0; j < 4; ++j) { v[j] = xr[64 * j]; s += (v[j].x * v[j].x + v[j].y * v[j].y) + (v[j].z * v[j].z + v[j].w * v[j].w); }
            s = wave_sum(s);
            u32x2* o8 = (u32x2*)(XB + (size_t)row * D) + lane;
#pragma unroll
            for (int j = 0; j < 4; ++j) { u32x2 w; w.x = cvt_pk_bf16(v[j].x, v[j].y); w.y = cvt_pk_bf16(v[j].z, v[j].w); o8[64 * j] = w; }
            if (lane == 0) RS0[row] = rsqrtf(s * (1.f / D) + EPS);
        }
        LAS float* scr = (LAS float*)(lds + wave * 16384);
        constexpr int I_A = 1536, I_B = 256, I_C = 512, I_D = 1024, I_E = 512, I_F = 256, I_G = 16384, I_H = 8192, NITEMS = I_A + I_B + I_C + I_D + I_E + I_F + I_G + I_H;
        for (int it = gw; it < NITEMS; it += NGW) {
            int r = it;
            if (r < I_A) { cvt_item(in[2], 3088, 0, in[1], W1, 1024, 0, r / 96, r % 96, scr, lane); continue; } r -= I_A;
            if (r < I_B) { cvt_item_la(in[2], in[3], in[1], W1, r / 16, r % 16, scr, lane); continue; } r -= I_B;
            if (r < I_C) { cvt_item(in[6], 1024, 0, in[5], WO, 1024, 0, r / 32, r % 32, scr, lane, 255); continue; } r -= I_C;
            if (r < I_D) { cvt_item(in[8], 2048, 0, in[7], WLI, 1024, 0, r / 64, r % 64, scr, lane); continue; } r -= I_D;
            if (r < I_E) { cvt_item(in[16], 1024, 0, nullptr, WLO, 1024, 0, r / 32, r % 32, scr, lane); continue; } r -= I_E;
            if (r < I_F) { const int seg = r / 16, q = r % 16, nb4 = seg >> 2, half = (seg >> 1) & 1, pn = seg & 1;
                cvt_item((half ? in[13] : in[11]) + (size_t)nb4 * 65536, 256, pn * 128, nullptr, WG + (size_t)nb4 * 512 * 256, 256, pn * 256 + half * 128, q / 4, q % 4, scr, lane); continue; } r -= I_F;
            if (r < I_G) { const int seg = r / 64, q = r % 64, le = seg >> 2, half = (seg >> 1) & 1, pn = seg & 1;
                cvt_item((half ? in[21] : in[20]) + (size_t)le * 1024 * 256, 256, pn * 128, in[17] + (le >> 5) * D, WGU + (size_t)le * 512 * 1024, 1024, pn * 256 + half * 128, q / 4, q % 4, scr, lane); continue; } r -= I_G;
            { const int le = r / 128, q = r % 128; cvt_item(in[22] + (size_t)le * 256 * 1024, 1024, 0, nullptr, WD + (size_t)le * 1024 * 256, 256, 0, q / 32, q % 32, scr, lane); }
        }
        float* SP = (float*)(wsp + WS_SP); bf16* WRw = (bf16*)(wsp + WS_WR);
        for (int i = bx * NTHR + tid; i < 1024; i += G * NTHR) { const float l = -in[15][i]; SP[i] = fmaxf(l, 0.f) + log1pf(__expf(-fabsf(l))); }
        for (int i = bx * NTHR + tid; i < 2 * 48 * 1024; i += G * NTHR) { const int l = i / (48 * 1024), n = (i / 1024) % 48, k = i % 1024; float v = 0.f;
            if (n < 4) v = in[18][(size_t)l * D * 4 + k * 4 + n]; else if (n < 36) v = in[19][(size_t)l * D * 32 + k * 32 + n - 4];
            WRw[i] = f2bf(v * in[17][l * D + k]); }
        if (BOTH(0)) xcd_barrier(bar, wave);
    }
    if (IN(1)) { PH_PTRS
        pg8::SchedDense S{128, 14, G, bx, (const char*)S0, (const char*)W1, (size_t)256 * 1024 * 2, (size_t)256 * 1024 * 2, 1, 0};
        EpiG1 E{S1, S1 + (size_t)T * 512, S2, S3, S4, S4 + (size_t)T * 512, EREF, ELAST, ELR, nullptr, RS0, in[4]};
        pg8::gemm_phase<EpiG1, pg8::SchedDense, false>(lds, 1024, 1024, 1024, S, E, wave);
        if (BOTH(1)) xcd_barrier(bar, wave);
    }
    if (IN(2)) { PH_PTRS
        gla_core_phase(lds, S1, S1 + (size_t)T * 512, S2, S3, S4, S4 + (size_t)T * 512, EREF, ELAST, ELR, S0, bx, G, wave);
        if (BOTH(2)) xcd_barrier(bar, wave);
    }
    if (IN(3)) { PH_PTRS
        pg8::SchedDense S{128, 4, G, bx, (const char*)S0, (const char*)WO, (size_t)256 * 1024 * 2, (size_t)256 * 1024 * 2, 1, 0};
        EpiResidF E{in[0], nullptr, S1};
        pg8::gemm_phase<EpiResidF, pg8::SchedDense, false>(lds, 1024, 1024, 1024, S, E, wave);
        if (BOTH(3)) xcd_barrier(bar, wave);
    }

    LAS int* ts = (LAS int*)(lds + LDS_MISC + TS_OFF);
#define MOE_PHASES(P, LAYER, XIN, RSX, ACTB, YB, XOUT, RSOUT, FW, OUTP) \
    if (IN(P)) { PH_PTRS TIDLANE router_phase(lds, XIN, WR + (size_t)(LAYER) * 48 * 1024, RSX, ctlp + CW_CNT + 64 * (LAYER), LIST, LW, POS, bx, G, tid, lane, wave); if (BOTH(P)) xcd_barrier(bar, wave); } \
    if (IN(P + 1)) { PH_PTRS TIDLANE build_ts(ctlp + CW_CNT + 64 * (LAYER), ts, tid); \
        pg8::SchedMoe S{ts, G, bx, 2, (const char*)(XIN), (const char*)(WGU + (size_t)(LAYER) * 32 * 512 * 1024), LIST, (size_t)512 * 1024 * 2, (size_t)256 * 1024 * 2, 0, true}; \
        EpiM1 E{ACTB, LIST, LW, RSX}; \
        pg8::gemm_phase<EpiM1, pg8::SchedMoe, true>(lds, 1024, 1024, 1024, S, E, wave); if (BOTH(P + 1)) xcd_barrier(bar, wave); } \
    if (IN(P + 2)) { PH_PTRS TIDLANE build_ts(ctlp + CW_CNT + 64 * (LAYER), ts, tid); \
        pg8::SchedMoe S{ts, G, bx, 4, (const char*)(ACTB), (const char*)(WD + (size_t)(LAYER) * 32 * 1024 * 256), LIST, (size_t)1024 * 256 * 2, (size_t)256 * 256 * 2, (size_t)256 * 256 * 2, false}; \
        EpiStore E{YB, 1024, 0}; \
        pg8::gemm_phase<EpiStore, pg8::SchedMoe, false>(lds, 256, 256, 256, S, E, wave); if (BOTH(P + 2)) xcd_barrier(bar, wave); } \
    if (IN(P + 3)) { PH_PTRS TIDLANE build_ts(ctlp + CW_CNT + 64 * (LAYER), ts, tid); \
        combine_phase(ts, XIN, YB, POS, XOUT, RSOUT, FW, OUTP, bx, G, lane, wave); if (BOTH(P + 3)) xcd_barrier(bar, wave); }

    MOE_PHASES(4, 0, S1, RS1, S2, S3, S0, RS2, nullptr, nullptr)
    if (IN(8)) { PH_PTRS
        pg8::SchedDense S{128, 8, G, bx, (const char*)S0, (const char*)WLI, (size_t)256 * 1024 * 2, (size_t)256 * 1024 * 2, 1, 0};
        EpiL1 E{S1, S2, RS2};
        pg8::gemm_phase<EpiL1, pg8::SchedDense, false>(lds, 1024, 1024, 1024, S, E, wave);
        if (BOTH(8)) xcd_barrier(bar, wave);
    }
    if (IN(9)) { PH_PTRS TIDLANE conv_phase(S1, in[9], in[10], S3, bx, G, tid); if (BOTH(9)) xcd_barrier(bar, wave); }
    if (IN(10)) { PH_PTRS
        pg8::SchedDense S{128, 8, G, bx, (const char*)S3, (const char*)WG, (size_t)256 * 1024 * 2, (size_t)256 * 256 * 2, 2, (size_t)512};
        EpiL2 E{S3, S4, S5, in[12], in[14], (const float*)(wsp + WS_SP)};
        pg8::gemm_phase<EpiL2, pg8::SchedDense, false>(lds, 1024, 256, 256, S, E, wave);
        if (BOTH(10)) xcd_barrier(bar, wave);
    }
    if (IN(11)) { PH_PTRS TIDLANE scan_a_phase(lds, S4, S5, (float*)(wsp + WS_AGG), (float*)(wsp + WS_CARRY), bx, G, tid); if (BOTH(11)) xcd_barrier(bar, wave); }
    if (IN(12)) { PH_PTRS TIDLANE scan_c_phase(S4, S5, S2, (const float*)(wsp + WS_AGG), (const float*)(wsp + WS_CARRY), S1, bx, G, tid); if (BOTH(12)) xcd_barrier(bar, wave); }
    if (IN(13)) { PH_PTRS
        pg8::SchedDense S{128, 4, G, bx, (const char*)S1, (const char*)WLO, (size_t)256 * 1024 * 2, (size_t)256 * 1024 * 2, 1, 0};
        EpiResidF E{nullptr, S0, S5};
        pg8::gemm_phase<EpiResidF, pg8::SchedDense, false>(lds, 1024, 1024, 1024, S, E, wave);
        if (BOTH(13)) xcd_barrier(bar, wave);
    }
    MOE_PHASES(14, 1, S5, RS3, S3, S0, (bf16*)nullptr, (float*)nullptr, in[23], args.out)
#undef MOE_PHASES
#undef PH_PTRS
#undef TIDLANE
#undef IN
#undef BOTH
}

static int mega_grid() {
    static int grid = 0;
    if (grid == 0) {
        int dev = 0, cus = 0;
        if (hipGetDevice(&dev) != hipSuccess || hipDeviceGetAttribute(&cus, hipDeviceAttributeMultiprocessorCount, dev) != hipSuccess) { grid = -1; return grid; }
        if (hipFuncSetAttribute((const void*)mega, hipFuncAttributeMaxDynamicSharedMemorySize, LDS_BYTES) != hipSuccess) { fprintf(stderr, "hipFuncSetAttribute failed\n"); grid = -1; return grid; }
        int per_cu = 0;
        if (hipOccupancyMaxActiveBlocksPerMultiprocessor(&per_cu, (const void*)mega, NTHR, LDS_BYTES) != hipSuccess || per_cu < 1) { fprintf(stderr, "occupancy query: %d\n", per_cu); (void)hipGetLastError(); }
        grid = cus;
    }
    return grid;
}
static void launch_mega(const MArgs& base, int lo, int hi, int li, hipStream_t stream) {
    MArgs a = base; a.ph_lo = lo; a.ph_hi = hi; a.li = li; a.pad = 0;
    hipLaunchKernelGGL(mega, dim3(mega_grid()), dim3(NTHR), LDS_BYTES, stream, a);
}
extern "C" void kernel_launch(void* const* d_in, const int* in_sizes, int n_in, void* d_out, int out_size, void* d_ws, size_t ws_size, hipStream_t stream) {
    if (n_in != 24 || out_size != T * D || ws_size < WS_END) { fprintf(stderr, "kernel_launch: unexpected shapes (n_in %d out %d ws %zu)\n", n_in, out_size, ws_size); return; }
    if (mega_grid() <= 0) return;
    const float* const* in = (const float* const*)d_in; unsigned char* ws = (unsigned char*)d_ws;
    (void)hipMemsetAsync(ws + WS_CTL, 0, 1 * MiB, stream);
    MArgs base{}; for (int i = 0; i < 24; ++i) base.in[i] = in[i]; base.out = (float*)d_out; base.ws = ws;
    launch_mega(base, 0, 18, 0, stream);
}
```

```cpp
#include <hip/hip_runtime.h>
#include <cstdio>
#include <cstdint>

typedef unsigned short bf16;
constexpr int T = 32768, D = 1024, SEQ = 4096, NB = 8;
constexpr float EPS = 1e-6f;
constexpr size_t MiB = 1u << 20;
constexpr size_t WS_CTL = 0;
constexpr size_t WS_RS0 = 1 * MiB, WS_RS1 = WS_RS0 + 128 * 1024, WS_RS2 = WS_RS1 + 128 * 1024, WS_RS3 = WS_RS2 + 128 * 1024;
constexpr size_t WS_EREF = 2 * MiB, WS_ELAST = 3 * MiB, WS_ELR = 4 * MiB;
constexpr size_t WS_S0 = 128 * MiB, WS_S1 = 192 * MiB, WS_S2 = 256 * MiB, WS_S3 = 320 * MiB, WS_S4 = 384 * MiB, WS_S5 = 448 * MiB, WS_END = 512 * MiB;

__device__ __forceinline__ float bf2f(bf16 b) { return __uint_as_float(((unsigned)b) << 16); }
__device__ __forceinline__ bf16 f2bf(float f) { unsigned u = __float_as_uint(f); u += 0x7fffu + ((u >> 16) & 1u); return (bf16)(u >> 16); }
__device__ __forceinline__ float wave_sum(float v) {
#pragma unroll
    for (int o = 1; o < 64; o <<= 1) v += __shfl_xor(v, o);
    return v;
}
__device__ __forceinline__ float sigmoidf_(float x) { return 1.f / (1.f + __expf(-x)); }
__device__ __forceinline__ float siluf_(float x) { return x / (1.f + __expf(-x)); }
__device__ __forceinline__ float logsigmoidf_(float x) { return fminf(x, 0.f) - log1pf(__expf(-fabsf(x))); }
__device__ __forceinline__ float softplusf_(float x) { return fmaxf(x, 0.f) + log1pf(__expf(-fabsf(x))); }
__device__ __forceinline__ float gelu_tanhf_(float x) { const float u = 0.7978845608028654f * (x + 0.044715f * x * x * x); return 0.5f * x * (1.f + tanhf(u)); }

__global__ void __launch_bounds__(256) n_prologue(const float* x, bf16* XB, float* RS) {
    const int row = blockIdx.x * 4 + (threadIdx.x >> 6), lane = threadIdx.x & 63;
    const float* xr = x + (size_t)row * D; float s = 0.f;
    for (int i = lane; i < D; i += 64) { const float v = xr[i]; s += v * v; XB[(size_t)row * D + i] = f2bf(v); }
    s = wave_sum(s);
    if (lane == 0) RS[row] = rsqrtf(s * (1.f / D) + EPS);
}

template <class Epi>
__global__ void __launch_bounds__(256) n_gemm(const bf16* A, int lda, const float* rs, const float* nw, const float* W, int ldw, int M, int N, int K, Epi epi) {
    __shared__ float As[16][65], Ws[16][64];
    const int tid = threadIdx.x, tx = tid & 15, ty = tid >> 4, m0 = blockIdx.y * 64, n0 = blockIdx.x * 64;
    float acc[4][4];
#pragma unroll
    for (int i = 0; i < 4; ++i)
#pragma unroll
        for (int j = 0; j < 4; ++j) acc[i][j] = 0.f;
    for (int k0 = 0; k0 < K; k0 += 16) {
#pragma unroll
        for (int i = 0; i < 4; ++i) { const int idx = tid + 256 * i, r = idx >> 4, kk = idx & 15; As[kk][r] = bf2f(A[(size_t)(m0 + r) * lda + k0 + kk]) * (nw ? nw[k0 + kk] : 1.f); }
#pragma unroll
        for (int i = 0; i < 4; ++i) { const int idx = tid + 256 * i, kk = idx >> 6, n = idx & 63; Ws[kk][n] = (n0 + n < N) ? W[(size_t)(k0 + kk) * ldw + n0 + n] : 0.f; }
        __syncthreads();
#pragma unroll
        for (int kk = 0; kk < 16; ++kk) {
            float a[4], b[4];
#pragma unroll
            for (int i = 0; i < 4; ++i) a[i] = As[kk][ty * 4 + i];
#pragma unroll
            for (int j = 0; j < 4; ++j) b[j] = Ws[kk][tx + 16 * j];
#pragma unroll
            for (int i = 0; i < 4; ++i)
#pragma unroll
                for (int j = 0; j < 4; ++j) acc[i][j] += a[i] * b[j];
        }
        __syncthreads();
    }
#pragma unroll
    for (int i = 0; i < 4; ++i) { const int r = m0 + ty * 4 + i; const float sc = rs ? rs[r] : 1.f;
#pragma unroll
        for (int j = 0; j < 4; ++j) { const int c = n0 + tx + 16 * j; if (c < N) epi(r, c, acc[i][j] * sc); } }
}
struct EpiGlaProj { bf16 *Q, *Kb, *V, *SG; float* LR;
    __device__ void operator()(int r, int c, float v) const {
        if (c < 512) Q[(size_t)r * 512 + c] = f2bf(v);
        else if (c < 1024) Kb[(size_t)r * 512 + c - 512] = f2bf(v);
        else if (c < 2048) V[(size_t)r * 1024 + c - 1024] = f2bf(v);
        else if (c < 3072) SG[(size_t)r * 1024 + c - 2048] = f2bf(siluf_(v));
        else LR[(size_t)r * 16 + c - 3072] = v; } };
struct EpiResid { const float* xf; const bf16* xb; bf16* out;
    __device__ void operator()(int r, int c, float v) const { const size_t i = (size_t)r * D + c; out[i] = f2bf((xf ? xf[i] : bf2f(xb[i])) + v); } };
struct EpiLruIn { bf16 *XBR, *GATE;
    __device__ void operator()(int r, int c, float v) const { if (c < 1024) XBR[(size_t)r * D + c] = f2bf(v); else GATE[(size_t)r * D + c - 1024] = f2bf(gelu_tanhf_(v)); } };
struct EpiGate { bf16* O; const float* bias; int coff; int pad;
    __device__ void operator()(int r, int c, float v) const { O[(size_t)r * D + coff + c] = f2bf(sigmoidf_(v + bias[coff + c])); } };

__global__ void __launch_bounds__(256) n_gla_prep(const float* LR, const float* w_alpha, const float* b_alpha, bf16* EQ, bf16* EK, float* EREF, float* ELAST, float* ELR, float* AF) {
    const int gi = blockIdx.x * 256 + threadIdx.x, chunk = gi >> 9, col = gi & 511;
    float wa[16];
#pragma unroll
    for (int r = 0; r < 16; ++r) wa[r] = w_alpha[r * 512 + col];
    const float ba = b_alpha[col];
    float cum = 0.f, ref = 0.f;
    for (int i = 0; i < 64; ++i) { const float* lr = LR + (size_t)(chunk * 64 + i) * 16; float z = ba;
#pragma unroll
        for (int r = 0; r < 16; ++r) z += lr[r] * wa[r];
        const float la = logsigmoidf_(z) * (1.f / 16.f); cum += la; if (i == 32) ref = cum; AF[(size_t)(chunk * 64 + i) * 512 + col] = __expf(la); }
    const float last = cum;
    EREF[chunk * 512 + col] = __expf(ref); ELAST[chunk * 512 + col] = __expf(last); ELR[chunk * 512 + col] = __expf(last - ref);
    cum = 0.f;
    for (int i = 0; i < 64; ++i) { const float* lr = LR + (size_t)(chunk * 64 + i) * 16; float z = ba;
#pragma unroll
        for (int r = 0; r < 16; ++r) z += lr[r] * wa[r];
        cum += logsigmoidf_(z) * (1.f / 16.f);
        const size_t o = (size_t)(chunk * 64 + i) * 512 + col;
        EQ[o] = f2bf(0.08838834764831845f * __expf(cum - ref)); EK[o] = f2bf(__expf(ref - cum)); }
}
__global__ void __launch_bounds__(256) n_gla_core(const bf16* Q, const bf16* Kb, const bf16* V, const bf16* SG, const float* AF, const float* hn, bf16* OG) {
    __shared__ float red[4];
    const int bh = blockIdx.x, b = bh >> 2, h = bh & 3, e = threadIdx.x, lane = e & 63, w = e >> 6;
    float S[128];
#pragma unroll
    for (int d = 0; d < 128; ++d) S[d] = 0.f;
    const float hw = hn[e];
    for (int t = 0; t < SEQ; ++t) {
        const size_t row = (size_t)b * SEQ + t;
        const float v = bf2f(V[row * 1024 + h * 256 + e]);
        const float* a = AF + row * 512 + h * 128; const bf16* k = Kb + row * 512 + h * 128; const bf16* q = Q + row * 512 + h * 128;
        float o = 0.f;
#pragma unroll
        for (int d = 0; d < 128; ++d) { S[d] = a[d] * S[d] + bf2f(k[d]) * v; o += bf2f(q[d]) * S[d]; }
        o *= 0.08838834764831845f;
        float ss = wave_sum(o * o);
        __syncthreads();
        if (lane == 0) red[w] = ss;
        __syncthreads();
        ss = red[0] + red[1] + red[2] + red[3];
        const float rstd = rsqrtf(ss * (1.f / 256.f) + EPS);
        OG[row * 1024 + h * 256 + e] = f2bf(o * rstd * hw * bf2f(SG[row * 1024 + h * 256 + e]));
    }
}
__global__ void __launch_bounds__(256) n_moe(const bf16* Xin, const float* nw, const float* wg, const float* we, const float* Wgate, const float* Wup, const float* Wdown,
                                             bf16* Xout, float* RSout, const float* final_w, float* out) {
    __shared__ float hs[1024], logit[36], act[256], red[4]; __shared__ int sel[2]; __shared__ float selw[2];
    const int t = blockIdx.x, tid = threadIdx.x, lane = tid & 63, w = tid >> 6;
    float xv[4]; float s = 0.f;
#pragma unroll
    for (int i = 0; i < 4; ++i) { xv[i] = bf2f(Xin[(size_t)t * D + tid + 256 * i]); s += xv[i] * xv[i]; }
    s = wave_sum(s); if (lane == 0) red[w] = s; __syncthreads();
    const float rstd = rsqrtf((red[0] + red[1] + red[2] + red[3]) * (1.f / D) + EPS);
#pragma unroll
    for (int i = 0; i < 4; ++i) hs[tid + 256 * i] = xv[i] * rstd * nw[tid + 256 * i];
    __syncthreads();
    for (int li = w * 9; li < w * 9 + 9; ++li) { float p = 0.f;
        for (int k = lane; k < D; k += 64) p += hs[k] * (li < 4 ? wg[k * 4 + li] : we[k * 32 + li - 4]);
        p = wave_sum(p); if (lane == 0) logit[li] = p; }
    __syncthreads();
    if (tid == 0) {
        int g = 0; float gm = logit[0];
        for (int i = 1; i < 4; ++i) if (logit[i] > gm) { gm = logit[i]; g = i; }
        float gs = 0.f; for (int i = 0; i < 4; ++i) gs += __expf(logit[i] - gm);
        const float pg = 1.f / gs;
        const float* el = logit + 4 + g * 8; int e0 = 0; float m0 = el[0];
        for (int i = 1; i < 8; ++i) if (el[i] > m0) { m0 = el[i]; e0 = i; }
        int e1 = -1; float m1 = -3.0e38f;
        for (int i = 0; i < 8; ++i) if (i != e0 && el[i] > m1) { m1 = el[i]; e1 = i; }
        const float p1 = __expf(m1 - m0), den = 1.f + p1;
        sel[0] = g * 8 + e0; sel[1] = g * 8 + e1; selw[0] = pg / den; selw[1] = pg * p1 / den;
    }
    __syncthreads();
    float oacc[4] = {0.f, 0.f, 0.f, 0.f};
    for (int kk = 0; kk < 2; ++kk) {
        const int e = sel[kk]; const float wt = selw[kk];
        const float* G = Wgate + (size_t)e * D * 256; const float* U = Wup + (size_t)e * D * 256; const float* Dn = Wdown + (size_t)e * 256 * D;
        float ga = 0.f, ua = 0.f;
        for (int k = 0; k < D; ++k) { const float hv = hs[k]; ga += hv * G[k * 256 + tid]; ua += hv * U[k * 256 + tid]; }
        __syncthreads();
        act[tid] = siluf_(ga) * ua;
        __syncthreads();
        float o4[4] = {0.f, 0.f, 0.f, 0.f};
        for (int f = 0; f < 256; ++f) { const float av = act[f];
#pragma unroll
            for (int i = 0; i < 4; ++i) o4[i] += av * Dn[(size_t)f * D + tid + 256 * i]; }
#pragma unroll
        for (int i = 0; i < 4; ++i) oacc[i] += wt * o4[i];
    }
    float s2 = 0.f;
#pragma unroll
    for (int i = 0; i < 4; ++i) { xv[i] += oacc[i]; s2 += xv[i] * xv[i]; }
    s2 = wave_sum(s2); __syncthreads(); if (lane == 0) red[w] = s2; __syncthreads();
    const float rstd2 = rsqrtf((red[0] + red[1] + red[2] + red[3]) * (1.f / D) + EPS);
    if (out) {
#pragma unroll
        for (int i = 0; i < 4; ++i) out[(size_t)t * D + tid + 256 * i] = xv[i] * rstd2 * final_w[tid + 256 * i];
    } else {
#pragma unroll
        for (int i = 0; i < 4; ++i) Xout[(size_t)t * D + tid + 256 * i] = f2bf(xv[i]);
        if (tid == 0) RSout[t] = rstd2;
    }
}
__global__ void __launch_bounds__(256) n_conv(const bf16* XBR, const float* cw, const float* cb, bf16* XC) {
    const size_t i = (size_t)blockIdx.x * 256 + threadIdx.x; const int c = (int)(i & 1023); const int row = (int)(i >> 10), s = row & (SEQ - 1);
    float v = cb[c];
#pragma unroll
    for (int tap = 0; tap < 4; ++tap) { const int ss = s - 3 + tap; if (ss >= 0) v += cw[tap * 1024 + c] * bf2f(XBR[(size_t)(row - 3 + tap) * D + c]); }
    XC[i] = f2bf(v);
}
__global__ void __launch_bounds__(256) n_lru_scan(const bf16* XC, const bf16* RG, const bf16* IG, const bf16* GATE, const float* lam, bf16* YL) {
    const int gi = blockIdx.x * 256 + threadIdx.x, b = gi >> 10, c = gi & 1023;
    const float sp = softplusf_(-lam[c]); float h = 0.f;
    for (int t = 0; t < SEQ; ++t) { const size_t i = ((size_t)b * SEQ + t) * D + c;
        const float la = -8.f * bf2f(RG[i]) * sp, a = __expf(la), mult = sqrtf(-expm1f(2.f * la));
        h = a * h + bf2f(XC[i]) * bf2f(IG[i]) * mult;
        YL[i] = f2bf(h * bf2f(GATE[i])); }
}


#define LAS __attribute__((address_space(3)))
#define GAS __attribute__((address_space(1)))
typedef short bf16x8 __attribute__((ext_vector_type(8)));
typedef float f32x4 __attribute__((ext_vector_type(4)));
typedef float f32x2 __attribute__((ext_vector_type(2)));
typedef unsigned u32x4 __attribute__((ext_vector_type(4)));
typedef unsigned u32x2 __attribute__((ext_vector_type(2)));
typedef GAS unsigned gu32;
#define RLX_AGENT __ATOMIC_RELAXED, __HIP_MEMORY_SCOPE_AGENT
constexpr int NWAVES = 8, NTHR = 512;
constexpr int LDS_STAGE = 131072, LDS_MISC = LDS_STAGE, LDS_BYTES = 147456;
constexpr float QSCALE = 0.08838834764831845f;

constexpr size_t WS_SP = 1 * MiB + 512 * 1024;
constexpr size_t WS_WR = 14 * MiB;
constexpr size_t WS_W1 = 16 * MiB;
constexpr size_t WS_WO = WS_W1 + (size_t)3584 * 1024 * 2;
constexpr size_t WS_WLI = WS_WO + (size_t)1024 * 1024 * 2;
constexpr size_t WS_WLO = WS_WLI + (size_t)2048 * 1024 * 2;
constexpr size_t WS_WG = WS_WLO + (size_t)1024 * 1024 * 2;
constexpr size_t WS_WGU = WS_WG + (size_t)4 * 512 * 256 * 2;
constexpr size_t WS_WD = WS_WGU + (size_t)64 * 512 * 1024 * 2;
static_assert(WS_WD + (size_t)64 * 1024 * 256 * 2 <= WS_S0, "weights fit below the activation slots");
constexpr int CW_TMO = 0, CW_BAR = 4096;

__device__ __forceinline__ unsigned cvt_pk_bf16(float lo, float hi) { unsigned r; asm volatile("v_cvt_pk_bf16_f32 %0, %1, %2" : "=v"(r) : "v"(lo), "v"(hi)); return r; }
__device__ __forceinline__ float fexp(float x) { return __builtin_amdgcn_exp2f(x * 1.4426950408889634f); }
__device__ __forceinline__ float flog(float x) { return __builtin_amdgcn_logf(x) * 0.6931471805599453f; }
__device__ __forceinline__ float frcp(float x) { return __builtin_amdgcn_rcpf(x); }
__device__ __forceinline__ float fsilu(float x) { return x * frcp(1.f + fexp(-x)); }
__device__ __forceinline__ float fsigmoid(float x) { return frcp(1.f + fexp(-x)); }
__device__ __forceinline__ float flogsigmoid(float x) { return fminf(x, 0.f) - flog(1.f + fexp(-fabsf(x))); }
__device__ __forceinline__ float fgelu_tanh(float x) { const float u = 1.5957691216057308f * (x + 0.044715f * x * x * x); return x * frcp(1.f + fexp(-u)); }
__device__ __forceinline__ int lane_id_v() { int l; asm volatile("v_mbcnt_lo_u32_b32 %0, -1, 0\n\tv_mbcnt_hi_u32_b32 %0, -1, %0" : "=v"(l)); return l; }
template <int N> __device__ __forceinline__ float dpp_shr(float v) {
    return __builtin_bit_cast(float, __builtin_amdgcn_update_dpp(0, __builtin_bit_cast(int, v), 0x110 + N, 0xf, 0xf, true)); }

#define XB_TMO      128
#define XB_XCNT(j)  (256  + 64 * (j))
#define XB_XSUB(j)  (1280 + 64 * (j))
#define XB_XGEN(j)  (2304 + 64 * (j))
#define XB_TOP      3328
#define XB_TOPGEN   3392
#define XCD_BAR_WORDS 3456
#define XB_SPIN_CAP (1u << 18)
__device__ __forceinline__ unsigned xb_ld(unsigned* p)              { return __hip_atomic_load(p, __ATOMIC_RELAXED, __HIP_MEMORY_SCOPE_AGENT); }
__device__ __forceinline__ unsigned xb_add(unsigned* p, unsigned v) { return __hip_atomic_fetch_add(p, v, __ATOMIC_RELAXED, __HIP_MEMORY_SCOPE_AGENT); }
__device__ __forceinline__ unsigned xb_xcc_id() { return (unsigned)__builtin_amdgcn_s_getreg((3 << 11) | 20) & 0xFu; }
#define XB_SPIN(cond, bar) do { unsigned _sp = 0; while (cond) { __builtin_amdgcn_s_sleep(1); \
    if ((++_sp & 255u) == 0u) { if (xb_ld(&(bar)[XB_TMO])) break; if (_sp > XB_SPIN_CAP) { atomicAdd(&(bar)[XB_TMO], 1u); break; } } } } while (0)
struct XcdBarrier { unsigned* bar; unsigned x; volatile LAS unsigned* st; };
__device__ __forceinline__ XcdBarrier xcd_barrier_post(unsigned* bar, volatile LAS unsigned* st, bool t0) {
    XcdBarrier b; b.bar = bar; b.x = xb_xcc_id(); b.st = st;
    if (t0) (void)xb_add(&bar[XB_XCNT(b.x)], 1u);
    return b;
}
__device__ __forceinline__ void xcd_barrier_complete(unsigned* bar, unsigned x, unsigned& nloc, unsigned& nx) {
    const unsigned G = gridDim.x * gridDim.y * gridDim.z;
    unsigned sum, cnt, mine, sp = 0u;
    for (;;) {
        sum = 0u; cnt = 0u; mine = 0u;
#pragma unroll
        for (unsigned j = 0; j < 16; ++j) { const unsigned c = xb_ld(&bar[XB_XCNT(j)]); sum += c; cnt += (c > 0u) ? 1u : 0u; mine = (j == x) ? c : mine; }
        if (sum == G) break;
        __builtin_amdgcn_s_sleep(1);
        if ((++sp & 255u) == 0u) { if (xb_ld(&bar[XB_TMO])) break; if (sp > XB_SPIN_CAP) { atomicAdd(&bar[XB_TMO], 1u); break; } }
    }
    nloc = mine > 0u ? mine : 1u; nx = cnt > 0u ? cnt : 1u;
}
__device__ __forceinline__ void xcd_barrier(const XcdBarrier& b, int wave_) {
    asm volatile("s_waitcnt vmcnt(0)" ::: "memory");
    __syncthreads();
    if (wave_ == 0 && lane_id_v() == 0) {
        unsigned* bar = b.bar;
        __builtin_amdgcn_s_waitcnt(0);
        unsigned nloc = b.st[0], nx = b.st[1];
        if (nloc == 0u) { xcd_barrier_complete(bar, b.x, nloc, nx); b.st[0] = nloc; b.st[1] = nx; }
        const unsigned old = xb_add(&bar[XB_XSUB(b.x)], 1u);
        const unsigned gen = old / nloc;
        if (old + 1u == (gen + 1u) * nloc) {
            __builtin_amdgcn_fence(__ATOMIC_RELEASE, "agent");
            asm volatile("s_waitcnt vmcnt(0)" ::: "memory");
            const unsigned og = xb_add(&bar[XB_TOP], 1u);
            const unsigned tg = og / nx;
            if (og + 1u == (tg + 1u) * nx) xb_add(&bar[XB_TOPGEN], 1u);
            else XB_SPIN(xb_ld(&bar[XB_TOPGEN]) == tg, bar);
            __builtin_amdgcn_fence(__ATOMIC_ACQUIRE, "agent");
            xb_add(&bar[XB_XGEN(b.x)], 1u);
            asm volatile("s_waitcnt vmcnt(0)" ::: "memory");
        } else {
            XB_SPIN(xb_ld(&bar[XB_XGEN(b.x)]) == gen, bar);
            __builtin_amdgcn_fence(__ATOMIC_ACQUIRE, "agent");
            asm volatile("s_waitcnt vmcnt(0)" ::: "memory");
        }
    }
    __syncthreads();
}

namespace pg8 {
constexpr int BM = 256, BK = 64, HALF = 128, HTB = HALF * BK * 2, NXCD = 8, WGM = 8;
__device__ __forceinline__ int lds_byte(int r, int c) { const int st = (r >> 4) * 2 + (c >> 5), rr = r & 15, cc = c & 31, ob = rr * 64 + cc * 2; return st * 1024 + (ob ^ (((ob >> 9) & 1) << 5)); }
__device__ __forceinline__ void stage_rc(int b, int& R, int& C) { const int st = b / 1024, sb = b % 1024, swz = sb ^ (((sb >> 9) & 1) << 5); R = (st >> 1) * 16 + swz / 64; C = (st & 1) * 32 + (swz % 64) / 2; }
__device__ __forceinline__ int perm32(int rho) { const int n = rho >> 4, i = rho & 15; return 8 * (i >> 2) + 4 * n + (i & 3); }
__device__ __forceinline__ void tile_order(int L, int nM, int nN, int& pm, int& pn) {
    const int nwg = nM * nN; int wgid = L; { const int q = nwg / NXCD, r = nwg % NXCD, xcd = wgid % NXCD, off = wgid / NXCD; wgid = (xcd < r ? xcd * (q + 1) : r * (q + 1) + (xcd - r) * q) + off; }
    const int nig = WGM * nN, gid = wgid / nig, fm = gid * WGM, gsz = (nM - fm) < WGM ? (nM - fm) : WGM;
    pm = fm + ((wgid % nig) % gsz); pn = (wgid % nig) / gsz;
}
struct Unit { const char* a; const char* b; const int* rows; int pm, pn, e; };

template <class Epi, class Sched, bool GATHER>
__device__ __forceinline__ void gemm_phase(LAS unsigned char* lds, const int lda, const int ldb, const int K, const Sched& S, const Epi& E, const int wid) {
    const int lane = lane_id_v(), tid = wid * 64 + lane, wr = wid >> 2, wc = wid & 3, fr = lane & 15, fq = lane >> 4;
    int nt = K / BK; asm volatile("" : "+s"(nt));
    int Rr[2], Cc[2]; unsigned voffB[2];
#pragma unroll
    for (int i = 0; i < 2; ++i) { int R, C; stage_rc(tid * 16 + i * 8192, R, C); Rr[i] = R; Cc[i] = C; const int Rb = (R & ~31) + perm32(R & 31); voffB[i] = (unsigned)(Rb * ldb + C) * 2u; }
    const size_t kstep = (size_t)(BK * 2);
    const size_t hstepB = (size_t)HALF * ldb * 2;
    const unsigned ldsw = (unsigned)wid * 1024u;
    const int aoff = lds_byte(wr * 64 + fr, fq * 8), boff = lds_byte(wc * 32 + fr, fq * 8);
#define PG8_SA(b, h) (((b) * 2 + (h)) * HTB)
#define PG8_SB(b, h) ((4 + (b) * 2 + (h)) * HTB)
#define PG8_STAGE(bufoff, gbase, voff) do { _Pragma("unroll") for (int _i = 0; _i < 2; ++_i) \
        __builtin_amdgcn_global_load_lds((const unsigned*)((const char*)(gbase) + (voff)[_i]), (LAS unsigned*)(lds + (bufoff) + ldsw + _i * 8192), 16, 0, 0); } while (0)
#define PG8_LDA(dst, b, h) do { _Pragma("unroll") for (int m = 0; m < 4; ++m) _Pragma("unroll") for (int k = 0; k < 2; ++k) dst[m][k] = *(const LAS bf16x8*)(lds + PG8_SA(b, h) + aoff + m * 2048 + k * 1024); } while (0)
#define PG8_LDB(dst, b, h) do { _Pragma("unroll") for (int n = 0; n < 2; ++n) _Pragma("unroll") for (int k = 0; k < 2; ++k) dst[n][k] = *(const LAS bf16x8*)(lds + PG8_SB(b, h) + boff + n * 2048 + k * 1024); } while (0)
#define PG8_MMA(ai, bj, At, Bt) do { __builtin_amdgcn_s_setprio(1); _Pragma("unroll") for (int m = 0; m < 4; ++m) _Pragma("unroll") for (int n = 0; n < 2; ++n) _Pragma("unroll") for (int k = 0; k < 2; ++k) \
        acc[ai][bj][m][n] = __builtin_amdgcn_mfma_f32_16x16x32_bf16(Bt[n][k], At[m][k], acc[ai][bj][m][n], 0, 0, 0); __builtin_amdgcn_s_setprio(0); } while (0)
#define PG8_WAIT_V(n) asm volatile("s_waitcnt vmcnt(" #n ")" ::: "memory")
#define PG8_WAIT_L(n) asm volatile("s_waitcnt lgkmcnt(" #n ")" ::: "memory")
#define PG8_BAR __builtin_amdgcn_s_barrier()
#define PG8_SCHED __builtin_amdgcn_sched_barrier(0)
#define PG8_SETVOFF(v, u) do { _Pragma("unroll") for (int _h = 0; _h < 2; ++_h) _Pragma("unroll") for (int _i = 0; _i < 2; ++_i) { \
        if (GATHER) { unsigned _tk = (unsigned)(u).rows[_h * HALF + Rr[_i]]; _tk = _tk < (unsigned)T ? _tk : 0u; (v)[_h][_i] = (_tk * (unsigned)lda + (unsigned)Cc[_i]) * 2u; } else (v)[_h][_i] = (unsigned)(((_h * HALF + Rr[_i]) * lda + Cc[_i]) * 2); } } while (0)
    Unit cur, nxt; int ui = 0;
    if (!S.next(0, cur)) return;
    f32x4 acc[2][2][4][2];
#pragma unroll
    for (int a = 0; a < 2; ++a)
#pragma unroll
        for (int b = 0; b < 2; ++b)
#pragma unroll
            for (int m = 0; m < 4; ++m)
#pragma unroll
                for (int n = 0; n < 2; ++n) acc[a][b][m][n] = (f32x4){0.f, 0.f, 0.f, 0.f};
    bf16x8 At[4][2], B0[2][2], B1[2][2];
    unsigned vA[2][2], vN[2][2];
    PG8_SETVOFF(vA, cur);
    if (GATHER) asm volatile("" :: "v"(vA[0][0]), "v"(vA[0][1]), "v"(vA[1][0]), "v"(vA[1][1]));
    const char* cA = cur.a; const char* cB = cur.b;
    PG8_STAGE(PG8_SB(0, 0), cB, voffB); PG8_STAGE(PG8_SB(0, 1), cB + hstepB, voffB); PG8_STAGE(PG8_SA(0, 0), cA, vA[0]); PG8_STAGE(PG8_SA(0, 1), cA, vA[1]);
    if (wr == 1) PG8_BAR;
    PG8_WAIT_V(2); PG8_BAR;
    PG8_STAGE(PG8_SB(1, 0), cB + kstep, voffB); PG8_STAGE(PG8_SA(1, 0), cA + kstep, vA[0]); PG8_STAGE(PG8_SB(1, 1), cB + hstepB + kstep, voffB);
    PG8_WAIT_V(6); PG8_BAR;
    for (;;) {
        const bool has_next = S.next(ui + 1, nxt);
        const char* nA = has_next ? nxt.a : cA; const char* nB = has_next ? nxt.b : cB;
        if (GATHER) {
            if (has_next) { PG8_SETVOFF(vN, nxt); } else {
#pragma unroll
                for (int h = 0; h < 2; ++h)
#pragma unroll
                    for (int i = 0; i < 2; ++i) vN[h][i] = vA[h][i]; }
            asm volatile("" :: "v"(vN[0][0]), "v"(vN[0][1]), "v"(vN[1][0]), "v"(vN[1][1]));
        }
#pragma nounroll
        for (int t = 0; t < nt; t += 2) {
            const bool last = (t == nt - 2);
            const char* a1 = cA + (size_t)(t + 1) * kstep;
            const char* a2 = last ? nA : cA + (size_t)(t + 2) * kstep; const char* b2 = last ? nB : cB + (size_t)(t + 2) * kstep;
            const char* a3 = a2 + kstep; const char* b3 = b2 + kstep;
            PG8_LDB(B0, 0, 0); PG8_LDB(B1, 0, 1); PG8_SCHED; PG8_LDA(At, 0, 0); PG8_STAGE(PG8_SA(1, 1), a1, vA[1]);
            if (GATHER && last) {
#pragma unroll
                for (int h = 0; h < 2; ++h)
#pragma unroll
                    for (int i = 0; i < 2; ++i) vA[h][i] = vN[h][i]; }
            PG8_WAIT_V(8); PG8_WAIT_L(0); PG8_BAR; PG8_MMA(0, 0, At, B0); PG8_MMA(0, 1, At, B1); PG8_BAR; PG8_SCHED;
            PG8_LDA(At, 0, 1); PG8_STAGE(PG8_SB(0, 0), b2, voffB); PG8_STAGE(PG8_SB(0, 1), b2 + hstepB, voffB); PG8_STAGE(PG8_SA(0, 0), a2, vA[0]);
            PG8_WAIT_V(8); PG8_WAIT_L(0); PG8_BAR; PG8_MMA(1, 0, At, B0); PG8_MMA(1, 1, At, B1); PG8_BAR; PG8_SCHED;
            PG8_LDB(B0, 1, 0); PG8_LDB(B1, 1, 1); PG8_SCHED; PG8_LDA(At, 1, 0); PG8_STAGE(PG8_SA(0, 1), a2, vA[1]);
            PG8_WAIT_V(8); PG8_WAIT_L(0); PG8_BAR; PG8_MMA(0, 0, At, B0); PG8_MMA(0, 1, At, B1); PG8_BAR; PG8_SCHED;
            PG8_LDA(At, 1, 1); PG8_STAGE(PG8_SB(1, 0), b3, voffB); PG8_STAGE(PG8_SB(1, 1), b3 + hstepB, voffB); PG8_STAGE(PG8_SA(1, 0), a3, vA[0]);
            PG8_WAIT_V(8); PG8_WAIT_L(0); PG8_BAR; PG8_MMA(1, 0, At, B0); PG8_MMA(1, 1, At, B1); PG8_BAR; PG8_SCHED;
        }
        if (wr == 0) PG8_BAR;
        E(acc, cur, wr, wc, fr, fq, lane);
        if (!has_next) break;
#pragma unroll
        for (int a = 0; a < 2; ++a)
#pragma unroll
            for (int b = 0; b < 2; ++b)
#pragma unroll
                for (int m = 0; m < 4; ++m)
#pragma unroll
                    for (int n = 0; n < 2; ++n) acc[a][b][m][n] = (f32x4){0.f, 0.f, 0.f, 0.f};
        cur = nxt; cA = nA; cB = nB; ++ui;
        if (wr == 1) PG8_BAR;
    }
    PG8_WAIT_V(0);
    PG8_BAR;
#undef PG8_SA
#undef PG8_SB
#undef PG8_STAGE
#undef PG8_LDA
#undef PG8_LDB
#undef PG8_MMA
#undef PG8_WAIT_V
#undef PG8_WAIT_L
#undef PG8_BAR
#undef PG8_SCHED
#undef PG8_SETVOFF
}
struct SchedDense {
    int nM, nN, G, c; const char* A; const char* B; size_t a_tile, b_tile; int pn_div; size_t a_pn_step;
    __device__ __forceinline__ bool next(int i, Unit& u) const {
        const long L = (long)i * G + c; if (L >= (long)nM * nN) return false;
        int pm, pn; tile_order((int)L, nM, nN, pm, pn);
        u.pm = pm; u.pn = pn; u.e = 0; u.rows = nullptr; u.a = A + (size_t)pm * a_tile + (size_t)(pn / pn_div) * a_pn_step; u.b = B + (size_t)pn * b_tile; return true;
    }
};
}

__device__ __forceinline__ void unpack8(const u32x4 p, f32x4& r0, f32x4& r1) {
    r0 = (f32x4){__uint_as_float(p.x << 16), __uint_as_float(p.x & 0xffff0000u), __uint_as_float(p.y << 16), __uint_as_float(p.y & 0xffff0000u)};
    r1 = (f32x4){__uint_as_float(p.z << 16), __uint_as_float(p.z & 0xffff0000u), __uint_as_float(p.w << 16), __uint_as_float(p.w & 0xffff0000u)}; }
__device__ __forceinline__ u32x4 pack8(const f32x4 v0, const f32x4 v1) { u32x4 w; w.x = cvt_pk_bf16(v0[0], v0[1]); w.y = cvt_pk_bf16(v0[2], v0[3]); w.z = cvt_pk_bf16(v1[0], v1[1]); w.w = cvt_pk_bf16(v1[2], v1[3]); return w; }

struct EpiG1 {
    bf16 *Q, *Kb, *V, *SG, *EQ, *EK; float *EREF, *ELAST, *ELR, *AF; const float* RS; const float* b_alpha;
    __device__ __forceinline__ void operator()(f32x4 (&acc)[2][2][4][2], const pg8::Unit& u, int wr, int wc, int fr, int fq, int lane) const {
        const int row0 = u.pm * 256 + wr * 64 + fr, pn = u.pn;
        if (pn < 12) {
            bf16* base; int ldc, colt; const bool act = pn >= 8;
            if (pn < 2) { base = Q; ldc = 512; colt = pn * 256; } else if (pn < 4) { base = Kb; ldc = 512; colt = (pn - 2) * 256; }
            else if (pn < 8) { base = V; ldc = 1024; colt = (pn - 4) * 256; } else { base = SG; ldc = 1024; colt = (pn - 8) * 256; }
            const int col0 = colt + wc * 32 + 8 * fq;
#pragma unroll
            for (int ai = 0; ai < 2; ++ai)
#pragma unroll
                for (int m = 0; m < 4; ++m) { const int row = row0 + ai * 128 + m * 16; const float rs = RS[row]; bf16* rowp = base + (size_t)row * ldc + col0;
#pragma unroll
                    for (int bj = 0; bj < 2; ++bj) { f32x4 v0 = acc[ai][bj][m][0] * rs, v1 = acc[ai][bj][m][1] * rs;
                        if (act) {
#pragma unroll
                            for (int j = 0; j < 4; ++j) { v0[j] = fsilu(v0[j]); v1[j] = fsilu(v1[j]); } }
                        u32x4 w; w.x = cvt_pk_bf16(v0[0], v0[1]); w.y = cvt_pk_bf16(v0[2], v0[3]); w.z = cvt_pk_bf16(v1[0], v1[1]); w.w = cvt_pk_bf16(v1[2], v1[3]);
                        *(u32x4*)(rowp + bj * 128) = w; } }
        } else {
            const int colt = (pn - 12) * 256;
#pragma unroll
            for (int ai = 0; ai < 2; ++ai) {
                const int chunk = u.pm * 4 + ai * 2 + wr; float rsv[4];
#pragma unroll
                for (int m = 0; m < 4; ++m) rsv[m] = RS[row0 + ai * 128 + m * 16];
#pragma unroll
                for (int bj = 0; bj < 2; ++bj)
#pragma unroll
                    for (int n = 0; n < 2; ++n) {
                        const int c = colt + bj * 128 + wc * 32 + 8 * fq + 4 * n;
                        const f32x4 ba = *(const f32x4*)(b_alpha + c);
                        f32x4 cum[4]; f32x4 run = (f32x4){0.f, 0.f, 0.f, 0.f};
#pragma unroll
                        for (int m = 0; m < 4; ++m) { const f32x4 z = acc[ai][bj][m][n] * rsv[m] + ba; f32x4 la;
#pragma unroll
                            for (int j = 0; j < 4; ++j) la[j] = flogsigmoid(z[j]) * 0.0625f;
                            if (AF) { f32x4 ea;
#pragma unroll
                                for (int j = 0; j < 4; ++j) ea[j] = fexp(la[j]);
                                *(f32x4*)(AF + (size_t)(row0 + ai * 128 + m * 16) * 512 + c) = ea; }
                            f32x4 tot;
#pragma unroll
                            for (int j = 0; j < 4; ++j) { float v = la[j]; v += dpp_shr<1>(v); v += dpp_shr<2>(v); v += dpp_shr<4>(v); v += dpp_shr<8>(v); la[j] = v; tot[j] = __shfl(v, lane | 15); }
                            cum[m] = la + run; run += tot; }
                        f32x4 ref;
#pragma unroll
                        for (int j = 0; j < 4; ++j) ref[j] = __shfl(cum[2][j], lane & 48);
#pragma unroll
                        for (int m = 0; m < 4; ++m) { const size_t o = (size_t)(row0 + ai * 128 + m * 16) * 512 + c; float q[4], k[4];
#pragma unroll
                            for (int j = 0; j < 4; ++j) { q[j] = QSCALE * fexp(cum[m][j] - ref[j]); k[j] = fexp(ref[j] - cum[m][j]); }
                            u32x2 wq, wk; wq.x = cvt_pk_bf16(q[0], q[1]); wq.y = cvt_pk_bf16(q[2], q[3]); wk.x = cvt_pk_bf16(k[0], k[1]); wk.y = cvt_pk_bf16(k[2], k[3]);
                            *(u32x2*)(EQ + o) = wq; *(u32x2*)(EK + o) = wk; }
                        { f32x4 er, el, elr;
#pragma unroll
                            for (int j = 0; j < 4; ++j) { er[j] = fexp(ref[j]); el[j] = fexp(run[j]); elr[j] = fexp(run[j] - ref[j]); }
                            asm volatile("" : "+v"(er), "+v"(el), "+v"(elr));
                            if (fr == 0) { *(f32x4*)(EREF + chunk * 512 + c) = er; *(f32x4*)(ELAST + chunk * 512 + c) = el; *(f32x4*)(ELR + chunk * 512 + c) = elr; } }
                    }
            }
        }
    }
};
__device__ __forceinline__ unsigned opaque_u0(unsigned v) { asm volatile("" : "+v"(v)); return v; }
struct EpiResidF {
    const float* xf; const bf16* xb; bf16* out;
    __device__ __forceinline__ void operator()(f32x4 (&acc)[2][2][4][2], const pg8::Unit& u, int wr, int wc, int fr, int fq, int lane) const {
        const size_t uo = (size_t)u.pm * 256 * 1024 + u.pn * 256;
        const char* xfb = (const char*)(xf + uo); const char* xbb = (const char*)(xb + uo); char* ob = (char*)(out + uo);
        const unsigned lo = opaque_u0((unsigned)((wr * 64 + fr) * 1024 + wc * 32 + 8 * fq) * 2u);
#pragma unroll
        for (int ai = 0; ai < 2; ++ai)
#pragma unroll
            for (int m = 0; m < 4; ++m)
#pragma unroll
                for (int bj = 0; bj < 2; ++bj) { const unsigned o = lo + (unsigned)((ai * 128 + m * 16) * 1024 + bj * 128) * 2u; f32x4 r0, r1;
                    if (xf) { r0 = *(const f32x4*)(xfb + 2u * o); r1 = *(const f32x4*)(xfb + (2u * o + 16u)); }
                    else unpack8(*(const u32x4*)(xbb + o), r0, r1);
                    *(u32x4*)(ob + o) = pack8(acc[ai][bj][m][0] + r0, acc[ai][bj][m][1] + r1); }
    }
};

__device__ __forceinline__ void cvt_item(const float* W, int ldn, int scol0, const float* kscale, bf16* dst, int dstK, int drow0, int kb, int nb, LAS float* scr, int lane, int kmask = 0x7fffffff) {
    const int k0 = 64 * kb, n0 = 32 * nb;
#pragma unroll 8
    for (int i = 0; i < 32; ++i) { const int kk = 2 * i + (lane >> 5); float v = W[(size_t)(k0 + kk) * ldn + scol0 + n0 + (lane & 31)]; if (kscale) v *= kscale[(k0 + kk) & kmask]; scr[kk * 33 + (lane & 31)] = v; }
    asm volatile("s_waitcnt lgkmcnt(0)" ::: "memory");
    const int c = lane & 7;
#pragma unroll
    for (int j = 0; j < 4; ++j) { const int n = (lane >> 3) + 8 * j; const LAS float* s = scr + (8 * c) * 33 + n;
        u32x4 o; o.x = cvt_pk_bf16(s[0 * 33], s[1 * 33]); o.y = cvt_pk_bf16(s[2 * 33], s[3 * 33]); o.z = cvt_pk_bf16(s[4 * 33], s[5 * 33]); o.w = cvt_pk_bf16(s[6 * 33], s[7 * 33]);
        *(u32x4*)(dst + (size_t)(drow0 + n0 + n) * dstK + k0 + 8 * c) = o; }
    asm volatile("s_waitcnt lgkmcnt(0)" ::: "memory");
}
__device__ __forceinline__ void cvt_item_la(const float* Win, const float* wal, const float* kscale, bf16* dst, int kb, int nb, LAS float* scr, int lane) {
    const int k0 = 64 * kb, n0 = 32 * nb; float wa[16];
#pragma unroll
    for (int r = 0; r < 16; ++r) wa[r] = wal[r * 512 + n0 + (lane & 31)];
#pragma unroll 4
    for (int i = 0; i < 32; ++i) { const int kk = 2 * i + (lane >> 5); const float* lr = Win + (size_t)(k0 + kk) * 3088 + 3072; float v = 0.f;
#pragma unroll
        for (int r = 0; r < 16; ++r) v += lr[r] * wa[r];
        scr[kk * 33 + (lane & 31)] = v * kscale[k0 + kk]; }
    asm volatile("s_waitcnt lgkmcnt(0)" ::: "memory");
    const int c = lane & 7;
#pragma unroll
    for (int j = 0; j < 4; ++j) { const int n = (lane >> 3) + 8 * j; const LAS float* s = scr + (8 * c) * 33 + n;
        u32x4 o; o.x = cvt_pk_bf16(s[0 * 33], s[1 * 33]); o.y = cvt_pk_bf16(s[2 * 33], s[3 * 33]); o.z = cvt_pk_bf16(s[4 * 33], s[5 * 33]); o.w = cvt_pk_bf16(s[6 * 33], s[7 * 33]);
        *(u32x4*)(dst + (size_t)(3072 + n0 + n) * 1024 + k0 + 8 * c) = o; }
    asm volatile("s_waitcnt lgkmcnt(0)" ::: "memory");
}


constexpr int CAP = 32768;
constexpr size_t WS_LIST = 5 * MiB, WS_LW = 9 * MiB, WS_POS = 13 * MiB;
constexpr size_t WS_AGG = 13 * MiB + 512 * 1024;
constexpr size_t WS_CARRY = 5 * MiB;
constexpr int CW_CNT = 16384;
constexpr int TS_OFF = 256;

namespace pg8 {
struct SchedMoe {
    const LAS int* ts; int G, c, npn; const char* A; const char* B; const int* LIST; size_t b_exp, b_pn, a_tile; bool gather;
    __device__ __forceinline__ bool next(int i, Unit& u) const {
        const int NT = __builtin_amdgcn_readfirstlane(ts[32]); const long L = (long)i * G + c; if (L >= (long)NT * npn) return false;
        const int tg = (int)(L / npn), pn = (int)(L % npn);
        const int e = __builtin_amdgcn_readfirstlane(ts[64 + tg]);
        const int tile = tg - __builtin_amdgcn_readfirstlane(ts[e]);
        u.pm = tg; u.pn = pn; u.e = e; u.rows = LIST + (size_t)e * CAP + tile * 256; u.a = gather ? A : A + (size_t)tg * a_tile; u.b = B + (size_t)e * b_exp + (size_t)pn * b_pn; return true;
    }
};
}
__device__ __forceinline__ unsigned opaque_u(unsigned v) { asm volatile("" : "+v"(v)); return v; }
struct EpiM1 {
    bf16* ACT; const int* LIST; const float* LW; const float* RS;
    __device__ __forceinline__ void operator()(f32x4 (&acc)[2][2][4][2], const pg8::Unit& u, int wr, int wc, int fr, int fq, int lane) const {
        const char* rowsb = (const char*)u.rows; const char* lwb = (const char*)(LW + (u.rows - LIST)); const char* rsb = (const char*)RS;
        char* ob = (char*)(ACT + (size_t)u.pm * 256 * 256 + u.pn * 128);
        const unsigned r4 = opaque_u((unsigned)(wr * 64 + fr) * 4u), lo = opaque_u((unsigned)((wr * 64 + fr) * 256 + wc * 32 + 8 * fq) * 2u);
#pragma unroll
        for (int ai = 0; ai < 2; ++ai)
#pragma unroll
            for (int m = 0; m < 4; ++m) { const unsigned ro = r4 + (unsigned)(ai * 128 + m * 16) * 4u;
                unsigned tk = *(const unsigned*)(rowsb + ro); tk = tk < (unsigned)T ? tk : 0u;
                const float rs = *(const float*)(rsb + tk * 4u), w = *(const float*)(lwb + ro); f32x4 o[2];
#pragma unroll
                for (int n = 0; n < 2; ++n) { const f32x4 g = acc[ai][0][m][n] * rs, up = acc[ai][1][m][n] * rs;
#pragma unroll
                    for (int j = 0; j < 4; ++j) o[n][j] = fsilu(g[j]) * up[j] * w; }
                *(u32x4*)(ob + (lo + (unsigned)(ai * 128 + m * 16) * 512u)) = pack8(o[0], o[1]); }
    }
};
struct EpiStore {
    bf16* O; int ldc; int pad;
    __device__ __forceinline__ void operator()(f32x4 (&acc)[2][2][4][2], const pg8::Unit& u, int wr, int wc, int fr, int fq, int lane) const {
        char* ob = (char*)(O + (size_t)u.pm * 256 * 1024 + u.pn * 256);
        const unsigned lo = opaque_u((unsigned)((wr * 64 + fr) * 1024 + wc * 32 + 8 * fq) * 2u);
#pragma unroll
        for (int ai = 0; ai < 2; ++ai)
#pragma unroll
            for (int m = 0; m < 4; ++m)
#pragma unroll
                for (int bj = 0; bj < 2; ++bj) *(u32x4*)(ob + (lo + (unsigned)((ai * 128 + m * 16) * 1024 + bj * 128) * 2u)) = pack8(acc[ai][bj][m][0], acc[ai][bj][m][1]);
    }
};
struct EpiL1 {
    bf16 *XBR, *GATE; const float* RS;
    __device__ __forceinline__ void operator()(f32x4 (&acc)[2][2][4][2], const pg8::Unit& u, int wr, int wc, int fr, int fq, int lane) const {
        const bool act = u.pn >= 4; char* ob = (char*)((act ? GATE : XBR) + (size_t)u.pm * 256 * 1024 + (u.pn & 3) * 256); const char* rsb = (const char*)(RS + u.pm * 256);
        const unsigned r4 = opaque_u((unsigned)(wr * 64 + fr) * 4u), lo = opaque_u((unsigned)((wr * 64 + fr) * 1024 + wc * 32 + 8 * fq) * 2u);
#pragma unroll
        for (int ai = 0; ai < 2; ++ai)
#pragma unroll
            for (int m = 0; m < 4; ++m) { const float rs = *(const float*)(rsb + (r4 + (unsigned)(ai * 128 + m * 16) * 4u));
#pragma unroll
                for (int bj = 0; bj < 2; ++bj) { f32x4 v0 = acc[ai][bj][m][0] * rs, v1 = acc[ai][bj][m][1] * rs;
                    if (act) {
#pragma unroll
                        for (int j = 0; j < 4; ++j) { v0[j] = fgelu_tanh(v0[j]); v1[j] = fgelu_tanh(v1[j]); } }
                    *(u32x4*)(ob + (lo + (unsigned)((ai * 128 + m * 16) * 1024 + bj * 128) * 2u)) = pack8(v0, v1); } }
    }
};
struct EpiL2 {
    const bf16* XC; bf16 *LOGA, *XN; const float *br, *bi, *SP;
    __device__ __forceinline__ void operator()(f32x4 (&acc)[2][2][4][2], const pg8::Unit& u, int wr, int wc, int fr, int fq, int lane) const {
        const int cu = (u.pn >> 1) * 256 + (u.pn & 1) * 128; const size_t uo = (size_t)u.pm * 256 * 1024 + cu;
        const char* xcb = (const char*)(XC + uo); char* lab = (char*)(LOGA + uo); char* xnb = (char*)(XN + uo);
        const unsigned cl = opaque_u((unsigned)(wc * 32 + 8 * fq) * 4u), lo = opaque_u((unsigned)((wr * 64 + fr) * 1024 + wc * 32 + 8 * fq) * 2u);
        f32x4 vbr[2], vbi[2], vsp[2];
#pragma unroll
        for (int n = 0; n < 2; ++n) { vbr[n] = *(const f32x4*)((const char*)(br + cu) + (cl + 16u * n)); vbi[n] = *(const f32x4*)((const char*)(bi + cu) + (cl + 16u * n)); vsp[n] = *(const f32x4*)((const char*)(SP + cu) + (cl + 16u * n)); }
#pragma unroll
        for (int ai = 0; ai < 2; ++ai)
#pragma unroll
            for (int m = 0; m < 4; ++m) { const unsigned o = lo + (unsigned)((ai * 128 + m * 16) * 1024) * 2u;
                f32x4 xc[2]; unpack8(*(const u32x4*)(xcb + o), xc[0], xc[1]); f32x4 la[2], xn[2];
#pragma unroll
                for (int n = 0; n < 2; ++n)
#pragma unroll
                    for (int j = 0; j < 4; ++j) { const float r = fsigmoid(acc[ai][0][m][n][j] + vbr[n][j]), ig = fsigmoid(acc[ai][1][m][n][j] + vbi[n][j]);
                        const float l = -8.f * r * vsp[n][j]; la[n][j] = l; xn[n][j] = xc[n][j] * ig * sqrtf(fmaxf(1.f - fexp(2.f * l), 0.f)); }
                *(u32x4*)(lab + o) = pack8(la[0], la[1]); *(u32x4*)(xnb + o) = pack8(xn[0], xn[1]); }
    }
};

__device__ __forceinline__ void build_ts(unsigned* CNT, LAS int* ts, int tid) {
    __syncthreads();
    if (tid < 32) ts[400 + tid] = (int)((xb_ld(CNT + tid) + 255u) >> 8);
    __syncthreads();
    if (tid == 0) { int a = 0; for (int e = 0; e < 32; ++e) { ts[e] = a; a += ts[400 + e]; } ts[32] = a; }
    __syncthreads();
    if (tid < 32) { const int b = ts[tid], n = ts[tid + 1] - b; for (int k = 0; k < n; ++k) ts[64 + b + k] = tid; }
    __syncthreads();
}
__device__ __forceinline__ void router_phase(LAS unsigned char* lds, const bf16* X, const bf16* WRl, float* RS, unsigned* CNT, int* LIST, float* LW, int* POS, int bx, int G, int tid, int lane, int wave) {
    LAS float* lg = (LAS float*)lds + wave * (16 * 48);
    LAS float* rsl = (LAS float*)(lds + 24576) + wave * 16;
    LAS unsigned* cnt_l = (LAS unsigned*)(lds + 25600); LAS unsigned* base_l = cnt_l + 32;
    const int fr = lane & 15, fq = lane >> 4;
    for (int grp = bx; grp < T / 128; grp += G) {
        if (tid < 32) cnt_l[tid] = 0u;
        __syncthreads();
        const int t0 = grp * 128 + wave * 16;
        f32x4 a0 = (f32x4){0.f, 0.f, 0.f, 0.f}, a1 = a0, a2 = a0; float ss = 0.f;
        const bf16* xa = X + (size_t)(t0 + fr) * D + 8 * fq; const bf16* wb = WRl + (size_t)fr * D + 8 * fq;
#pragma unroll 4
        for (int s = 0; s < 32; ++s) {
            const bf16x8 a = *(const bf16x8*)(xa + 32 * s), b0 = *(const bf16x8*)(wb + 32 * s), b1 = *(const bf16x8*)(wb + 16 * D + 32 * s), b2 = *(const bf16x8*)(wb + 32 * D + 32 * s);
#pragma unroll
            for (int j = 0; j < 8; ++j) { const float v = bf2f((bf16)a[j]); ss += v * v; }
            a0 = __builtin_amdgcn_mfma_f32_16x16x32_bf16(a, b0, a0, 0, 0, 0); a1 = __builtin_amdgcn_mfma_f32_16x16x32_bf16(a, b1, a1, 0, 0, 0); a2 = __builtin_amdgcn_mfma_f32_16x16x32_bf16(a, b2, a2, 0, 0, 0);
        }
        ss += __shfl_xor(ss, 16); ss += __shfl_xor(ss, 32);
        const float rstd = rsqrtf(ss * (1.f / D) + EPS);
        if (fq == 0) { rsl[fr] = rstd; RS[t0 + fr] = rstd; }
#pragma unroll
        for (int r = 0; r < 4; ++r) { lg[(4 * fq + r) * 48 + fr] = a0[r]; lg[(4 * fq + r) * 48 + 16 + fr] = a1[r]; lg[(4 * fq + r) * 48 + 32 + fr] = a2[r]; }
        asm volatile("s_waitcnt lgkmcnt(0)" ::: "memory");
        int e0g = 0, e1g = 0; float w0 = 0.f, w1 = 0.f; unsigned rk0 = 0u, rk1 = 0u;
        if (lane < 16) {
            const LAS float* l = lg + lane * 48; const float rs = rsl[lane];
            int g = 0; float gm = l[0] * rs;
            for (int i = 1; i < 4; ++i) { const float v = l[i] * rs; if (v > gm) { gm = v; g = i; } }
            float gs = 0.f; for (int i = 0; i < 4; ++i) gs += fexp(l[i] * rs - gm);
            const float pg = 1.f / gs;
            const LAS float* el = l + 4 + g * 8; int e0 = 0; float m0 = el[0] * rs;
            for (int i = 1; i < 8; ++i) { const float v = el[i] * rs; if (v > m0) { m0 = v; e0 = i; } }
            int e1 = 0; float m1 = -3.0e38f;
            for (int i = 0; i < 8; ++i) { const float v = el[i] * rs; if (i != e0 && v > m1) { m1 = v; e1 = i; } }
            const float p1 = fexp(m1 - m0), den = 1.f / (1.f + p1);
            e0g = g * 8 + e0; e1g = g * 8 + e1; w0 = pg * den; w1 = pg * p1 * den;
            rk0 = __hip_atomic_fetch_add(cnt_l + e0g, 1u, __ATOMIC_RELAXED, __HIP_MEMORY_SCOPE_WORKGROUP);
            rk1 = __hip_atomic_fetch_add(cnt_l + e1g, 1u, __ATOMIC_RELAXED, __HIP_MEMORY_SCOPE_WORKGROUP);
        }
        __syncthreads();
        if (tid < 32) base_l[tid] = xb_add(CNT + tid, cnt_l[tid]);
        __syncthreads();
        if (lane < 16) { const int tok = t0 + lane; const int s0 = e0g * CAP + (int)(base_l[e0g] + rk0), s1 = e1g * CAP + (int)(base_l[e1g] + rk1);
            LIST[s0] = tok; LW[s0] = w0; LIST[s1] = tok; LW[s1] = w1; POS[2 * tok] = s0; POS[2 * tok + 1] = s1; }
        __syncthreads();
    }
}
__device__ __forceinline__ void combine_phase(const LAS int* ts, const bf16* X, const bf16* Y, const int* POS, bf16* Xn, float* RSn, const float* fw, float* out, int bx, int G, int lane, int wave) {
    for (int t = bx * NWAVES + wave; t < T; t += G * NWAVES) {
        const int p0 = POS[2 * t], p1 = POS[2 * t + 1];
        const size_t r0 = (size_t)ts[p0 >> 15] * 256 + (p0 & (CAP - 1)), r1 = (size_t)ts[p1 >> 15] * 256 + (p1 & (CAP - 1));
        f32x4 v[4]; float ss = 0.f;
#pragma unroll
        for (int h = 0; h < 2; ++h) { f32x4 x0, x1, y0, y1, z0, z1; const int c = h * 512 + lane * 8;
            unpack8(*(const u32x4*)(X + (size_t)t * D + c), x0, x1); unpack8(*(const u32x4*)(Y + r0 * D + c), y0, y1); unpack8(*(const u32x4*)(Y + r1 * D + c), z0, z1);
            v[2 * h] = x0 + y0 + z0; v[2 * h + 1] = x1 + y1 + z1;
#pragma unroll
            for (int j = 0; j < 4; ++j) ss += v[2 * h][j] * v[2 * h][j] + v[2 * h + 1][j] * v[2 * h + 1][j]; }
        ss = wave_sum(ss); const float rstd = rsqrtf(ss * (1.f / D) + EPS);
        if (out) {
#pragma unroll
            for (int h = 0; h < 2; ++h) { const int c = h * 512 + lane * 8; const f32x4 f0 = *(const f32x4*)(fw + c), f1 = *(const f32x4*)(fw + c + 4);
                *(f32x4*)(out + (size_t)t * D + c) = v[2 * h] * rstd * f0; *(f32x4*)(out + (size_t)t * D + c + 4) = v[2 * h + 1] * rstd * f1; }
        } else {
#pragma unroll
            for (int h = 0; h < 2; ++h) *(u32x4*)(Xn + (size_t)t * D + h * 512 + lane * 8) = pack8(v[2 * h], v[2 * h + 1]);
            if (lane == 0) RSn[t] = rstd;
        }
    }
}
__device__ __forceinline__ void conv_phase(const bf16* XBR, const float* cw, const float* cb, bf16* XC, int bx, int G, int tid) {
    for (int item = bx * NTHR + tid; item < (T / 32) * 128; item += G * NTHR) {
        const int cg = item & 127, run = item >> 7, c = cg * 8, t0 = run * 32;
        f32x4 w[4][2], b[2];
#pragma unroll
        for (int k = 0; k < 4; ++k) { w[k][0] = *(const f32x4*)(cw + k * D + c); w[k][1] = *(const f32x4*)(cw + k * D + c + 4); }
        b[0] = *(const f32x4*)(cb + c); b[1] = *(const f32x4*)(cb + c + 4);
        f32x4 h0[2], h1[2], h2[2];
        const bool first = (t0 & (SEQ - 1)) == 0;
        if (first) { h0[0] = h0[1] = h1[0] = h1[1] = h2[0] = h2[1] = (f32x4){0.f, 0.f, 0.f, 0.f}; }
        else { unpack8(*(const u32x4*)(XBR + (size_t)(t0 - 3) * D + c), h0[0], h0[1]); unpack8(*(const u32x4*)(XBR + (size_t)(t0 - 2) * D + c), h1[0], h1[1]); unpack8(*(const u32x4*)(XBR + (size_t)(t0 - 1) * D + c), h2[0], h2[1]); }
#pragma unroll 4
        for (int i = 0; i < 32; ++i) { f32x4 x[2]; unpack8(*(const u32x4*)(XBR + (size_t)(t0 + i) * D + c), x[0], x[1]); f32x4 o[2];
#pragma unroll
            for (int q = 0; q < 2; ++q) { o[q] = b[q] + w[0][q] * h0[q] + w[1][q] * h1[q] + w[2][q] * h2[q] + w[3][q] * x[q]; h0[q] = h1[q]; h1[q] = h2[q]; h2[q] = x[q]; }
            *(u32x4*)(XC + (size_t)(t0 + i) * D + c) = pack8(o[0], o[1]); }
    }
}
__device__ __forceinline__ void scan_a_phase(LAS unsigned char* lds, const bf16* LOGA, const bf16* XN, float* AGG, float* CARRY, int bx, int G, int tid) {
    LAS float* sA = (LAS float*)lds; LAS float* sH = sA + 64 * 64;
    for (int item = bx; item < 256; item += G) {
        const int b = item >> 5, slab = (item >> 1) & 15, half = item & 1, seg = tid >> 3, cg = tid & 7, c = slab * 64 + cg * 8;
        const size_t row0 = (size_t)b * SEQ + half * 2048 + seg * 32;
        f32x4 A[2], H[2]; A[0] = A[1] = (f32x4){0.f, 0.f, 0.f, 0.f}; H[0] = H[1] = A[0];
#pragma unroll 4
        for (int i = 0; i < 32; ++i) { f32x4 la[2], xn[2]; unpack8(*(const u32x4*)(LOGA + (row0 + i) * D + c), la[0], la[1]); unpack8(*(const u32x4*)(XN + (row0 + i) * D + c), xn[0], xn[1]);
#pragma unroll
            for (int q = 0; q < 2; ++q) { A[q] += la[q];
#pragma unroll
                for (int j = 0; j < 4; ++j) H[q][j] = fexp(la[q][j]) * H[q][j] + xn[q][j]; } }
        __syncthreads();
#pragma unroll
        for (int q = 0; q < 2; ++q) { *(LAS f32x4*)(sA + seg * 64 + cg * 8 + 4 * q) = A[q]; *(LAS f32x4*)(sH + seg * 64 + cg * 8 + 4 * q) = H[q]; }
        __syncthreads();
        if (tid < 64) { float pl = 0.f, h = 0.f; float* cr = CARRY + (size_t)item * 64 * 128;
            for (int sgi = 0; sgi < 64; ++sgi) { cr[sgi * 128 + tid] = pl; cr[sgi * 128 + 64 + tid] = h; const float a = sA[sgi * 64 + tid]; h = fexp(a) * h + sH[sgi * 64 + tid]; pl += a; }
            AGG[item * 128 + tid] = pl; AGG[item * 128 + 64 + tid] = h; }
    }
}
__device__ __forceinline__ void scan_c_phase(const bf16* LOGA, const bf16* XN, const bf16* GATE, const float* AGG, const float* CARRY, bf16* YL, int bx, int G, int tid) {
    for (int item = bx; item < 256; item += G) {
        const int b = item >> 5, slab = (item >> 1) & 15, half = item & 1, seg = tid >> 3, cg = tid & 7, c = slab * 64 + cg * 8;
        const size_t row0 = (size_t)b * SEQ + half * 2048 + seg * 32;
        const float* cr = CARRY + (size_t)item * 64 * 128 + seg * 128 + cg * 8;
        f32x4 h[2];
#pragma unroll
        for (int q = 0; q < 2; ++q) { const f32x4 pl = *(const f32x4*)(cr + 4 * q), hl = *(const f32x4*)(cr + 64 + 4 * q);
            f32x4 hw = (f32x4){0.f, 0.f, 0.f, 0.f}; if (half) hw = *(const f32x4*)(AGG + (item - 1) * 128 + 64 + cg * 8 + 4 * q);
#pragma unroll
            for (int j = 0; j < 4; ++j) h[q][j] = hl[j] + fexp(pl[j]) * hw[j]; }
#pragma unroll 4
        for (int i = 0; i < 32; ++i) { f32x4 la[2], xn[2], g[2], y[2]; const size_t o = (row0 + i) * D + c;
            unpack8(*(const u32x4*)(LOGA + o), la[0], la[1]); unpack8(*(const u32x4*)(XN + o), xn[0], xn[1]); unpack8(*(const u32x4*)(GATE + o), g[0], g[1]);
#pragma unroll
            for (int q = 0; q < 2; ++q)
#pragma unroll
                for (int j = 0; j < 4; ++j) { h[q][j] = fexp(la[q][j]) * h[q][j] + xn[q][j]; y[q][j] = h[q][j] * g[q][j]; }
            *(u32x4*)(YL + o) = pack8(y[0], y[1]); }
    }
}


__device__ __forceinline__ void gla_core_ref_phase(LAS unsigned char* lds, const bf16* Q, const bf16* Kb, const bf16* V, const bf16* SG, const float* AF, const float* hn, bf16* OG, int bx, int G, int tid) {
    LAS float* part = (LAS float*)lds;
    LAS float* red = part + 512;
    const int e = tid & 255, hf = tid >> 8, lane = tid & 63, w4 = (tid >> 6) & 3;
    for (int bh = bx; bh < 32; bh += G) {
        const int b = bh >> 2, h = bh & 3;
        float S[64];
#pragma unroll
        for (int d = 0; d < 64; ++d) S[d] = 0.f;
        const float hw = hn[e];
        for (int t = 0; t < SEQ; ++t) {
            const size_t row = (size_t)b * SEQ + t;
            const float v = bf2f(V[row * 1024 + h * 256 + e]);
            const float* a = AF + row * 512 + h * 128 + hf * 64; const bf16* k = Kb + row * 512 + h * 128 + hf * 64; const bf16* q = Q + row * 512 + h * 128 + hf * 64;
            float o = 0.f;
#pragma unroll
            for (int d = 0; d < 64; ++d) { S[d] = a[d] * S[d] + bf2f(k[d]) * v; o += bf2f(q[d]) * S[d]; }
            part[hf * 256 + e] = o;
            __syncthreads();
            o = (part[e] + part[256 + e]) * QSCALE;
            float ss = wave_sum(o * o);
            if (hf == 0 && lane == 0) red[w4] = ss;
            __syncthreads();
            ss = red[0] + red[1] + red[2] + red[3];
            const float rstd = rsqrtf(ss * (1.f / 256.f) + EPS);
            if (hf == 0) OG[row * 1024 + h * 256 + e] = f2bf(o * rstd * hw * bf2f(SG[row * 1024 + h * 256 + e]));
        }
        __syncthreads();
    }
}


typedef float f32x16 __attribute__((ext_vector_type(16)));
typedef short s16x4 __attribute__((ext_vector_type(4)));
typedef short v4i16_t __attribute__((ext_vector_type(4)));
typedef __bf16 bf16x2_t __attribute__((ext_vector_type(2)));
__device__ __forceinline__ unsigned cvtpk2(float lo, float hi) { f32x2 v = {lo, hi}; bf16x2_t b = __builtin_convertvector(v, bf16x2_t); return __builtin_bit_cast(unsigned, b); }
__device__ __forceinline__ s16x4 vtr(const LAS unsigned char* p) { return __builtin_bit_cast(s16x4, __builtin_amdgcn_ds_read_tr16_b64_v4i16((LAS v4i16_t*)p)); }
__device__ __forceinline__ bf16x8 tr_frag(const LAS unsigned char* a, int P) { const s16x4 lo = vtr(a), hi = vtr(a + 4 * P); return __builtin_shufflevector(lo, hi, 0, 1, 2, 3, 4, 5, 6, 7); }
__device__ __forceinline__ int crow(int r, int hh) { return (r & 3) + 8 * (r >> 2) + 4 * hh; }
#define MFMA32(a, b, c) __builtin_amdgcn_mfma_f32_32x32x16_bf16((a), (b), (c), 0, 0, 0)
#define CORE_BAR() asm volatile("s_waitcnt lgkmcnt(0)\n\ts_barrier" ::: "memory")

__device__ __forceinline__ void gla_core_phase(LAS unsigned char* lds, const bf16* Q, const bf16* Kb, const bf16* V, const bf16* SG, const bf16* EQ, const bf16* EK,
                                               const float* EREF, const float* ELAST, const float* ELR, bf16* OG, int bx, int G, int wave) {
    constexpr int TP = 272, VP = 80, PP = 144;
    constexpr int O_QP = 0, O_KP = 17408, O_QC = 34816, O_KST = 52224, O_V = 69632, O_P = 110592, O_PART = 119808, O_VEC = 121856;
    const int lane = lane_id_v(), tid = wave * 64 + lane, hh = lane >> 5, l31 = lane & 31;
    const int ptok = tid >> 3, pdp = tid & 7;
    LAS unsigned char* vsl = lds + O_V + wave * (64 * VP);
    const int troff = (8 * hh + ((lane & 15) >> 2)) * 1 ;
    const int trcol = 32 * ((lane >> 4) & 1) + 8 * (lane & 3);
    LAS float* part = (LAS float*)(lds + O_PART);
    for (int bh = bx; bh < 32; bh += G) {
        const int b = bh >> 2, h = bh & 3;
        const size_t seq0 = (size_t)b * SEQ;
        f32x16 S[4];
#pragma unroll
        for (int dt = 0; dt < 4; ++dt)
#pragma unroll
            for (int r = 0; r < 16; ++r) S[dt][r] = 0.f;
        u32x4 pq[2], pk[2], peq[2], pek[2], pv[4]; float ve[3] = {0.f, 0.f, 0.f};
#define CORE_LOAD(cc) do { const size_t rr = seq0 + (size_t)(cc) * 64; \
            { const size_t o = (rr + ptok) * 512 + h * 128 + pdp * 16; \
              pq[0] = *(const GAS u32x4*)(Q + o); pq[1] = *(const GAS u32x4*)(Q + o + 8); pk[0] = *(const GAS u32x4*)(Kb + o); pk[1] = *(const GAS u32x4*)(Kb + o + 8); \
              peq[0] = *(const GAS u32x4*)(EQ + o); peq[1] = *(const GAS u32x4*)(EQ + o + 8); pek[0] = *(const GAS u32x4*)(EK + o); pek[1] = *(const GAS u32x4*)(EK + o + 8); } \
            { const bf16* vp = V + (rr + lane) * 1024 + h * 256 + wave * 32; pv[0] = *(const GAS u32x4*)vp; pv[1] = *(const GAS u32x4*)(vp + 8); pv[2] = *(const GAS u32x4*)(vp + 16); pv[3] = *(const GAS u32x4*)(vp + 24); } \
            if (tid < 128) { const size_t vo = (rr >> 6) * 512 + h * 128 + tid; ve[0] = *(const GAS float*)(EREF + vo); ve[1] = *(const GAS float*)(ELR + vo); ve[2] = *(const GAS float*)(ELAST + vo); } } while (0)
#define CORE_VEC(par) do { if (tid < 128) { LAS float* vv = (LAS float*)(lds + O_VEC) + (par) * 384; vv[tid] = ve[0]; vv[128 + tid] = ve[1]; vv[256 + tid] = ve[2]; } } while (0)
#define CORE_PREP(par) do { const LAS float* vv = (const LAS float*)(lds + O_VEC) + (par) * 384 + pdp * 16; \
            _Pragma("unroll") for (int q2 = 0; q2 < 2; ++q2) { f32x4 q0, q1, e0, e1, k0, k1, g0, g1; unpack8(pq[q2], q0, q1); unpack8(peq[q2], e0, e1); unpack8(pk[q2], k0, k1); unpack8(pek[q2], g0, g1); \
                const f32x4 er0 = *(const LAS f32x4*)(vv + q2 * 8), er1 = *(const LAS f32x4*)(vv + q2 * 8 + 4), lr0 = *(const LAS f32x4*)(vv + 128 + q2 * 8), lr1 = *(const LAS f32x4*)(vv + 128 + q2 * 8 + 4); \
                q0 = q0 * e0; q1 = q1 * e1; k0 = k0 * g0; k1 = k1 * g1; \
                const int lo_ = ptok * TP + (pdp * 16 + q2 * 8) * 2; \
                *(LAS u32x4*)(lds + O_QP + lo_) = pack8(q0, q1); *(LAS u32x4*)(lds + O_KP + lo_) = pack8(k0, k1); \
                *(LAS u32x4*)(lds + O_QC + lo_) = pack8(q0 * er0, q1 * er1); *(LAS u32x4*)(lds + O_KST + lo_) = pack8(k0 * lr0, k1 * lr1); } \
            _Pragma("unroll") for (int i_ = 0; i_ < 4; ++i_) *(LAS u32x4*)(vsl + lane * VP + i_ * 16) = pv[i_]; } while (0)
        CORE_LOAD(0); CORE_VEC(0);
        CORE_BAR();
        CORE_PREP(0);
        CORE_BAR();
        for (int c = 0; c < 64; ++c) {
            const int par = c & 1; const size_t row0 = seq0 + (size_t)c * 64;
            u32x2 psg[8];
#pragma unroll
            for (int it = 0; it < 2; ++it)
#pragma unroll
                for (int g = 0; g < 4; ++g) psg[it * 4 + g] = *(const GAS u32x2*)(SG + (row0 + 32 * it + l31) * 1024 + h * 256 + wave * 32 + 8 * g + 4 * hh);
            CORE_LOAD(c < 63 ? c + 1 : 63);
            if (wave < 3) { const int jt = wave == 2 ? 1 : 0, it = wave >= 1 ? 1 : 0; f32x16 p;
#pragma unroll
                for (int r = 0; r < 16; ++r) p[r] = 0.f;
#pragma unroll
                for (int ks = 0; ks < 8; ++ks) { const bf16x8 a = *(const LAS bf16x8*)(lds + O_KP + (32 * jt + l31) * TP + (16 * ks + 8 * hh) * 2), bq = *(const LAS bf16x8*)(lds + O_QP + (32 * it + l31) * TP + (16 * ks + 8 * hh) * 2);
                    p = MFMA32(a, bq, p); }
                if (jt == it) {
#pragma unroll
                    for (int r = 0; r < 16; ++r) p[r] = crow(r, hh) <= l31 ? p[r] : 0.f; }
#pragma unroll
                for (int g = 0; g < 4; ++g) { u32x2 w; w.x = cvtpk2(p[4 * g], p[4 * g + 1]); w.y = cvtpk2(p[4 * g + 2], p[4 * g + 3]);
                    *(LAS u32x2*)(lds + O_P + (32 * it + l31) * PP + (32 * jt + 8 * g + 4 * hh) * 2) = w; }
            }
            f32x16 o[2];
#pragma unroll
            for (int it = 0; it < 2; ++it)
#pragma unroll
                for (int r = 0; r < 16; ++r) o[it][r] = 0.f;
#pragma unroll
            for (int ks = 0; ks < 8; ++ks) { const int dt = ks >> 1, s2 = ks & 1; u32x4 ap;
                ap.x = cvtpk2(S[dt][8 * s2 + 0], S[dt][8 * s2 + 1]); ap.y = cvtpk2(S[dt][8 * s2 + 2], S[dt][8 * s2 + 3]); ap.z = cvtpk2(S[dt][8 * s2 + 4], S[dt][8 * s2 + 5]); ap.w = cvtpk2(S[dt][8 * s2 + 6], S[dt][8 * s2 + 7]);
                const bf16x8 a = __builtin_bit_cast(bf16x8, ap);
#pragma unroll
                for (int it = 0; it < 2; ++it) { const LAS unsigned char* qa = lds + O_QC + (32 * it + l31) * TP + (32 * dt + 16 * s2 + 4 * hh) * 2;
                    const s16x4 lo = *(const LAS s16x4*)qa, hi = *(const LAS s16x4*)(qa + 16);
                    o[it] = MFMA32(a, __builtin_shufflevector(lo, hi, 0, 1, 2, 3, 4, 5, 6, 7), o[it]); } }
            CORE_BAR();
            bf16x8 vf[4];
#pragma unroll
            for (int s4 = 0; s4 < 4; ++s4) vf[s4] = tr_frag(vsl + (16 * s4 + troff) * VP + trcol, VP);
#pragma unroll
            for (int it = 0; it < 2; ++it)
#pragma unroll
                for (int s4 = 0; s4 < 4; ++s4) { if (it == 0 && s4 >= 2) continue;
                    const bf16x8 pb = *(const LAS bf16x8*)(lds + O_P + (32 * it + l31) * PP + (16 * s4 + 8 * hh) * 2);
                    o[it] = MFMA32(vf[s4], pb, o[it]); }
#pragma unroll
            for (int it = 0; it < 2; ++it) { float ss = 0.f;
#pragma unroll
                for (int r = 0; r < 16; ++r) ss += o[it][r] * o[it][r];
                ss += __shfl_xor(ss, 32);
                if (hh == 0) part[wave * 64 + 32 * it + l31] = ss; }
            { const LAS float* el = (const LAS float*)(lds + O_VEC) + par * 384 + 256;
#pragma unroll
              for (int dt = 0; dt < 4; ++dt)
#pragma unroll
                for (int g = 0; g < 4; ++g) { const f32x4 e4 = *(const LAS f32x4*)(el + 32 * dt + 8 * g + 4 * hh);
#pragma unroll
                    for (int j = 0; j < 4; ++j) S[dt][4 * g + j] *= e4[j]; }
#pragma unroll
              for (int dt = 0; dt < 4; ++dt)
#pragma unroll
                for (int s4 = 0; s4 < 4; ++s4) S[dt] = MFMA32(tr_frag(lds + O_KST + (16 * s4 + troff) * TP + 64 * dt + trcol, TP), vf[s4], S[dt]); }
            CORE_VEC(par ^ 1);
            CORE_BAR();
#pragma unroll
            for (int it = 0; it < 2; ++it) { float tot = 0.f;
#pragma unroll
                for (int w8 = 0; w8 < 8; ++w8) tot += part[w8 * 64 + 32 * it + l31];
                const float rstd = rsqrtf(tot * (1.f / 256.f) + EPS);
#pragma unroll
                for (int g = 0; g < 4; ++g) { const u32x2 sg = psg[it * 4 + g]; u32x2 w;
                    w.x = cvtpk2(o[it][4 * g] * rstd * __uint_as_float(sg.x << 16), o[it][4 * g + 1] * rstd * __uint_as_float(sg.x & 0xffff0000u));
                    w.y = cvtpk2(o[it][4 * g + 2] * rstd * __uint_as_float(sg.y << 16), o[it][4 * g + 3] * rstd * __uint_as_float(sg.y & 0xffff0000u));
                    *(GAS u32x2*)(OG + (row0 + 32 * it + l31) * 1024 + h * 256 + wave * 32 + 8 * g + 4 * hh) = w; } }
            CORE_PREP(par ^ 1);
            CORE_BAR();
        }
#undef CORE_LOAD
#undef CORE_VEC
#undef CORE_PREP
    }
}

struct MArgs { const float* in[24]; float* out; unsigned char* ws; int ph_lo, ph_hi, li, pad; };

#define CVT_ITEMS(IT_LO, IT_HI, GW_, NGW_) do { \
        LAS float* scr = (LAS float*)(lds + wave * 16384); \
        constexpr int I_A = 1536, I_B = 256, I_C = 512, I_D = 1024, I_E = 512, I_F = 256, I_G = 16384; \
        for (int it = (IT_LO) + (GW_); it < (IT_HI); it += (NGW_)) { \
            int r = it; \
            if (r < I_A) { cvt_item(in[2], 3088, 0, in[1], W1, 1024, 0, r / 96, r % 96, scr, lane); continue; } r -= I_A; \
            if (r < I_B) { cvt_item_la(in[2], in[3], in[1], W1, r / 16, r % 16, scr, lane); continue; } r -= I_B; \
            if (r < I_C) { cvt_item(in[6], 1024, 0, in[5], WO, 1024, 0, r / 32, r % 32, scr, lane, 255); continue; } r -= I_C; \
            if (r < I_D) { cvt_item(in[8], 2048, 0, in[7], WLI, 1024, 0, r / 64, r % 64, scr, lane); continue; } r -= I_D; \
            if (r < I_E) { cvt_item(in[16], 1024, 0, nullptr, WLO, 1024, 0, r / 32, r % 32, scr, lane); continue; } r -= I_E; \
            if (r < I_F) { const int seg = r / 16, q = r % 16, nb4 = seg >> 2, half = (seg >> 1) & 1, pn = seg & 1; \
                cvt_item((half ? in[13] : in[11]) + (size_t)nb4 * 65536, 256, pn * 128, nullptr, WG + (size_t)nb4 * 512 * 256, 256, pn * 256 + half * 128, q / 4, q % 4, scr, lane); continue; } r -= I_F; \
            if (r < I_G) { const int seg = r / 64, q = r % 64, le = seg >> 2, half = (seg >> 1) & 1, pn = seg & 1; \
                cvt_item((half ? in[21] : in[20]) + (size_t)le * 1024 * 256, 256, pn * 128, in[17] + (le >> 5) * D, WGU + (size_t)le * 512 * 1024, 1024, pn * 256 + half * 128, q / 4, q % 4, scr, lane); continue; } r -= I_G; \
            { const int le = r / 128, q = r % 128; cvt_item(in[22] + (size_t)le * 256 * 1024, 1024, 0, nullptr, WD + (size_t)le * 1024 * 256, 256, 0, q / 32, q % 32, scr, lane); } \
        } } while (0)
constexpr int CVT_W1_ITEMS = 1536 + 256, CVT_ALL_ITEMS = 1536 + 256 + 512 + 1024 + 512 + 256 + 16384 + 8192;
__global__ void __launch_bounds__(NTHR, 2) mega(MArgs args) {
    extern __shared__ __attribute__((aligned(16))) unsigned char lds_raw[];
    LAS unsigned char* lds = (LAS unsigned char*)lds_raw;
    volatile LAS unsigned* MISC = (volatile LAS unsigned*)(lds + LDS_MISC);
    const int wave = __builtin_amdgcn_readfirstlane((int)(threadIdx.x >> 6));
    const int G = gridDim.x, bx = blockIdx.x;
    unsigned char* ws = args.ws;
    unsigned* ctl = (unsigned*)(ws + WS_CTL);
    { const int tid0 = wave * 64 + lane_id_v();
      for (int u = tid0; u < (LDS_BYTES - LDS_MISC) / 4; u += NTHR) ((LAS unsigned*)(lds + LDS_MISC))[u] = 0u;
      __syncthreads(); }
    XcdBarrier bar = xcd_barrier_post(ctl + CW_BAR + args.li * XCD_BAR_WORDS, MISC + 8, wave == 0 && lane_id_v() == 0);
#define TIDLANE const int lane = lane_id_v(), tid = wave * 64 + lane; (void)tid; (void)lane;
    const int lo = args.ph_lo, hi = args.ph_hi;
#define IN(k) (lo <= (k) && (k) < hi)
#define BOTH(k) (IN(k) && IN((k) + 1))
    const float* const* in = args.in;
#define PH_PTRS unsigned char* wsp = args.ws; asm volatile("" : "+s"(wsp)); \
    float *RS0 = (float*)(wsp + WS_RS0), *RS1 = (float*)(wsp + WS_RS1), *RS2 = (float*)(wsp + WS_RS2), *RS3 = (float*)(wsp + WS_RS3); \
    float *EREF = (float*)(wsp + WS_EREF), *ELAST = (float*)(wsp + WS_ELAST), *ELR = (float*)(wsp + WS_ELR); \
    bf16 *S0 = (bf16*)(wsp + WS_S0), *S1 = (bf16*)(wsp + WS_S1), *S2 = (bf16*)(wsp + WS_S2), *S3 = (bf16*)(wsp + WS_S3), *S4 = (bf16*)(wsp + WS_S4), *S5 = (bf16*)(wsp + WS_S5); \
    bf16 *W1 = (bf16*)(wsp + WS_W1), *WO = (bf16*)(wsp + WS_WO), *WLI = (bf16*)(wsp + WS_WLI), *WLO = (bf16*)(wsp + WS_WLO), *WG = (bf16*)(wsp + WS_WG), *WGU = (bf16*)(wsp + WS_WGU), *WD = (bf16*)(wsp + WS_WD); \
    int* LIST = (int*)(wsp + WS_LIST); float* LW = (float*)(wsp + WS_LW); int* POS = (int*)(wsp + WS_POS); const bf16* WR = (const bf16*)(wsp + WS_WR); unsigned* ctlp = (unsigned*)(wsp + WS_CTL); \
    (void)RS0; (void)RS1; (void)RS2; (void)RS3; (void)EREF; (void)ELAST; (void)ELR; (void)S0; (void)S1; (void)S2; (void)S3; (void)S4; (void)S5; \
    (void)W1; (void)WO; (void)WLI; (void)WLO; (void)WG; (void)WGU; (void)WD; (void)LIST; (void)LW; (void)POS; (void)WR; (void)ctlp;

    if (IN(0)) { PH_PTRS TIDLANE
        const int gw = bx * NWAVES + wave, NGW = G * NWAVES;
        bf16* XB = S0;
        for (int row = gw; row < T; row += NGW) {
            const f32x4* xr = (const f32x4*)(in[0] + (size_t)row * D) + lane; f32x4 v[4]; float s = 0.f;
#pragma unroll
            for (int j = 0; j < 4; ++j) { v[j] = xr[64 * j]; s += (v[j].x * v[j].x + v[j].y * v[j].y) + (v[j].z * v[j].z + v[j].w * v[j].w); }
            s = wave_sum(s);
            u32x2* o8 = (u32x2*)(XB + (size_t)row * D) + lane;
#pragma unroll
            for (int j = 0; j < 4; ++j) { u32x2 w; w.x = cvt_pk_bf16(v[j].x, v[j].y); w.y = cvt_pk_bf16(v[j].z, v[j].w); o8[64 * j] = w; }
            if (lane == 0) RS0[row] = rsqrtf(s * (1.f / D) + EPS);
        }
        CVT_ITEMS(0, (G > 32 ? CVT_W1_ITEMS : CVT_ALL_ITEMS), gw, NGW);
        float* SP = (float*)(wsp + WS_SP); bf16* WRw = (bf16*)(wsp + WS_WR);
        for (int i = bx * NTHR + tid; i < 1024; i += G * NTHR) { const float l = -in[15][i]; SP[i] = fmaxf(l, 0.f) + log1pf(__expf(-fabsf(l))); }
        for (int i = bx * NTHR + tid; i < 2 * 48 * 1024; i += G * NTHR) { const int l = i / (48 * 1024), n = (i / 1024) % 48, k = i % 1024; float v = 0.f;
            if (n < 4) v = in[18][(size_t)l * D * 4 + k * 4 + n]; else if (n < 36) v = in[19][(size_t)l * D * 32 + k * 32 + n - 4];
            WRw[i] = f2bf(v * in[17][l * D + k]); }
        if (BOTH(0)) xcd_barrier(bar, wave);
    }
    if (IN(1)) { PH_PTRS
        pg8::SchedDense S{128, 14, G, bx, (const char*)S0, (const char*)W1, (size_t)256 * 1024 * 2, (size_t)256 * 1024 * 2, 1, 0};
        EpiG1 E{S1, S1 + (size_t)T * 512, S2, S3, S4, S4 + (size_t)T * 512, EREF, ELAST, ELR, nullptr, RS0, in[4]};
        pg8::gemm_phase<EpiG1, pg8::SchedDense, false>(lds, 1024, 1024, 1024, S, E, wave);
        if (BOTH(1)) xcd_barrier(bar, wave);
    }
    if (IN(2)) { PH_PTRS
        gla_core_phase(lds, S1, S1 + (size_t)T * 512, S2, S3, S4, S4 + (size_t)T * 512, EREF, ELAST, ELR, S0, bx, G, wave);
        if (G > 32 && bx >= 32) { const int lane = lane_id_v(); CVT_ITEMS(CVT_W1_ITEMS, CVT_ALL_ITEMS, (bx - 32) * NWAVES + wave, (G - 32) * NWAVES); }
        if (BOTH(2)) xcd_barrier(bar, wave);
    }
    if (IN(3)) { PH_PTRS
        pg8::SchedDense S{128, 4, G, bx, (const char*)S0, (const char*)WO, (size_t)256 * 1024 * 2, (size_t)256 * 1024 * 2, 1, 0};
        EpiResidF E{in[0], nullptr, S1};
        pg8::gemm_phase<EpiResidF, pg8::SchedDense, false>(lds, 1024, 1024, 1024, S, E, wave);
        if (BOTH(3)) xcd_barrier(bar, wave);
    }

    LAS int* ts = (LAS int*)(lds + LDS_MISC + TS_OFF);
#define MOE_PHASES(P, LAYER, XIN, RSX, ACTB, YB, XOUT, RSOUT, FW, OUTP) \
    if (IN(P)) { PH_PTRS TIDLANE router_phase(lds, XIN, WR + (size_t)(LAYER) * 48 * 1024, RSX, ctlp + CW_CNT + 64 * (LAYER), LIST, LW, POS, bx, G, tid, lane, wave); if (BOTH(P)) xcd_barrier(bar, wave); } \
    if (IN(P + 1)) { PH_PTRS TIDLANE build_ts(ctlp + CW_CNT + 64 * (LAYER), ts, tid); \
        pg8::SchedMoe S{ts, G, bx, 2, (const char*)(XIN), (const char*)(WGU + (size_t)(LAYER) * 32 * 512 * 1024), LIST, (size_t)512 * 1024 * 2, (size_t)256 * 1024 * 2, 0, true}; \
        EpiM1 E{ACTB, LIST, LW, RSX}; \
        pg8::gemm_phase<EpiM1, pg8::SchedMoe, true>(lds, 1024, 1024, 1024, S, E, wave); if (BOTH(P + 1)) xcd_barrier(bar, wave); } \
    if (IN(P + 2)) { PH_PTRS TIDLANE build_ts(ctlp + CW_CNT + 64 * (LAYER), ts, tid); \
        pg8::SchedMoe S{ts, G, bx, 4, (const char*)(ACTB), (const char*)(WD + (size_t)(LAYER) * 32 * 1024 * 256), LIST, (size_t)1024 * 256 * 2, (size_t)256 * 256 * 2, (size_t)256 * 256 * 2, false}; \
        EpiStore E{YB, 1024, 0}; \
        pg8::gemm_phase<EpiStore, pg8::SchedMoe, false>(lds, 256, 256, 256, S, E, wave); if (BOTH(P + 2)) xcd_barrier(bar, wave); } \
    if (IN(P + 3)) { PH_PTRS TIDLANE build_ts(ctlp + CW_CNT + 64 * (LAYER), ts, tid); \
        combine_phase(ts, XIN, YB, POS, XOUT, RSOUT, FW, OUTP, bx, G, lane, wave); if (BOTH(P + 3)) xcd_barrier(bar, wave); }

    MOE_PHASES(4, 0, S1, RS1, S2, S3, S0, RS2, nullptr, nullptr)
    if (IN(8)) { PH_PTRS
        pg8::SchedDense S{128, 8, G, bx, (const char*)S0, (const char*)WLI, (size_t)256 * 1024 * 2, (size_t)256 * 1024 * 2, 1, 0};
        EpiL1 E{S1, S2, RS2};
        pg8::gemm_phase<EpiL1, pg8::SchedDense, false>(lds, 1024, 1024, 1024, S, E, wave);
        if (BOTH(8)) xcd_barrier(bar, wave);
    }
    if (IN(9)) { PH_PTRS TIDLANE conv_phase(S1, in[9], in[10], S3, bx, G, tid); if (BOTH(9)) xcd_barrier(bar, wave); }
    if (IN(10)) { PH_PTRS
        pg8::SchedDense S{128, 8, G, bx, (const char*)S3, (const char*)WG, (size_t)256 * 1024 * 2, (size_t)256 * 256 * 2, 2, (size_t)512};
        EpiL2 E{S3, S4, S5, in[12], in[14], (const float*)(wsp + WS_SP)};
        pg8::gemm_phase<EpiL2, pg8::SchedDense, false>(lds, 1024, 256, 256, S, E, wave);
        if (BOTH(10)) xcd_barrier(bar, wave);
    }
    if (IN(11)) { PH_PTRS TIDLANE scan_a_phase(lds, S4, S5, (float*)(wsp + WS_AGG), (float*)(wsp + WS_CARRY), bx, G, tid); if (BOTH(11)) xcd_barrier(bar, wave); }
    if (IN(12)) { PH_PTRS TIDLANE scan_c_phase(S4, S5, S2, (const float*)(wsp + WS_AGG), (const float*)(wsp + WS_CARRY), S1, bx, G, tid); if (BOTH(12)) xcd_barrier(bar, wave); }
    if (IN(13)) { PH_PTRS
        pg8::SchedDense S{128, 4, G, bx, (const char*)S1, (const char*)WLO, (size_t)256 * 1024 * 2, (size_t)256 * 1024 * 2, 1, 0};
        EpiResidF E{nullptr, S0, S5};
        pg8::gemm_phase<EpiResidF, pg8::SchedDense, false>(lds, 1024, 1024, 1024, S, E, wave);
        if (BOTH(13)) xcd_barrier(bar, wave);
    }
    MOE_PHASES(14, 1, S5, RS3, S3, S0, (bf16*)nullptr, (float*)nullptr, in[23], args.out)
#undef MOE_PHASES
#undef PH_PTRS
#undef TIDLANE
#undef CVT_ITEMS
#undef IN
#undef BOTH
}

static int mega_grid() {
    static int grid = 0;
    if (grid == 0) {
        int dev = 0, cus = 0;
        if (hipGetDevice(&dev) != hipSuccess || hipDeviceGetAttribute(&cus, hipDeviceAttributeMultiprocessorCount, dev) != hipSuccess) { grid = -1; return grid; }
        if (hipFuncSetAttribute((const void*)mega, hipFuncAttributeMaxDynamicSharedMemorySize, LDS_BYTES) != hipSuccess) { fprintf(stderr, "hipFuncSetAttribute failed\n"); grid = -1; return grid; }
        int per_cu = 0;
        if (hipOccupancyMaxActiveBlocksPerMultiprocessor(&per_cu, (const void*)mega, NTHR, LDS_BYTES) != hipSuccess || per_cu < 1) { fprintf(stderr, "occupancy query: %d\n", per_cu); (void)hipGetLastError(); }
        grid = cus;
    }
    return grid;
}
static void launch_mega(const MArgs& base, int lo, int hi, int li, hipStream_t stream) {
    MArgs a = base; a.ph_lo = lo; a.ph_hi = hi; a.li = li; a.pad = 0;
    hipLaunchKernelGGL(mega, dim3(mega_grid()), dim3(NTHR), LDS_BYTES, stream, a);
}
extern "C" void kernel_launch(void* const* d_in, const int* in_sizes, int n_in, void* d_out, int out_size, void* d_ws, size_t ws_size, hipStream_t stream) {
    if (n_in != 24 || out_size != T * D || ws_size < WS_END) { fprintf(stderr, "kernel_launch: unexpected shapes (n_in %d out %d ws %zu)\n", n_in, out_size, ws_size); return; }
    if (mega_grid() <= 0) return;
    const float* const* in = (const float* const*)d_in; unsigned char* ws = (unsigned char*)d_ws;
    (void)hipMemsetAsync(ws + WS_CTL, 0, 1 * MiB, stream);
    MArgs base{}; for (int i = 0; i < 24; ++i) base.in[i] = in[i]; base.out = (float*)d_out; base.ws = ws;
    launch_mega(base, 0, 18, 0, stream);
}
```

```cpp
#include <hip/hip_runtime.h>
#include <cstdio>
#include <cstdint>

typedef unsigned short bf16;
constexpr int T = 32768, D = 1024, SEQ = 4096, NB = 8;
constexpr float EPS = 1e-6f;
constexpr size_t MiB = 1u << 20;
constexpr size_t WS_CTL = 0;
constexpr size_t WS_RS0 = 1 * MiB, WS_RS1 = WS_RS0 + 128 * 1024, WS_RS2 = WS_RS1 + 128 * 1024, WS_RS3 = WS_RS2 + 128 * 1024;
constexpr size_t WS_EREF = 2 * MiB, WS_ELAST = 3 * MiB, WS_ELR = 4 * MiB;
constexpr size_t WS_S0 = 128 * MiB, WS_S1 = 192 * MiB, WS_S2 = 256 * MiB, WS_S3 = 320 * MiB, WS_S4 = 384 * MiB, WS_S5 = 448 * MiB, WS_END = 512 * MiB;

__device__ __forceinline__ float bf2f(bf16 b) { return __uint_as_float(((unsigned)b) << 16); }
__device__ __forceinline__ bf16 f2bf(float f) { unsigned u = __float_as_uint(f); u += 0x7fffu + ((u >> 16) & 1u); return (bf16)(u >> 16); }
__device__ __forceinline__ float wave_sum(float v) {
#pragma unroll
    for (int o = 1; o < 64; o <<= 1) v += __shfl_xor(v, o);
    return v;
}
__device__ __forceinline__ float sigmoidf_(float x) { return 1.f / (1.f + __expf(-x)); }
__device__ __forceinline__ float siluf_(float x) { return x / (1.f + __expf(-x)); }
__device__ __forceinline__ float logsigmoidf_(float x) { return fminf(x, 0.f) - log1pf(__expf(-fabsf(x))); }
__device__ __forceinline__ float softplusf_(float x) { return fmaxf(x, 0.f) + log1pf(__expf(-fabsf(x))); }
__device__ __forceinline__ float gelu_tanhf_(float x) { const float u = 0.7978845608028654f * (x + 0.044715f * x * x * x); return 0.5f * x * (1.f + tanhf(u)); }

__global__ void __launch_bounds__(256) n_prologue(const float* x, bf16* XB, float* RS) {
    const int row = blockIdx.x * 4 + (threadIdx.x >> 6), lane = threadIdx.x & 63;
    const float* xr = x + (size_t)row * D; float s = 0.f;
    for (int i = lane; i < D; i += 64) { const float v = xr[i]; s += v * v; XB[(size_t)row * D + i] = f2bf(v); }
    s = wave_sum(s);
    if (lane == 0) RS[row] = rsqrtf(s * (1.f / D) + EPS);
}

template <class Epi>
__global__ void __launch_bounds__(256) n_gemm(const bf16* A, int lda, const float* rs, const float* nw, const float* W, int ldw, int M, int N, int K, Epi epi) {
    __shared__ float As[16][65], Ws[16][64];
    const int tid = threadIdx.x, tx = tid & 15, ty = tid >> 4, m0 = blockIdx.y * 64, n0 = blockIdx.x * 64;
    float acc[4][4];
#pragma unroll
    for (int i = 0; i < 4; ++i)
#pragma unroll
        for (int j = 0; j < 4; ++j) acc[i][j] = 0.f;
    for (int k0 = 0; k0 < K; k0 += 16) {
#pragma unroll
        for (int i = 0; i < 4; ++i) { const int idx = tid + 256 * i, r = idx >> 4, kk = idx & 15; As[kk][r] = bf2f(A[(size_t)(m0 + r) * lda + k0 + kk]) * (nw ? nw[k0 + kk] : 1.f); }
#pragma unroll
        for (int i = 0; i < 4; ++i) { const int idx = tid + 256 * i, kk = idx >> 6, n = idx & 63; Ws[kk][n] = (n0 + n < N) ? W[(size_t)(k0 + kk) * ldw + n0 + n] : 0.f; }
        __syncthreads();
#pragma unroll
        for (int kk = 0; kk < 16; ++kk) {
            float a[4], b[4];
#pragma unroll
            for (int i = 0; i < 4; ++i) a[i] = As[kk][ty * 4 + i];
#pragma unroll
            for (int j = 0; j < 4; ++j) b[j] = Ws[kk][tx + 16 * j];
#pragma unroll
            for (int i = 0; i < 4; ++i)
#pragma unroll
                for (int j = 0; j < 4; ++j) acc[i][j] += a[i] * b[j];
        }
        __syncthreads();
    }
#pragma unroll
    for (int i = 0; i < 4; ++i) { const int r = m0 + ty * 4 + i; const float sc = rs ? rs[r] : 1.f;
#pragma unroll
        for (int j = 0; j < 4; ++j) { const int c = n0 + tx + 16 * j; if (c < N) epi(r, c, acc[i][j] * sc); } }
}
struct EpiGlaProj { bf16 *Q, *Kb, *V, *SG; float* LR;
    __device__ void operator()(int r, int c, float v) const {
        if (c < 512) Q[(size_t)r * 512 + c] = f2bf(v);
        else if (c < 1024) Kb[(size_t)r * 512 + c - 512] = f2bf(v);
        else if (c < 2048) V[(size_t)r * 1024 + c - 1024] = f2bf(v);
        else if (c < 3072) SG[(size_t)r * 1024 + c - 2048] = f2bf(siluf_(v));
        else LR[(size_t)r * 16 + c - 3072] = v; } };
struct EpiResid { const float* xf; const bf16* xb; bf16* out;
    __device__ void operator()(int r, int c, float v) const { const size_t i = (size_t)r * D + c; out[i] = f2bf((xf ? xf[i] : bf2f(xb[i])) + v); } };
struct EpiLruIn { bf16 *XBR, *GATE;
    __device__ void operator()(int r, int c, float v) const { if (c < 1024) XBR[(size_t)r * D + c] = f2bf(v); else GATE[(size_t)r * D + c - 1024] = f2bf(gelu_tanhf_(v)); } };
struct EpiGate { bf16* O; const float* bias; int coff; int pad;
    __device__ void operator()(int r, int c, float v) const { O[(size_t)r * D + coff + c] = f2bf(sigmoidf_(v + bias[coff + c])); } };

__global__ void __launch_bounds__(256) n_gla_prep(const float* LR, const float* w_alpha, const float* b_alpha, bf16* EQ, bf16* EK, float* EREF, float* ELAST, float* ELR, float* AF) {
    const int gi = blockIdx.x * 256 + threadIdx.x, chunk = gi >> 9, col = gi & 511;
    float wa[16];
#pragma unroll
    for (int r = 0; r < 16; ++r) wa[r] = w_alpha[r * 512 + col];
    const float ba = b_alpha[col];
    float cum = 0.f, ref = 0.f;
    for (int i = 0; i < 64; ++i) { const float* lr = LR + (size_t)(chunk * 64 + i) * 16; float z = ba;
#pragma unroll
        for (int r = 0; r < 16; ++r) z += lr[r] * wa[r];
        const float la = logsigmoidf_(z) * (1.f / 16.f); cum += la; if (i == 32) ref = cum; AF[(size_t)(chunk * 64 + i) * 512 + col] = __expf(la); }
    const float last = cum;
    EREF[chunk * 512 + col] = __expf(ref); ELAST[chunk * 512 + col] = __expf(last); ELR[chunk * 512 + col] = __expf(last - ref);
    cum = 0.f;
    for (int i = 0; i < 64; ++i) { const float* lr = LR + (size_t)(chunk * 64 + i) * 16; float z = ba;
#pragma unroll
        for (int r = 0; r < 16; ++r) z += lr[r] * wa[r];
        cum += logsigmoidf_(z) * (1.f / 16.f);
        const size_t o = (size_t)(chunk * 64 + i) * 512 + col;
        EQ[o] = f2bf(0.08838834764831845f * __expf(cum - ref)); EK[o] = f2bf(__expf(ref - cum)); }
}
__global__ void __launch_bounds__(256) n_gla_core(const bf16* Q, const bf16* Kb, const bf16* V, const bf16* SG, const float* AF, const float* hn, bf16* OG) {
    __shared__ float red[4];
    const int bh = blockIdx.x, b = bh >> 2, h = bh & 3, e = threadIdx.x, lane = e & 63, w = e >> 6;
    float S[128];
#pragma unroll
    for (int d = 0; d < 128; ++d) S[d] = 0.f;
    const float hw = hn[e];
    for (int t = 0; t < SEQ; ++t) {
        const size_t row = (size_t)b * SEQ + t;
        const float v = bf2f(V[row * 1024 + h * 256 + e]);
        const float* a = AF + row * 512 + h * 128; const bf16* k = Kb + row * 512 + h * 128; const bf16* q = Q + row * 512 + h * 128;
        float o = 0.f;
#pragma unroll
        for (int d = 0; d < 128; ++d) { S[d] = a[d] * S[d] + bf2f(k[d]) * v; o += bf2f(q[d]) * S[d]; }
        o *= 0.08838834764831845f;
        float ss = wave_sum(o * o);
        __syncthreads();
        if (lane == 0) red[w] = ss;
        __syncthreads();
        ss = red[0] + red[1] + red[2] + red[3];
        const float rstd = rsqrtf(ss * (1.f / 256.f) + EPS);
        OG[row * 1024 + h * 256 + e] = f2bf(o * rstd * hw * bf2f(SG[row * 1024 + h * 256 + e]));
    }
}
__global__ void __launch_bounds__(256) n_moe(const bf16* Xin, const float* nw, const float* wg, const float* we, const float* Wgate, const float* Wup, const float* Wdown,
                                             bf16* Xout, float* RSout, const float* final_w, float* out) {
    __shared__ float hs[1024], logit[36], act[256], red[4]; __shared__ int sel[2]; __shared__ float selw[2];
    const int t = blockIdx.x, tid = threadIdx.x, lane = tid & 63, w = tid >> 6;
    float xv[4]; float s = 0.f;
#pragma unroll
    for (int i = 0; i < 4; ++i) { xv[i] = bf2f(Xin[(size_t)t * D + tid + 256 * i]); s += xv[i] * xv[i]; }
    s = wave_sum(s); if (lane == 0) red[w] = s; __syncthreads();
    const float rstd = rsqrtf((red[0] + red[1] + red[2] + red[3]) * (1.f / D) + EPS);
#pragma unroll
    for (int i = 0; i < 4; ++i) hs[tid + 256 * i] = xv[i] * rstd * nw[tid + 256 * i];
    __syncthreads();
    for (int li = w * 9; li < w * 9 + 9; ++li) { float p = 0.f;
        for (int k = lane; k < D; k += 64) p += hs[k] * (li < 4 ? wg[k * 4 + li] : we[k * 32 + li - 4]);
        p = wave_sum(p); if (lane == 0) logit[li] = p; }
    __syncthreads();
    if (tid == 0) {
        int g = 0; float gm = logit[0];
        for (int i = 1; i < 4; ++i) if (logit[i] > gm) { gm = logit[i]; g = i; }
        float gs = 0.f; for (int i = 0; i < 4; ++i) gs += __expf(logit[i] - gm);
        const float pg = 1.f / gs;
        const float* el = logit + 4 + g * 8; int e0 = 0; float m0 = el[0];
        for (int i = 1; i < 8; ++i) if (el[i] > m0) { m0 = el[i]; e0 = i; }
        int e1 = -1; float m1 = -3.0e38f;
        for (int i = 0; i < 8; ++i) if (i != e0 && el[i] > m1) { m1 = el[i]; e1 = i; }
        const float p1 = __expf(m1 - m0), den = 1.f + p1;
        sel[0] = g * 8 + e0; sel[1] = g * 8 + e1; selw[0] = pg / den; selw[1] = pg * p1 / den;
    }
    __syncthreads();
    float oacc[4] = {0.f, 0.f, 0.f, 0.f};
    for (int kk = 0; kk < 2; ++kk) {
        const int e = sel[kk]; const float wt = selw[kk];
        const float* G = Wgate + (size_t)e * D * 256; const float* U = Wup + (size_t)e * D * 256; const float* Dn = Wdown + (size_t)e * 256 * D;
        float ga = 0.f, ua = 0.f;
        for (int k = 0; k < D; ++k) { const float hv = hs[k]; ga += hv * G[k * 256 + tid]; ua += hv * U[k * 256 + tid]; }
        __syncthreads();
        act[tid] = siluf_(ga) * ua;
        __syncthreads();
        float o4[4] = {0.f, 0.f, 0.f, 0.f};
        for (int f = 0; f < 256; ++f) { const float av = act[f];
#pragma unroll
            for (int i = 0; i < 4; ++i) o4[i] += av * Dn[(size_t)f * D + tid + 256 * i]; }
#pragma unroll
        for (int i = 0; i < 4; ++i) oacc[i] += wt * o4[i];
    }
    float s2 = 0.f;
#pragma unroll
    for (int i = 0; i < 4; ++i) { xv[i] += oacc[i]; s2 += xv[i] * xv[i]; }
    s2 = wave_sum(s2); __syncthreads(); if (lane == 0) red[w] = s2; __syncthreads();
    const float rstd2 = rsqrtf((red[0] + red[1] + red[2] + red[3]) * (1.f / D) + EPS);
    if (out) {
#pragma unroll
        for (int i = 0; i < 4; ++i) out[(size_t)t * D + tid + 256 * i] = xv[i] * rstd2 * final_w[tid + 256 * i];
    } else {
#pragma unroll
        for (int i = 0; i < 4; ++i) Xout[(size_t)t * D + tid + 256 * i] = f2bf(xv[i]);
        if (tid == 0) RSout[t] = rstd2;
    }
}
__global__ void __launch_bounds__(256) n_conv(const bf16* XBR, const float* cw, const float* cb, bf16* XC) {
    const size_t i = (size_t)blockIdx.x * 256 + threadIdx.x; const int c = (int)(i & 1023); const int row = (int)(i >> 10), s = row & (SEQ - 1);
    float v = cb[c];
#pragma unroll
    for (int tap = 0; tap < 4; ++tap) { const int ss = s - 3 + tap; if (ss >= 0) v += cw[tap * 1024 + c] * bf2f(XBR[(size_t)(row - 3 + tap) * D + c]); }
    XC[i] = f2bf(v);
}
__global__ void __launch_bounds__(256) n_lru_scan(const bf16* XC, const bf16* RG, const bf16* IG, const bf16* GATE, const float* lam, bf16* YL) {
    const int gi = blockIdx.x * 256 + threadIdx.x, b = gi >> 10, c = gi & 1023;
    const float sp = softplusf_(-lam[c]); float h = 0.f;
    for (int t = 0; t < SEQ; ++t) { const size_t i = ((size_t)b * SEQ + t) * D + c;
        const float la = -8.f * bf2f(RG[i]) * sp, a = __expf(la), mult = sqrtf(-expm1f(2.f * la));
        h = a * h + bf2f(XC[i]) * bf2f(IG[i]) * mult;
        YL[i] = f2bf(h * bf2f(GATE[i])); }
}


#define LAS __attribute__((address_space(3)))
#define GAS __attribute__((address_space(1)))
typedef short bf16x8 __attribute__((ext_vector_type(8)));
typedef float f32x4 __attribute__((ext_vector_type(4)));
typedef float f32x2 __attribute__((ext_vector_type(2)));
typedef unsigned u32x4 __attribute__((ext_vector_type(4)));
typedef unsigned u32x2 __attribute__((ext_vector_type(2)));
typedef GAS unsigned gu32;
#define RLX_AGENT __ATOMIC_RELAXED, __HIP_MEMORY_SCOPE_AGENT
constexpr int NWAVES = 8, NTHR = 512;
constexpr int LDS_STAGE = 131072, LDS_MISC = LDS_STAGE, LDS_BYTES = 147456;
constexpr float QSCALE = 0.08838834764831845f;

constexpr size_t WS_SP = 1 * MiB + 512 * 1024;
constexpr size_t WS_WR = 14 * MiB;
constexpr size_t WS_W1 = 16 * MiB;
constexpr size_t WS_WO = WS_W1 + (size_t)3584 * 1024 * 2;
constexpr size_t WS_WLI = WS_WO + (size_t)1024 * 1024 * 2;
constexpr size_t WS_WLO = WS_WLI + (size_t)2048 * 1024 * 2;
constexpr size_t WS_WG = WS_WLO + (size_t)1024 * 1024 * 2;
constexpr size_t WS_WGU = WS_WG + (size_t)4 * 512 * 256 * 2;
constexpr size_t WS_WD = WS_WGU + (size_t)64 * 512 * 1024 * 2;
static_assert(WS_WD + (size_t)64 * 1024 * 256 * 2 <= WS_S0, "weights fit below the activation slots");
constexpr int CW_TMO = 0, CW_BAR = 4096;

__device__ __forceinline__ unsigned cvt_pk_bf16(float lo, float hi) { unsigned r; asm volatile("v_cvt_pk_bf16_f32 %0, %1, %2" : "=v"(r) : "v"(lo), "v"(hi)); return r; }
__device__ __forceinline__ float fexp(float x) { return __builtin_amdgcn_exp2f(x * 1.4426950408889634f); }
__device__ __forceinline__ float flog(float x) { return __builtin_amdgcn_logf(x) * 0.6931471805599453f; }
__device__ __forceinline__ float frcp(float x) { return __builtin_amdgcn_rcpf(x); }
__device__ __forceinline__ float fsilu(float x) { return x * frcp(1.f + fexp(-x)); }
__device__ __forceinline__ float fsigmoid(float x) { return frcp(1.f + fexp(-x)); }
__device__ __forceinline__ float flogsigmoid(float x) { return fminf(x, 0.f) - flog(1.f + fexp(-fabsf(x))); }
__device__ __forceinline__ float fgelu_tanh(float x) { const float u = 1.5957691216057308f * (x + 0.044715f * x * x * x); return x * frcp(1.f + fexp(-u)); }
__device__ __forceinline__ int lane_id_v() { int l; asm volatile("v_mbcnt_lo_u32_b32 %0, -1, 0\n\tv_mbcnt_hi_u32_b32 %0, -1, %0" : "=v"(l)); return l; }
template <int N> __device__ __forceinline__ float dpp_shr(float v) {
    return __builtin_bit_cast(float, __builtin_amdgcn_update_dpp(0, __builtin_bit_cast(int, v), 0x110 + N, 0xf, 0xf, true)); }

#define XB_TMO      128
#define XB_XCNT(j)  (256  + 64 * (j))
#define XB_XSUB(j)  (1280 + 64 * (j))
#define XB_XGEN(j)  (2304 + 64 * (j))
#define XB_TOP      3328
#define XB_TOPGEN   3392
#define XCD_BAR_WORDS 3456
#define XB_SPIN_CAP (1u << 18)
__device__ __forceinline__ unsigned xb_ld(unsigned* p)              { return __hip_atomic_load(p, __ATOMIC_RELAXED, __HIP_MEMORY_SCOPE_AGENT); }
__device__ __forceinline__ unsigned xb_add(unsigned* p, unsigned v) { return __hip_atomic_fetch_add(p, v, __ATOMIC_RELAXED, __HIP_MEMORY_SCOPE_AGENT); }
__device__ __forceinline__ unsigned xb_xcc_id() { return (unsigned)__builtin_amdgcn_s_getreg((3 << 11) | 20) & 0xFu; }
#define XB_SPIN(cond, bar) do { unsigned _sp = 0; while (cond) { __builtin_amdgcn_s_sleep(1); \
    if ((++_sp & 255u) == 0u) { if (xb_ld(&(bar)[XB_TMO])) break; if (_sp > XB_SPIN_CAP) { atomicAdd(&(bar)[XB_TMO], 1u); break; } } } } while (0)
struct XcdBarrier { unsigned* bar; unsigned x; volatile LAS unsigned* st; };
__device__ __forceinline__ XcdBarrier xcd_barrier_post(unsigned* bar, volatile LAS unsigned* st, bool t0) {
    XcdBarrier b; b.bar = bar; b.x = xb_xcc_id(); b.st = st;
    if (t0) (void)xb_add(&bar[XB_XCNT(b.x)], 1u);
    return b;
}
__device__ __forceinline__ void xcd_barrier_complete(unsigned* bar, unsigned x, unsigned& nloc, unsigned& nx) {
    const unsigned G = gridDim.x * gridDim.y * gridDim.z;
    unsigned sum, cnt, mine, sp = 0u;
    for (;;) {
        sum = 0u; cnt = 0u; mine = 0u;
#pragma unroll
        for (unsigned j = 0; j < 16; ++j) { const unsigned c = xb_ld(&bar[XB_XCNT(j)]); sum += c; cnt += (c > 0u) ? 1u : 0u; mine = (j == x) ? c : mine; }
        if (sum == G) break;
        __builtin_amdgcn_s_sleep(1);
        if ((++sp & 255u) == 0u) { if (xb_ld(&bar[XB_TMO])) break; if (sp > XB_SPIN_CAP) { atomicAdd(&bar[XB_TMO], 1u); break; } }
    }
    nloc = mine > 0u ? mine : 1u; nx = cnt > 0u ? cnt : 1u;
}
__device__ __forceinline__ void xcd_barrier(const XcdBarrier& b, int wave_) {
    asm volatile("s_waitcnt vmcnt(0)" ::: "memory");
    __syncthreads();
    if (wave_ == 0 && lane_id_v() == 0) {
        unsigned* bar = b.bar;
        __builtin_amdgcn_s_waitcnt(0);
        unsigned nloc = b.st[0], nx = b.st[1];
        if (nloc == 0u) { xcd_barrier_complete(bar, b.x, nloc, nx); b.st[0] = nloc; b.st[1] = nx; }
        const unsigned old = xb_add(&bar[XB_XSUB(b.x)], 1u);
        const unsigned gen = old / nloc;
        if (old + 1u == (gen + 1u) * nloc) {
            __builtin_amdgcn_fence(__ATOMIC_RELEASE, "agent");
            asm volatile("s_waitcnt vmcnt(0)" ::: "memory");
            const unsigned og = xb_add(&bar[XB_TOP], 1u);
            const unsigned tg = og / nx;
            if (og + 1u == (tg + 1u) * nx) xb_add(&bar[XB_TOPGEN], 1u);
            else XB_SPIN(xb_ld(&bar[XB_TOPGEN]) == tg, bar);
            __builtin_amdgcn_fence(__ATOMIC_ACQUIRE, "agent");
            xb_add(&bar[XB_XGEN(b.x)], 1u);
            asm volatile("s_waitcnt vmcnt(0)" ::: "memory");
        } else {
            XB_SPIN(xb_ld(&bar[XB_XGEN(b.x)]) == gen, bar);
            __builtin_amdgcn_fence(__ATOMIC_ACQUIRE, "agent");
            asm volatile("s_waitcnt vmcnt(0)" ::: "memory");
        }
    }
    __syncthreads();
}

namespace pg8 {
constexpr int BM = 256, BK = 64, HALF = 128, HTB = HALF * BK * 2, NXCD = 8, WGM = 8;
__device__ __forceinline__ int lds_byte(int r, int c) { const int st = (r >> 4) * 2 + (c >> 5), rr = r & 15, cc = c & 31, ob = rr * 64 + cc * 2; return st * 1024 + (ob ^ (((ob >> 9) & 1) << 5)); }
__device__ __forceinline__ void stage_rc(int b, int& R, int& C) { const int st = b / 1024, sb = b % 1024, swz = sb ^ (((sb >> 9) & 1) << 5); R = (st >> 1) * 16 + swz / 64; C = (st & 1) * 32 + (swz % 64) / 2; }
__device__ __forceinline__ int perm32(int rho) { const int n = rho >> 4, i = rho & 15; return 8 * (i >> 2) + 4 * n + (i & 3); }
__device__ __forceinline__ void tile_order(int L, int nM, int nN, int& pm, int& pn) {
    const int nwg = nM * nN; int wgid = L; { const int q = nwg / NXCD, r = nwg % NXCD, xcd = wgid % NXCD, off = wgid / NXCD; wgid = (xcd < r ? xcd * (q + 1) : r * (q + 1) + (xcd - r) * q) + off; }
    const int nig = WGM * nN, gid = wgid / nig, fm = gid * WGM, gsz = (nM - fm) < WGM ? (nM - fm) : WGM;
    pm = fm + ((wgid % nig) % gsz); pn = (wgid % nig) / gsz;
}
struct Unit { const char* a; const char* b; const int* rows; int pm, pn, e; };

template <class Epi, class Sched, bool GATHER>
__device__ __forceinline__ void gemm_phase(LAS unsigned char* lds, const int lda, const int ldb, const int K, const Sched& S, const Epi& E, const int wid) {
    const int lane = lane_id_v(), tid = wid * 64 + lane, wr = wid >> 2, wc = wid & 3, fr = lane & 15, fq = lane >> 4;
    int nt = K / BK; asm volatile("" : "+s"(nt));
    int Rr[2], Cc[2]; unsigned voffB[2];
#pragma unroll
    for (int i = 0; i < 2; ++i) { int R, C; stage_rc(tid * 16 + i * 8192, R, C); Rr[i] = R; Cc[i] = C; const int Rb = (R & ~31) + perm32(R & 31); voffB[i] = (unsigned)(Rb * ldb + C) * 2u; }
    const size_t kstep = (size_t)(BK * 2);
    const size_t hstepB = (size_t)HALF * ldb * 2;
    const unsigned ldsw = (unsigned)wid * 1024u;
    const int aoff = lds_byte(wr * 64 + fr, fq * 8), boff = lds_byte(wc * 32 + fr, fq * 8);
#define PG8_SA(b, h) (((b) * 2 + (h)) * HTB)
#define PG8_SB(b, h) ((4 + (b) * 2 + (h)) * HTB)
#define PG8_STAGE(bufoff, gbase, voff) do { _Pragma("unroll") for (int _i = 0; _i < 2; ++_i) \
        __builtin_amdgcn_global_load_lds((const unsigned*)((const char*)(gbase) + (voff)[_i]), (LAS unsigned*)(lds + (bufoff) + ldsw + _i * 8192), 16, 0, 0); } while (0)
#define PG8_LDA(dst, b, h) do { _Pragma("unroll") for (int m = 0; m < 4; ++m) _Pragma("unroll") for (int k = 0; k < 2; ++k) dst[m][k] = *(const LAS bf16x8*)(lds + PG8_SA(b, h) + aoff + m * 2048 + k * 1024); } while (0)
#define PG8_LDB(dst, b, h) do { _Pragma("unroll") for (int n = 0; n < 2; ++n) _Pragma("unroll") for (int k = 0; k < 2; ++k) dst[n][k] = *(const LAS bf16x8*)(lds + PG8_SB(b, h) + boff + n * 2048 + k * 1024); } while (0)
#define PG8_MMA(ai, bj, At, Bt) do { __builtin_amdgcn_s_setprio(1); _Pragma("unroll") for (int m = 0; m < 4; ++m) _Pragma("unroll") for (int n = 0; n < 2; ++n) _Pragma("unroll") for (int k = 0; k < 2; ++k) \
        acc[ai][bj][m][n] = __builtin_amdgcn_mfma_f32_16x16x32_bf16(Bt[n][k], At[m][k], acc[ai][bj][m][n], 0, 0, 0); __builtin_amdgcn_s_setprio(0); } while (0)
#define PG8_WAIT_V(n) asm volatile("s_waitcnt vmcnt(" #n ")" ::: "memory")
#define PG8_WAIT_L(n) asm volatile("s_waitcnt lgkmcnt(" #n ")" ::: "memory")
#define PG8_BAR __builtin_amdgcn_s_barrier()
#define PG8_SCHED __builtin_amdgcn_sched_barrier(0)
#define PG8_SETVOFF(v, u) do { _Pragma("unroll") for (int _h = 0; _h < 2; ++_h) _Pragma("unroll") for (int _i = 0; _i < 2; ++_i) { \
        if (GATHER) { unsigned _tk = (unsigned)(u).rows[_h * HALF + Rr[_i]]; _tk = _tk < (unsigned)T ? _tk : 0u; (v)[_h][_i] = (_tk * (unsigned)lda + (unsigned)Cc[_i]) * 2u; } else (v)[_h][_i] = (unsigned)(((_h * HALF + Rr[_i]) * lda + Cc[_i]) * 2); } } while (0)
    Unit cur, nxt; int ui = 0;
    if (!S.next(0, cur)) return;
    f32x4 acc[2][2][4][2];
#pragma unroll
    for (int a = 0; a < 2; ++a)
#pragma unroll
        for (int b = 0; b < 2; ++b)
#pragma unroll
            for (int m = 0; m < 4; ++m)
#pragma unroll
                for (int n = 0; n < 2; ++n) acc[a][b][m][n] = (f32x4){0.f, 0.f, 0.f, 0.f};
    bf16x8 At[4][2], B0[2][2], B1[2][2];
    unsigned vA[2][2], vN[2][2];
    PG8_SETVOFF(vA, cur);
    if (GATHER) asm volatile("" :: "v"(vA[0][0]), "v"(vA[0][1]), "v"(vA[1][0]), "v"(vA[1][1]));
    const char* cA = cur.a; const char* cB = cur.b;
    PG8_STAGE(PG8_SB(0, 0), cB, voffB); PG8_STAGE(PG8_SB(0, 1), cB + hstepB, voffB); PG8_STAGE(PG8_SA(0, 0), cA, vA[0]); PG8_STAGE(PG8_SA(0, 1), cA, vA[1]);
    if (wr == 1) PG8_BAR;
    PG8_WAIT_V(2); PG8_BAR;
    PG8_STAGE(PG8_SB(1, 0), cB + kstep, voffB); PG8_STAGE(PG8_SA(1, 0), cA + kstep, vA[0]); PG8_STAGE(PG8_SB(1, 1), cB + hstepB + kstep, voffB);
    PG8_WAIT_V(6); PG8_BAR;
    for (;;) {
        const bool has_next = S.next(ui + 1, nxt);
        const char* nA = has_next ? nxt.a : cA; const char* nB = has_next ? nxt.b : cB;
        if (GATHER) {
            if (has_next) { PG8_SETVOFF(vN, nxt); } else {
#pragma unroll
                for (int h = 0; h < 2; ++h)
#pragma unroll
                    for (int i = 0; i < 2; ++i) vN[h][i] = vA[h][i]; }
            asm volatile("" :: "v"(vN[0][0]), "v"(vN[0][1]), "v"(vN[1][0]), "v"(vN[1][1]));
        }
#pragma nounroll
        for (int t = 0; t < nt; t += 2) {
            const bool last = (t == nt - 2);
            const char* a1 = cA + (size_t)(t + 1) * kstep;
            const char* a2 = last ? nA : cA + (size_t)(t + 2) * kstep; const char* b2 = last ? nB : cB + (size_t)(t + 2) * kstep;
            const char* a3 = a2 + kstep; const char* b3 = b2 + kstep;
            PG8_LDB(B0, 0, 0); PG8_LDB(B1, 0, 1); PG8_SCHED; PG8_LDA(At, 0, 0); PG8_STAGE(PG8_SA(1, 1), a1, vA[1]);
            if (GATHER && last) {
#pragma unroll
                for (int h = 0; h < 2; ++h)
#pragma unroll
                    for (int i = 0; i < 2; ++i) vA[h][i] = vN[h][i]; }
            PG8_WAIT_V(8); PG8_WAIT_L(0); PG8_BAR; PG8_MMA(0, 0, At, B0); PG8_MMA(0, 1, At, B1); PG8_BAR; PG8_SCHED;
            PG8_LDA(At, 0, 1); PG8_STAGE(PG8_SB(0, 0), b2, voffB); PG8_STAGE(PG8_SB(0, 1), b2 + hstepB, voffB); PG8_STAGE(PG8_SA(0, 0), a2, vA[0]);
            PG8_WAIT_V(8); PG8_WAIT_L(0); PG8_BAR; PG8_MMA(1, 0, At, B0); PG8_MMA(1, 1, At, B1); PG8_BAR; PG8_SCHED;
            PG8_LDB(B0, 1, 0); PG8_LDB(B1, 1, 1); PG8_SCHED; PG8_LDA(At, 1, 0); PG8_STAGE(PG8_SA(0, 1), a2, vA[1]);
            PG8_WAIT_V(8); PG8_WAIT_L(0); PG8_BAR; PG8_MMA(0, 0, At, B0); PG8_MMA(0, 1, At, B1); PG8_BAR; PG8_SCHED;
            PG8_LDA(At, 1, 1); PG8_STAGE(PG8_SB(1, 0), b3, voffB); PG8_STAGE(PG8_SB(1, 1), b3 + hstepB, voffB); PG8_STAGE(PG8_SA(1, 0), a3, vA[0]);
            PG8_WAIT_V(8); PG8_WAIT_L(0); PG8_BAR; PG8_MMA(1, 0, At, B0); PG8_MMA(1, 1, At, B1); PG8_BAR; PG8_SCHED;
        }
        if (wr == 0) PG8_BAR;
        E(acc, cur, wr, wc, fr, fq, lane);
        if (!has_next) break;
#pragma unroll
        for (int a = 0; a < 2; ++a)
#pragma unroll
            for (int b = 0; b < 2; ++b)
#pragma unroll
                for (int m = 0; m < 4; ++m)
#pragma unroll
                    for (int n = 0; n < 2; ++n) acc[a][b][m][n] = (f32x4){0.f, 0.f, 0.f, 0.f};
        cur = nxt; cA = nA; cB = nB; ++ui;
        if (wr == 1) PG8_BAR;
    }
    PG8_WAIT_V(0);
    PG8_BAR;
#undef PG8_SA
#undef PG8_SB
#undef PG8_STAGE
#undef PG8_LDA
#undef PG8_LDB
#undef PG8_MMA
#undef PG8_WAIT_V
#undef PG8_WAIT_L
#undef PG8_BAR
#undef PG8_SCHED
#undef PG8_SETVOFF
}
struct SchedDense {
    int nM, nN, G, c; const char* A; const char* B; size_t a_tile, b_tile; int pn_div; size_t a_pn_step;
    __device__ __forceinline__ bool next(int i, Unit& u) const {
        const long L = (long)i * G + c; if (L >= (long)nM * nN) return false;
        int pm, pn; tile_order((int)L, nM, nN, pm, pn);
        u.pm = pm; u.pn = pn; u.e = 0; u.rows = nullptr; u.a = A + (size_t)pm * a_tile + (size_t)(pn / pn_div) * a_pn_step; u.b = B + (size_t)pn * b_tile; return true;
    }
};
}

__device__ __forceinline__ void unpack8(const u32x4 p, f32x4& r0, f32x4& r1) {
    r0 = (f32x4){__uint_as_float(p.x << 16), __uint_as_float(p.x & 0xffff0000u), __uint_as_float(p.y << 16), __uint_as_float(p.y & 0xffff0000u)};
    r1 = (f32x4){__uint_as_float(p.z << 16), __uint_as_float(p.z & 0xffff0000u), __uint_as_float(p.w << 16), __uint_as_float(p.w & 0xffff0000u)}; }
__device__ __forceinline__ u32x4 pack8(const f32x4 v0, const f32x4 v1) { u32x4 w; w.x = cvt_pk_bf16(v0[0], v0[1]); w.y = cvt_pk_bf16(v0[2], v0[3]); w.z = cvt_pk_bf16(v1[0], v1[1]); w.w = cvt_pk_bf16(v1[2], v1[3]); return w; }

struct EpiG1 {
    bf16 *Q, *Kb, *V, *SG, *EQ, *EK; float *EREF, *ELAST, *ELR, *AF; const float* RS; const float* b_alpha;
    __device__ __forceinline__ void operator()(f32x4 (&acc)[2][2][4][2], const pg8::Unit& u, int wr, int wc, int fr, int fq, int lane) const {
        const int row0 = u.pm * 256 + wr * 64 + fr, pn = u.pn;
        if (pn < 12) {
            bf16* base; int ldc, colt; const bool act = pn >= 8;
            if (pn < 2) { base = Q; ldc = 512; colt = pn * 256; } else if (pn < 4) { base = Kb; ldc = 512; colt = (pn - 2) * 256; }
            else if (pn < 8) { base = V; ldc = 1024; colt = (pn - 4) * 256; } else { base = SG; ldc = 1024; colt = (pn - 8) * 256; }
            const int col0 = colt + wc * 32 + 8 * fq;
#pragma unroll
            for (int ai = 0; ai < 2; ++ai)
#pragma unroll
                for (int m = 0; m < 4; ++m) { const int row = row0 + ai * 128 + m * 16; const float rs = RS[row]; bf16* rowp = base + (size_t)row * ldc + col0;
#pragma unroll
                    for (int bj = 0; bj < 2; ++bj) { f32x4 v0 = acc[ai][bj][m][0] * rs, v1 = acc[ai][bj][m][1] * rs;
                        if (act) {
#pragma unroll
                            for (int j = 0; j < 4; ++j) { v0[j] = fsilu(v0[j]); v1[j] = fsilu(v1[j]); } }
                        u32x4 w; w.x = cvt_pk_bf16(v0[0], v0[1]); w.y = cvt_pk_bf16(v0[2], v0[3]); w.z = cvt_pk_bf16(v1[0], v1[1]); w.w = cvt_pk_bf16(v1[2], v1[3]);
                        *(u32x4*)(rowp + bj * 128) = w; } }
        } else {
            const int colt = (pn - 12) * 256;
#pragma unroll
            for (int ai = 0; ai < 2; ++ai) {
                const int chunk = u.pm * 4 + ai * 2 + wr; float rsv[4];
#pragma unroll
                for (int m = 0; m < 4; ++m) rsv[m] = RS[row0 + ai * 128 + m * 16];
#pragma unroll
                for (int bj = 0; bj < 2; ++bj)
#pragma unroll
                    for (int n = 0; n < 2; ++n) {
                        const int c = colt + bj * 128 + wc * 32 + 8 * fq + 4 * n;
                        const f32x4 ba = *(const f32x4*)(b_alpha + c);
                        f32x4 cum[4]; f32x4 run = (f32x4){0.f, 0.f, 0.f, 0.f};
#pragma unroll
                        for (int m = 0; m < 4; ++m) { const f32x4 z = acc[ai][bj][m][n] * rsv[m] + ba; f32x4 la;
#pragma unroll
                            for (int j = 0; j < 4; ++j) la[j] = flogsigmoid(z[j]) * 0.0625f;
                            if (AF) { f32x4 ea;
#pragma unroll
                                for (int j = 0; j < 4; ++j) ea[j] = fexp(la[j]);
                                *(f32x4*)(AF + (size_t)(row0 + ai * 128 + m * 16) * 512 + c) = ea; }
                            f32x4 tot;
#pragma unroll
                            for (int j = 0; j < 4; ++j) { float v = la[j]; v += dpp_shr<1>(v); v += dpp_shr<2>(v); v += dpp_shr<4>(v); v += dpp_shr<8>(v); la[j] = v; tot[j] = __shfl(v, lane | 15); }
                            cum[m] = la + run; run += tot; }
                        f32x4 ref;
#pragma unroll
                        for (int j = 0; j < 4; ++j) ref[j] = __shfl(cum[2][j], lane & 48);
#pragma unroll
                        for (int m = 0; m < 4; ++m) { const size_t o = (size_t)(row0 + ai * 128 + m * 16) * 512 + c; float q[4], k[4];
#pragma unroll
                            for (int j = 0; j < 4; ++j) { q[j] = QSCALE * fexp(cum[m][j] - ref[j]); k[j] = fexp(ref[j] - cum[m][j]); }
                            u32x2 wq, wk; wq.x = cvt_pk_bf16(q[0], q[1]); wq.y = cvt_pk_bf16(q[2], q[3]); wk.x = cvt_pk_bf16(k[0], k[1]); wk.y = cvt_pk_bf16(k[2], k[3]);
                            *(u32x2*)(EQ + o) = wq; *(u32x2*)(EK + o) = wk; }
                        { f32x4 er, el, elr;
#pragma unroll
                            for (int j = 0; j < 4; ++j) { er[j] = fexp(ref[j]); el[j] = fexp(run[j]); elr[j] = fexp(run[j] - ref[j]); }
                            asm volatile("" : "+v"(er), "+v"(el), "+v"(elr));
                            if (fr == 0) { *(f32x4*)(EREF + chunk * 512 + c) = er; *(f32x4*)(ELAST + chunk * 512 + c) = el; *(f32x4*)(ELR + chunk * 512 + c) = elr; } }
                    }
            }
        }
    }
};
__device__ __forceinline__ unsigned opaque_u0(unsigned v) { asm volatile("" : "+v"(v)); return v; }
struct EpiResidF {
    const float* xf; const bf16* xb; bf16* out;
    __device__ __forceinline__ void operator()(f32x4 (&acc)[2][2][4][2], const pg8::Unit& u, int wr, int wc, int fr, int fq, int lane) const {
        const size_t uo = (size_t)u.pm * 256 * 1024 + u.pn * 256;
        const char* xfb = (const char*)(xf + uo); const char* xbb = (const char*)(xb + uo); char* ob = (char*)(out + uo);
        const unsigned lo = opaque_u0((unsigned)((wr * 64 + fr) * 1024 + wc * 32 + 8 * fq) * 2u);
#pragma unroll
        for (int ai = 0; ai < 2; ++ai)
#pragma unroll
            for (int m = 0; m < 4; ++m)
#pragma unroll
                for (int bj = 0; bj < 2; ++bj) { const unsigned o = lo + (unsigned)((ai * 128 + m * 16) * 1024 + bj * 128) * 2u; f32x4 r0, r1;
                    if (xf) { r0 = *(const f32x4*)(xfb + 2u * o); r1 = *(const f32x4*)(xfb + (2u * o + 16u)); }
                    else unpack8(*(const u32x4*)(xbb + o), r0, r1);
                    *(u32x4*)(ob + o) = pack8(acc[ai][bj][m][0] + r0, acc[ai][bj][m][1] + r1); }
    }
};

__device__ __forceinline__ void cvt_item(const float* W, int ldn, int scol0, const float* kscale, bf16* dst, int dstK, int drow0, int kb, int nb, LAS float* scr, int lane, int kmask = 0x7fffffff) {
    const int k0 = 64 * kb, n0 = 32 * nb;
    float vv[32];
    const GAS float* wp = (const GAS float*)W + (size_t)(k0 + (lane >> 5)) * ldn + scol0 + n0 + (lane & 31);
#pragma unroll
    for (int i = 0; i < 32; ++i) vv[i] = wp[(size_t)(2 * i) * ldn];
#pragma unroll
    for (int i = 0; i < 32; ++i) { const int kk = 2 * i + (lane >> 5); float v = vv[i]; if (kscale) v *= kscale[(k0 + kk) & kmask]; scr[kk * 33 + (lane & 31)] = v; }
    asm volatile("s_waitcnt lgkmcnt(0)" ::: "memory");
    const int c = lane & 7;
#pragma unroll
    for (int j = 0; j < 4; ++j) { const int n = (lane >> 3) + 8 * j; const LAS float* s = scr + (8 * c) * 33 + n;
        u32x4 o; o.x = cvt_pk_bf16(s[0 * 33], s[1 * 33]); o.y = cvt_pk_bf16(s[2 * 33], s[3 * 33]); o.z = cvt_pk_bf16(s[4 * 33], s[5 * 33]); o.w = cvt_pk_bf16(s[6 * 33], s[7 * 33]);
        *(u32x4*)(dst + (size_t)(drow0 + n0 + n) * dstK + k0 + 8 * c) = o; }
    asm volatile("s_waitcnt lgkmcnt(0)" ::: "memory");
}
__device__ __forceinline__ void cvt_item_la(const float* Win, const float* wal, const float* kscale, bf16* dst, int kb, int nb, LAS float* scr, int lane) {
    const int k0 = 64 * kb, n0 = 32 * nb; float wa[16];
#pragma unroll
    for (int r = 0; r < 16; ++r) wa[r] = wal[r * 512 + n0 + (lane & 31)];
#pragma unroll 4
    for (int i = 0; i < 32; ++i) { const int kk = 2 * i + (lane >> 5); const float* lr = Win + (size_t)(k0 + kk) * 3088 + 3072; float v = 0.f;
#pragma unroll
        for (int r = 0; r < 16; ++r) v += lr[r] * wa[r];
        scr[kk * 33 + (lane & 31)] = v * kscale[k0 + kk]; }
    asm volatile("s_waitcnt lgkmcnt(0)" ::: "memory");
    const int c = lane & 7;
#pragma unroll
    for (int j = 0; j < 4; ++j) { const int n = (lane >> 3) + 8 * j; const LAS float* s = scr + (8 * c) * 33 + n;
        u32x4 o; o.x = cvt_pk_bf16(s[0 * 33], s[1 * 33]); o.y = cvt_pk_bf16(s[2 * 33], s[3 * 33]); o.z = cvt_pk_bf16(s[4 * 33], s[5 * 33]); o.w = cvt_pk_bf16(s[6 * 33], s[7 * 33]);
        *(u32x4*)(dst + (size_t)(3072 + n0 + n) * 1024 + k0 + 8 * c) = o; }
    asm volatile("s_waitcnt lgkmcnt(0)" ::: "memory");
}


constexpr int CAP = 32768;
constexpr size_t WS_LIST = 5 * MiB, WS_LW = 9 * MiB, WS_POS = 13 * MiB;
constexpr size_t WS_AGG = 13 * MiB + 512 * 1024;
constexpr size_t WS_CARRY = 5 * MiB;
constexpr int CW_CNT = 16384;
constexpr int TS_OFF = 256;

namespace pg8 {
struct SchedMoe {
    const LAS int* ts; int G, c, npn; const char* A; const char* B; const int* LIST; size_t b_exp, b_pn, a_tile; bool gather;
    __device__ __forceinline__ bool next(int i, Unit& u) const {
        const int NT = __builtin_amdgcn_readfirstlane(ts[32]); const long L = (long)i * G + c; if (L >= (long)NT * npn) return false;
        const int tg = (int)(L / npn), pn = (int)(L % npn);
        const int e = __builtin_amdgcn_readfirstlane(ts[64 + tg]);
        const int tile = tg - __builtin_amdgcn_readfirstlane(ts[e]);
        u.pm = tg; u.pn = pn; u.e = e; u.rows = LIST + (size_t)e * CAP + tile * 256; u.a = gather ? A : A + (size_t)tg * a_tile; u.b = B + (size_t)e * b_exp + (size_t)pn * b_pn; return true;
    }
};
}
__device__ __forceinline__ unsigned opaque_u(unsigned v) { asm volatile("" : "+v"(v)); return v; }
struct EpiM1 {
    bf16* ACT; const int* LIST; const float* LW; const float* RS;
    __device__ __forceinline__ void operator()(f32x4 (&acc)[2][2][4][2], const pg8::Unit& u, int wr, int wc, int fr, int fq, int lane) const {
        const char* rowsb = (const char*)u.rows; const char* lwb = (const char*)(LW + (u.rows - LIST)); const char* rsb = (const char*)RS;
        char* ob = (char*)(ACT + (size_t)u.pm * 256 * 256 + u.pn * 128);
        const unsigned r4 = opaque_u((unsigned)(wr * 64 + fr) * 4u), lo = opaque_u((unsigned)((wr * 64 + fr) * 256 + wc * 32 + 8 * fq) * 2u);
#pragma unroll
        for (int ai = 0; ai < 2; ++ai)
#pragma unroll
            for (int m = 0; m < 4; ++m) { const unsigned ro = r4 + (unsigned)(ai * 128 + m * 16) * 4u;
                unsigned tk = *(const unsigned*)(rowsb + ro); tk = tk < (unsigned)T ? tk : 0u;
                const float rs = *(const float*)(rsb + tk * 4u), w = *(const float*)(lwb + ro); f32x4 o[2];
#pragma unroll
                for (int n = 0; n < 2; ++n) { const f32x4 g = acc[ai][0][m][n] * rs, up = acc[ai][1][m][n] * rs;
#pragma unroll
                    for (int j = 0; j < 4; ++j) o[n][j] = fsilu(g[j]) * up[j] * w; }
                *(u32x4*)(ob + (lo + (unsigned)(ai * 128 + m * 16) * 512u)) = pack8(o[0], o[1]); }
    }
};
struct EpiStore {
    bf16* O; int ldc; int pad;
    __device__ __forceinline__ void operator()(f32x4 (&acc)[2][2][4][2], const pg8::Unit& u, int wr, int wc, int fr, int fq, int lane) const {
        char* ob = (char*)(O + (size_t)u.pm * 256 * 1024 + u.pn * 256);
        const unsigned lo = opaque_u((unsigned)((wr * 64 + fr) * 1024 + wc * 32 + 8 * fq) * 2u);
#pragma unroll
        for (int ai = 0; ai < 2; ++ai)
#pragma unroll
            for (int m = 0; m < 4; ++m)
#pragma unroll
                for (int bj = 0; bj < 2; ++bj) *(u32x4*)(ob + (lo + (unsigned)((ai * 128 + m * 16) * 1024 + bj * 128) * 2u)) = pack8(acc[ai][bj][m][0], acc[ai][bj][m][1]);
    }
};
struct EpiL1 {
    bf16 *XBR, *GATE; const float* RS;
    __device__ __forceinline__ void operator()(f32x4 (&acc)[2][2][4][2], const pg8::Unit& u, int wr, int wc, int fr, int fq, int lane) const {
        const bool act = u.pn >= 4; char* ob = (char*)((act ? GATE : XBR) + (size_t)u.pm * 256 * 1024 + (u.pn & 3) * 256); const char* rsb = (const char*)(RS + u.pm * 256);
        const unsigned r4 = opaque_u((unsigned)(wr * 64 + fr) * 4u), lo = opaque_u((unsigned)((wr * 64 + fr) * 1024 + wc * 32 + 8 * fq) * 2u);
#pragma unroll
        for (int ai = 0; ai < 2; ++ai)
#pragma unroll
            for (int m = 0; m < 4; ++m) { const float rs = *(const float*)(rsb + (r4 + (unsigned)(ai * 128 + m * 16) * 4u));
#pragma unroll
                for (int bj = 0; bj < 2; ++bj) { f32x4 v0 = acc[ai][bj][m][0] * rs, v1 = acc[ai][bj][m][1] * rs;
                    if (act) {
#pragma unroll
                        for (int j = 0; j < 4; ++j) { v0[j] = fgelu_tanh(v0[j]); v1[j] = fgelu_tanh(v1[j]); } }
                    *(u32x4*)(ob + (lo + (unsigned)((ai * 128 + m * 16) * 1024 + bj * 128) * 2u)) = pack8(v0, v1); } }
    }
};
struct EpiL2 {
    const bf16* XC; bf16 *LOGA, *XN; const float *br, *bi, *SP;
    __device__ __forceinline__ void operator()(f32x4 (&acc)[2][2][4][2], const pg8::Unit& u, int wr, int wc, int fr, int fq, int lane) const {
        const int cu = (u.pn >> 1) * 256 + (u.pn & 1) * 128; const size_t uo = (size_t)u.pm * 256 * 1024 + cu;
        const char* xcb = (const char*)(XC + uo); char* lab = (char*)(LOGA + uo); char* xnb = (char*)(XN + uo);
        const unsigned cl = opaque_u((unsigned)(wc * 32 + 8 * fq) * 4u), lo = opaque_u((unsigned)((wr * 64 + fr) * 1024 + wc * 32 + 8 * fq) * 2u);
        f32x4 vbr[2], vbi[2], vsp[2];
#pragma unroll
        for (int n = 0; n < 2; ++n) { vbr[n] = *(const f32x4*)((const char*)(br + cu) + (cl + 16u * n)); vbi[n] = *(const f32x4*)((const char*)(bi + cu) + (cl + 16u * n)); vsp[n] = *(const f32x4*)((const char*)(SP + cu) + (cl + 16u * n)); }
#pragma unroll
        for (int ai = 0; ai < 2; ++ai)
#pragma unroll
            for (int m = 0; m < 4; ++m) { const unsigned o = lo + (unsigned)((ai * 128 + m * 16) * 1024) * 2u;
                f32x4 xc[2]; unpack8(*(const u32x4*)(xcb + o), xc[0], xc[1]); f32x4 la[2], xn[2];
#pragma unroll
                for (int n = 0; n < 2; ++n)
#pragma unroll
                    for (int j = 0; j < 4; ++j) { const float r = fsigmoid(acc[ai][0][m][n][j] + vbr[n][j]), ig = fsigmoid(acc[ai][1][m][n][j] + vbi[n][j]);
                        const float l = -8.f * r * vsp[n][j]; la[n][j] = l; xn[n][j] = xc[n][j] * ig * sqrtf(fmaxf(1.f - fexp(2.f * l), 0.f)); }
                *(u32x4*)(lab + o) = pack8(la[0], la[1]); *(u32x4*)(xnb + o) = pack8(xn[0], xn[1]); }
    }
};

__device__ __forceinline__ void build_ts(unsigned* CNT, LAS int* ts, int tid) {
    __syncthreads();
    if (tid < 32) ts[400 + tid] = (int)((xb_ld(CNT + tid) + 255u) >> 8);
    __syncthreads();
    if (tid == 0) { int a = 0; for (int e = 0; e < 32; ++e) { ts[e] = a; a += ts[400 + e]; } ts[32] = a; }
    __syncthreads();
    if (tid < 32) { const int b = ts[tid], n = ts[tid + 1] - b; for (int k = 0; k < n; ++k) ts[64 + b + k] = tid; }
    __syncthreads();
}
__device__ __forceinline__ void router_phase(LAS unsigned char* lds, const bf16* X, const bf16* WRl, float* RS, unsigned* CNT, int* LIST, float* LW, int* POS, int bx, int G, int tid, int lane, int wave) {
    LAS float* lg = (LAS float*)lds + wave * (16 * 48);
    LAS float* rsl = (LAS float*)(lds + 24576) + wave * 16;
    LAS unsigned* cnt_l = (LAS unsigned*)(lds + 25600); LAS unsigned* base_l = cnt_l + 32;
    const int fr = lane & 15, fq = lane >> 4;
    for (int grp = bx; grp < T / 128; grp += G) {
        if (tid < 32) cnt_l[tid] = 0u;
        __syncthreads();
        const int t0 = grp * 128 + wave * 16;
        f32x4 a0 = (f32x4){0.f, 0.f, 0.f, 0.f}, a1 = a0, a2 = a0; float ss = 0.f;
        const bf16* xa = X + (size_t)(t0 + fr) * D + 8 * fq; const bf16* wb = WRl + (size_t)fr * D + 8 * fq;
#pragma unroll 4
        for (int s = 0; s < 32; ++s) {
            const bf16x8 a = *(const bf16x8*)(xa + 32 * s), b0 = *(const bf16x8*)(wb + 32 * s), b1 = *(const bf16x8*)(wb + 16 * D + 32 * s), b2 = *(const bf16x8*)(wb + 32 * D + 32 * s);
#pragma unroll
            for (int j = 0; j < 8; ++j) { const float v = bf2f((bf16)a[j]); ss += v * v; }
            a0 = __builtin_amdgcn_mfma_f32_16x16x32_bf16(a, b0, a0, 0, 0, 0); a1 = __builtin_amdgcn_mfma_f32_16x16x32_bf16(a, b1, a1, 0, 0, 0); a2 = __builtin_amdgcn_mfma_f32_16x16x32_bf16(a, b2, a2, 0, 0, 0);
        }
        ss += __shfl_xor(ss, 16); ss += __shfl_xor(ss, 32);
        const float rstd = rsqrtf(ss * (1.f / D) + EPS);
        if (fq == 0) { rsl[fr] = rstd; RS[t0 + fr] = rstd; }
#pragma unroll
        for (int r = 0; r < 4; ++r) { lg[(4 * fq + r) * 48 + fr] = a0[r]; lg[(4 * fq + r) * 48 + 16 + fr] = a1[r]; lg[(4 * fq + r) * 48 + 32 + fr] = a2[r]; }
        asm volatile("s_waitcnt lgkmcnt(0)" ::: "memory");
        int e0g = 0, e1g = 0; float w0 = 0.f, w1 = 0.f; unsigned rk0 = 0u, rk1 = 0u;
        if (lane < 16) {
            const LAS float* l = lg + lane * 48; const float rs = rsl[lane];
            int g = 0; float gm = l[0] * rs;
            for (int i = 1; i < 4; ++i) { const float v = l[i] * rs; if (v > gm) { gm = v; g = i; } }
            float gs = 0.f; for (int i = 0; i < 4; ++i) gs += fexp(l[i] * rs - gm);
            const float pg = 1.f / gs;
            const LAS float* el = l + 4 + g * 8; int e0 = 0; float m0 = el[0] * rs;
            for (int i = 1; i < 8; ++i) { const float v = el[i] * rs; if (v > m0) { m0 = v; e0 = i; } }
            int e1 = 0; float m1 = -3.0e38f;
            for (int i = 0; i < 8; ++i) { const float v = el[i] * rs; if (i != e0 && v > m1) { m1 = v; e1 = i; } }
            const float p1 = fexp(m1 - m0), den = 1.f / (1.f + p1);
            e0g = g * 8 + e0; e1g = g * 8 + e1; w0 = pg * den; w1 = pg * p1 * den;
            rk0 = __hip_atomic_fetch_add(cnt_l + e0g, 1u, __ATOMIC_RELAXED, __HIP_MEMORY_SCOPE_WORKGROUP);
            rk1 = __hip_atomic_fetch_add(cnt_l + e1g, 1u, __ATOMIC_RELAXED, __HIP_MEMORY_SCOPE_WORKGROUP);
        }
        __syncthreads();
        if (tid < 32) base_l[tid] = xb_add(CNT + tid, cnt_l[tid]);
        __syncthreads();
        if (lane < 16) { const int tok = t0 + lane; const int s0 = e0g * CAP + (int)(base_l[e0g] + rk0), s1 = e1g * CAP + (int)(base_l[e1g] + rk1);
            LIST[s0] = tok; LW[s0] = w0; LIST[s1] = tok; LW[s1] = w1; POS[2 * tok] = s0; POS[2 * tok + 1] = s1; }
        __syncthreads();
    }
}
__device__ __forceinline__ void combine_phase(const LAS int* ts, const bf16* X, const bf16* Y, const int* POS, bf16* Xn, float* RSn, const float* fw, float* out, int bx, int G, int lane, int wave) {
    for (int t = bx * NWAVES + wave; t < T; t += G * NWAVES) {
        const int p0 = POS[2 * t], p1 = POS[2 * t + 1];
        const size_t r0 = (size_t)ts[p0 >> 15] * 256 + (p0 & (CAP - 1)), r1 = (size_t)ts[p1 >> 15] * 256 + (p1 & (CAP - 1));
        f32x4 v[4]; float ss = 0.f;
#pragma unroll
        for (int h = 0; h < 2; ++h) { f32x4 x0, x1, y0, y1, z0, z1; const int c = h * 512 + lane * 8;
            unpack8(*(const u32x4*)(X + (size_t)t * D + c), x0, x1); unpack8(*(const u32x4*)(Y + r0 * D + c), y0, y1); unpack8(*(const u32x4*)(Y + r1 * D + c), z0, z1);
            v[2 * h] = x0 + y0 + z0; v[2 * h + 1] = x1 + y1 + z1;
#pragma unroll
            for (int j = 0; j < 4; ++j) ss += v[2 * h][j] * v[2 * h][j] + v[2 * h + 1][j] * v[2 * h + 1][j]; }
        ss = wave_sum(ss); const float rstd = rsqrtf(ss * (1.f / D) + EPS);
        if (out) {
#pragma unroll
            for (int h = 0; h < 2; ++h) { const int c = h * 512 + lane * 8; const f32x4 f0 = *(const f32x4*)(fw + c), f1 = *(const f32x4*)(fw + c + 4);
                *(f32x4*)(out + (size_t)t * D + c) = v[2 * h] * rstd * f0; *(f32x4*)(out + (size_t)t * D + c + 4) = v[2 * h + 1] * rstd * f1; }
        } else {
#pragma unroll
            for (int h = 0; h < 2; ++h) *(u32x4*)(Xn + (size_t)t * D + h * 512 + lane * 8) = pack8(v[2 * h], v[2 * h + 1]);
            if (lane == 0) RSn[t] = rstd;
        }
    }
}
__device__ __forceinline__ void conv_phase(const bf16* XBR, const float* cw, const float* cb, bf16* XC, int bx, int G, int tid) {
    for (int item = bx * NTHR + tid; item < (T / 32) * 128; item += G * NTHR) {
        const int cg = item & 127, run = item >> 7, c = cg * 8, t0 = run * 32;
        f32x4 w[4][2], b[2];
#pragma unroll
        for (int k = 0; k < 4; ++k) { w[k][0] = *(const f32x4*)(cw + k * D + c); w[k][1] = *(const f32x4*)(cw + k * D + c + 4); }
        b[0] = *(const f32x4*)(cb + c); b[1] = *(const f32x4*)(cb + c + 4);
        f32x4 h0[2], h1[2], h2[2];
        const bool first = (t0 & (SEQ - 1)) == 0;
        if (first) { h0[0] = h0[1] = h1[0] = h1[1] = h2[0] = h2[1] = (f32x4){0.f, 0.f, 0.f, 0.f}; }
        else { unpack8(*(const u32x4*)(XBR + (size_t)(t0 - 3) * D + c), h0[0], h0[1]); unpack8(*(const u32x4*)(XBR + (size_t)(t0 - 2) * D + c), h1[0], h1[1]); unpack8(*(const u32x4*)(XBR + (size_t)(t0 - 1) * D + c), h2[0], h2[1]); }
#pragma unroll 4
        for (int i = 0; i < 32; ++i) { f32x4 x[2]; unpack8(*(const u32x4*)(XBR + (size_t)(t0 + i) * D + c), x[0], x[1]); f32x4 o[2];
#pragma unroll
            for (int q = 0; q < 2; ++q) { o[q] = b[q] + w[0][q] * h0[q] + w[1][q] * h1[q] + w[2][q] * h2[q] + w[3][q] * x[q]; h0[q] = h1[q]; h1[q] = h2[q]; h2[q] = x[q]; }
            *(u32x4*)(XC + (size_t)(t0 + i) * D + c) = pack8(o[0], o[1]); }
    }
}
__device__ __forceinline__ void scan_a_phase(LAS unsigned char* lds, const bf16* LOGA, const bf16* XN, float* AGG, float* CARRY, int bx, int G, int tid) {
    LAS float* sA = (LAS float*)lds; LAS float* sH = sA + 64 * 64;
    for (int item = bx; item < 256; item += G) {
        const int b = item >> 5, slab = (item >> 1) & 15, half = item & 1, seg = tid >> 3, cg = tid & 7, c = slab * 64 + cg * 8;
        const size_t row0 = (size_t)b * SEQ + half * 2048 + seg * 32;
        f32x4 A[2], H[2]; A[0] = A[1] = (f32x4){0.f, 0.f, 0.f, 0.f}; H[0] = H[1] = A[0];
#pragma unroll 4
        for (int i = 0; i < 32; ++i) { f32x4 la[2], xn[2]; unpack8(*(const u32x4*)(LOGA + (row0 + i) * D + c), la[0], la[1]); unpack8(*(const u32x4*)(XN + (row0 + i) * D + c), xn[0], xn[1]);
#pragma unroll
            for (int q = 0; q < 2; ++q) { A[q] += la[q];
#pragma unroll
                for (int j = 0; j < 4; ++j) H[q][j] = fexp(la[q][j]) * H[q][j] + xn[q][j]; } }
        __syncthreads();
#pragma unroll
        for (int q = 0; q < 2; ++q) { *(LAS f32x4*)(sA + seg * 64 + cg * 8 + 4 * q) = A[q]; *(LAS f32x4*)(sH + seg * 64 + cg * 8 + 4 * q) = H[q]; }
        __syncthreads();
        if (tid < 64) { float pl = 0.f, h = 0.f; float* cr = CARRY + (size_t)item * 64 * 128;
            for (int sgi = 0; sgi < 64; ++sgi) { cr[sgi * 128 + tid] = pl; cr[sgi * 128 + 64 + tid] = h; const float a = sA[sgi * 64 + tid]; h = fexp(a) * h + sH[sgi * 64 + tid]; pl += a; }
            AGG[item * 128 + tid] = pl; AGG[item * 128 + 64 + tid] = h; }
    }
}
__device__ __forceinline__ void scan_c_phase(const bf16* LOGA, const bf16* XN, const bf16* GATE, const float* AGG, const float* CARRY, bf16* YL, int bx, int G, int tid) {
    for (int item = bx; item < 256; item += G) {
        const int b = item >> 5, slab = (item >> 1) & 15, half = item & 1, seg = tid >> 3, cg = tid & 7, c = slab * 64 + cg * 8;
        const size_t row0 = (size_t)b * SEQ + half * 2048 + seg * 32;
        const float* cr = CARRY + (size_t)item * 64 * 128 + seg * 128 + cg * 8;
        f32x4 h[2];
#pragma unroll
        for (int q = 0; q < 2; ++q) { const f32x4 pl = *(const f32x4*)(cr + 4 * q), hl = *(const f32x4*)(cr + 64 + 4 * q);
            f32x4 hw = (f32x4){0.f, 0.f, 0.f, 0.f}; if (half) hw = *(const f32x4*)(AGG + (item - 1) * 128 + 64 + cg * 8 + 4 * q);
#pragma unroll
            for (int j = 0; j < 4; ++j) h[q][j] = hl[j] + fexp(pl[j]) * hw[j]; }
#pragma unroll 4
        for (int i = 0; i < 32; ++i) { f32x4 la[2], xn[2], g[2], y[2]; const size_t o = (row0 + i) * D + c;
            unpack8(*(const u32x4*)(LOGA + o), la[0], la[1]); unpack8(*(const u32x4*)(XN + o), xn[0], xn[1]); unpack8(*(const u32x4*)(GATE + o), g[0], g[1]);
#pragma unroll
            for (int q = 0; q < 2; ++q)
#pragma unroll
                for (int j = 0; j < 4; ++j) { h[q][j] = fexp(la[q][j]) * h[q][j] + xn[q][j]; y[q][j] = h[q][j] * g[q][j]; }
            *(u32x4*)(YL + o) = pack8(y[0], y[1]); }
    }
}


__device__ __forceinline__ void gla_core_ref_phase(LAS unsigned char* lds, const bf16* Q, const bf16* Kb, const bf16* V, const bf16* SG, const float* AF, const float* hn, bf16* OG, int bx, int G, int tid) {
    LAS float* part = (LAS float*)lds;
    LAS float* red = part + 512;
    const int e = tid & 255, hf = tid >> 8, lane = tid & 63, w4 = (tid >> 6) & 3;
    for (int bh = bx; bh < 32; bh += G) {
        const int b = bh >> 2, h = bh & 3;
        float S[64];
#pragma unroll
        for (int d = 0; d < 64; ++d) S[d] = 0.f;
        const float hw = hn[e];
        for (int t = 0; t < SEQ; ++t) {
            const size_t row = (size_t)b * SEQ + t;
            const float v = bf2f(V[row * 1024 + h * 256 + e]);
            const float* a = AF + row * 512 + h * 128 + hf * 64; const bf16* k = Kb + row * 512 + h * 128 + hf * 64; const bf16* q = Q + row * 512 + h * 128 + hf * 64;
            float o = 0.f;
#pragma unroll
            for (int d = 0; d < 64; ++d) { S[d] = a[d] * S[d] + bf2f(k[d]) * v; o += bf2f(q[d]) * S[d]; }
            part[hf * 256 + e] = o;
            __syncthreads();
            o = (part[e] + part[256 + e]) * QSCALE;
            float ss = wave_sum(o * o);
            if (hf == 0 && lane == 0) red[w4] = ss;
            __syncthreads();
            ss = red[0] + red[1] + red[2] + red[3];
            const float rstd = rsqrtf(ss * (1.f / 256.f) + EPS);
            if (hf == 0) OG[row * 1024 + h * 256 + e] = f2bf(o * rstd * hw * bf2f(SG[row * 1024 + h * 256 + e]));
        }
        __syncthreads();
    }
}


typedef float f32x16 __attribute__((ext_vector_type(16)));
typedef short s16x4 __attribute__((ext_vector_type(4)));
typedef short v4i16_t __attribute__((ext_vector_type(4)));
typedef __bf16 bf16x2_t __attribute__((ext_vector_type(2)));
__device__ __forceinline__ unsigned cvtpk2(float lo, float hi) { f32x2 v = {lo, hi}; bf16x2_t b = __builtin_convertvector(v, bf16x2_t); return __builtin_bit_cast(unsigned, b); }
__device__ __forceinline__ s16x4 vtr(const LAS unsigned char* p) { return __builtin_bit_cast(s16x4, __builtin_amdgcn_ds_read_tr16_b64_v4i16((LAS v4i16_t*)p)); }
__device__ __forceinline__ bf16x8 tr_frag(const LAS unsigned char* a, int P) { const s16x4 lo = vtr(a), hi = vtr(a + 4 * P); return __builtin_shufflevector(lo, hi, 0, 1, 2, 3, 4, 5, 6, 7); }
__device__ __forceinline__ int crow(int r, int hh) { return (r & 3) + 8 * (r >> 2) + 4 * hh; }
#define MFMA32(a, b, c) __builtin_amdgcn_mfma_f32_32x32x16_bf16((a), (b), (c), 0, 0, 0)
#define CORE_BAR() asm volatile("s_waitcnt lgkmcnt(0)\n\ts_barrier" ::: "memory")

template <bool FULL>
__device__ __forceinline__ void gla_core_phase(LAS unsigned char* lds, const bf16* Q, const bf16* Kb, const bf16* V, const bf16* SG, const bf16* EQ, const bf16* EK,
                                               const float* EREF, const float* ELAST, const float* ELR, bf16* OG, float* USEG, int bx, int G, int wave) {
    constexpr int NSEG = 8, SEGC = 8;
    constexpr int TP = 272, VP = 80, PP = 144;
    constexpr int O_QP = 0, O_KP = 17408, O_QC = 34816, O_KST = 52224, O_V = 69632, O_P = 110592, O_PART = 119808, O_VEC = 121856;
    const int lane = lane_id_v(), tid = wave * 64 + lane, hh = lane >> 5, l31 = lane & 31;
    const int ptok = tid >> 3, pdp = tid & 7;
    LAS unsigned char* vsl = lds + O_V + wave * (64 * VP);
    const int troff = (8 * hh + ((lane & 15) >> 2)) * 1 ;
    const int trcol = 32 * ((lane >> 4) & 1) + 8 * (lane & 3);
    LAS float* part = (LAS float*)(lds + O_PART);
    for (int un = bx; un < 32 * NSEG; un += G) {
        const int bh = un & 31, seg = un >> 5, c0 = seg * SEGC, b = bh >> 2, h = bh & 3;
        if (!FULL && seg == NSEG - 1) continue;
        const size_t seq0 = (size_t)b * SEQ;
        f32x16 S[4];
#pragma unroll
        for (int dt = 0; dt < 4; ++dt)
#pragma unroll
            for (int r = 0; r < 16; ++r) S[dt][r] = 0.f;
        if (FULL) {
            for (int sg = 0; sg < seg; ++sg) {
                CORE_BAR();
                if (tid < 128) { float a = 1.f; const float* ep = ELAST + ((size_t)(b * 64 + sg * SEGC)) * 512 + h * 128 + tid;
#pragma unroll
                    for (int q = 0; q < SEGC; ++q) a *= *(const GAS float*)(ep + q * 512);
                    ((LAS float*)(lds + O_VEC))[256 + tid] = a; }
                CORE_BAR();
                const LAS float* el = (const LAS float*)(lds + O_VEC) + 256;
                const GAS float* up = (const GAS float*)USEG + (((size_t)(bh * NSEG + sg) * 8 + wave) * 64) * 64 + lane;
#pragma unroll
                for (int dt = 0; dt < 4; ++dt)
#pragma unroll
                    for (int g = 0; g < 4; ++g) { const f32x4 e4 = *(const LAS f32x4*)(el + 32 * dt + 8 * g + 4 * hh);
#pragma unroll
                        for (int j = 0; j < 4; ++j) S[dt][4 * g + j] = S[dt][4 * g + j] * e4[j] + up[(dt * 16 + 4 * g + j) * 64]; }
            }
            CORE_BAR();
        }
        u32x4 pq[2], pk[2], peq[2], pek[2], pv[4]; float ve[3] = {0.f, 0.f, 0.f};
#define CORE_LOAD(cc) do { const size_t rr = seq0 + (size_t)(cc) * 64; \
            { const size_t o = (rr + ptok) * 512 + h * 128 + pdp * 16; \
              if (FULL) { pq[0] = *(const GAS u32x4*)(Q + o); pq[1] = *(const GAS u32x4*)(Q + o + 8); peq[0] = *(const GAS u32x4*)(EQ + o); peq[1] = *(const GAS u32x4*)(EQ + o + 8); } pk[0] = *(const GAS u32x4*)(Kb + o); pk[1] = *(const GAS u32x4*)(Kb + o + 8); \
              pek[0] = *(const GAS u32x4*)(EK + o); pek[1] = *(const GAS u32x4*)(EK + o + 8); } \
            { const bf16* vp = V + (rr + lane) * 1024 + h * 256 + wave * 32; pv[0] = *(const GAS u32x4*)vp; pv[1] = *(const GAS u32x4*)(vp + 8); pv[2] = *(const GAS u32x4*)(vp + 16); pv[3] = *(const GAS u32x4*)(vp + 24); } \
            if (tid < 128) { const size_t vo = (rr >> 6) * 512 + h * 128 + tid; ve[0] = *(const GAS float*)(EREF + vo); ve[1] = *(const GAS float*)(ELR + vo); ve[2] = *(const GAS float*)(ELAST + vo); } } while (0)
#define CORE_VEC(par) do { if (tid < 128) { LAS float* vv = (LAS float*)(lds + O_VEC) + (par) * 384; vv[tid] = ve[0]; vv[128 + tid] = ve[1]; vv[256 + tid] = ve[2]; } } while (0)
#define CORE_PREP(par) do { const LAS float* vv = (const LAS float*)(lds + O_VEC) + (par) * 384 + pdp * 16; \
            _Pragma("unroll") for (int q2 = 0; q2 < 2; ++q2) { f32x4 q0, q1, e0, e1, k0, k1, g0, g1; if (FULL) { unpack8(pq[q2], q0, q1); unpack8(peq[q2], e0, e1); } unpack8(pk[q2], k0, k1); unpack8(pek[q2], g0, g1); \
                const f32x4 er0 = *(const LAS f32x4*)(vv + q2 * 8), er1 = *(const LAS f32x4*)(vv + q2 * 8 + 4), lr0 = *(const LAS f32x4*)(vv + 128 + q2 * 8), lr1 = *(const LAS f32x4*)(vv + 128 + q2 * 8 + 4); \
                k0 = k0 * g0; k1 = k1 * g1; \
                const int lo_ = ptok * TP + (pdp * 16 + q2 * 8) * 2; \
                if (FULL) { q0 = q0 * e0; q1 = q1 * e1; *(LAS u32x4*)(lds + O_QP + lo_) = pack8(q0, q1); *(LAS u32x4*)(lds + O_KP + lo_) = pack8(k0, k1); *(LAS u32x4*)(lds + O_QC + lo_) = pack8(q0 * er0, q1 * er1); } \
                *(LAS u32x4*)(lds + O_KST + lo_) = pack8(k0 * lr0, k1 * lr1); } \
            _Pragma("unroll") for (int i_ = 0; i_ < 4; ++i_) *(LAS u32x4*)(vsl + lane * VP + i_ * 16) = pv[i_]; } while (0)
        CORE_LOAD(c0); CORE_VEC(0);
        CORE_BAR();
        CORE_PREP(0);
        CORE_BAR();
        for (int c = c0; c < c0 + SEGC; ++c) {
            const int par = (c - c0) & 1; const size_t row0 = seq0 + (size_t)c * 64;
            u32x2 psg[8];
            if (FULL)
#pragma unroll
            for (int it = 0; it < 2; ++it)
#pragma unroll
                for (int g = 0; g < 4; ++g) psg[it * 4 + g] = *(const GAS u32x2*)(SG + (row0 + 32 * it + l31) * 1024 + h * 256 + wave * 32 + 8 * g + 4 * hh);
            CORE_LOAD(c < c0 + SEGC - 1 ? c + 1 : c0 + SEGC - 1);
            if (FULL && wave < 3) { const int jt = wave == 2 ? 1 : 0, it = wave >= 1 ? 1 : 0; f32x16 p;
#pragma unroll
                for (int r = 0; r < 16; ++r) p[r] = 0.f;
#pragma unroll
                for (int ks = 0; ks < 8; ++ks) { const bf16x8 a = *(const LAS bf16x8*)(lds + O_KP + (32 * jt + l31) * TP + (16 * ks + 8 * hh) * 2), bq = *(const LAS bf16x8*)(lds + O_QP + (32 * it + l31) * TP + (16 * ks + 8 * hh) * 2);
                    p = MFMA32(a, bq, p); }
                if (jt == it) {
#pragma unroll
                    for (int r = 0; r < 16; ++r) p[r] = crow(r, hh) <= l31 ? p[r] : 0.f; }
#pragma unroll
                for (int g = 0; g < 4; ++g) { u32x2 w; w.x = cvtpk2(p[4 * g], p[4 * g + 1]); w.y = cvtpk2(p[4 * g + 2], p[4 * g + 3]);
                    *(LAS u32x2*)(lds + O_P + (32 * it + l31) * PP + (32 * jt + 8 * g + 4 * hh) * 2) = w; }
            }
            f32x16 o[2];
#pragma unroll
            for (int it = 0; it < 2; ++it)
#pragma unroll
                for (int r = 0; r < 16; ++r) o[it][r] = 0.f;
            if (FULL)
#pragma unroll
            for (int ks = 0; ks < 8; ++ks) { const int dt = ks >> 1, s2 = ks & 1; u32x4 ap;
                ap.x = cvtpk2(S[dt][8 * s2 + 0], S[dt][8 * s2 + 1]); ap.y = cvtpk2(S[dt][8 * s2 + 2], S[dt][8 * s2 + 3]); ap.z = cvtpk2(S[dt][8 * s2 + 4], S[dt][8 * s2 + 5]); ap.w = cvtpk2(S[dt][8 * s2 + 6], S[dt][8 * s2 + 7]);
                const bf16x8 a = __builtin_bit_cast(bf16x8, ap);
#pragma unroll
                for (int it = 0; it < 2; ++it) { const LAS unsigned char* qa = lds + O_QC + (32 * it + l31) * TP + (32 * dt + 16 * s2 + 4 * hh) * 2;
                    const s16x4 lo = *(const LAS s16x4*)qa, hi = *(const LAS s16x4*)(qa + 16);
                    o[it] = MFMA32(a, __builtin_shufflevector(lo, hi, 0, 1, 2, 3, 4, 5, 6, 7), o[it]); } }
            if (FULL) CORE_BAR();
            bf16x8 vf[4];
#pragma unroll
            for (int s4 = 0; s4 < 4; ++s4) vf[s4] = tr_frag(vsl + (16 * s4 + troff) * VP + trcol, VP);
            if (FULL)
#pragma unroll
            for (int it = 0; it < 2; ++it)
#pragma unroll
                for (int s4 = 0; s4 < 4; ++s4) { if (it == 0 && s4 >= 2) continue;
                    const bf16x8 pb = *(const LAS bf16x8*)(lds + O_P + (32 * it + l31) * PP + (16 * s4 + 8 * hh) * 2);
                    o[it] = MFMA32(vf[s4], pb, o[it]); }
            if (FULL)
#pragma unroll
            for (int it = 0; it < 2; ++it) { float ss = 0.f;
#pragma unroll
                for (int r = 0; r < 16; ++r) ss += o[it][r] * o[it][r];
                ss += __shfl_xor(ss, 32);
                if (hh == 0) part[wave * 64 + 32 * it + l31] = ss; }
            { const LAS float* el = (const LAS float*)(lds + O_VEC) + par * 384 + 256;
#pragma unroll
              for (int dt = 0; dt < 4; ++dt)
#pragma unroll
                for (int g = 0; g < 4; ++g) { const f32x4 e4 = *(const LAS f32x4*)(el + 32 * dt + 8 * g + 4 * hh);
#pragma unroll
                    for (int j = 0; j < 4; ++j) S[dt][4 * g + j] *= e4[j]; }
#pragma unroll
              for (int dt = 0; dt < 4; ++dt)
#pragma unroll
                for (int s4 = 0; s4 < 4; ++s4) S[dt] = MFMA32(tr_frag(lds + O_KST + (16 * s4 + troff) * TP + 64 * dt + trcol, TP), vf[s4], S[dt]); }
            CORE_VEC(par ^ 1);
            CORE_BAR();
            if (FULL)
#pragma unroll
            for (int it = 0; it < 2; ++it) { float tot = 0.f;
#pragma unroll
                for (int w8 = 0; w8 < 8; ++w8) tot += part[w8 * 64 + 32 * it + l31];
                const float rstd = rsqrtf(tot * (1.f / 256.f) + EPS);
#pragma unroll
                for (int g = 0; g < 4; ++g) { const u32x2 sg = psg[it * 4 + g]; u32x2 w;
                    w.x = cvtpk2(o[it][4 * g] * rstd * __uint_as_float(sg.x << 16), o[it][4 * g + 1] * rstd * __uint_as_float(sg.x & 0xffff0000u));
                    w.y = cvtpk2(o[it][4 * g + 2] * rstd * __uint_as_float(sg.y << 16), o[it][4 * g + 3] * rstd * __uint_as_float(sg.y & 0xffff0000u));
                    *(GAS u32x2*)(OG + (row0 + 32 * it + l31) * 1024 + h * 256 + wave * 32 + 8 * g + 4 * hh) = w; } }
            CORE_PREP(par ^ 1);
            CORE_BAR();
        }
        if (!FULL) { GAS float* up = (GAS float*)USEG + (((size_t)(bh * NSEG + seg) * 8 + wave) * 64) * 64 + lane;
#pragma unroll
            for (int dt = 0; dt < 4; ++dt)
#pragma unroll
                for (int r = 0; r < 16; ++r) up[(dt * 16 + r) * 64] = S[dt][r]; }
#undef CORE_LOAD
#undef CORE_VEC
#undef CORE_PREP
    }
}

struct MArgs { const float* in[24]; float* out; unsigned char* ws; int ph_lo, ph_hi, li, pad; };

#define CVT_ITEMS(IT_LO, IT_HI, GW_, NGW_) do { \
        LAS float* scr = (LAS float*)(lds + wave * 16384); \
        constexpr int I_A = 1536, I_B = 256, I_C = 512, I_D = 1024, I_E = 512, I_F = 256, I_G = 16384; \
        for (int it = (IT_LO) + (GW_); it < (IT_HI); it += (NGW_)) { \
            int r = it; \
            if (r < I_A) { cvt_item(in[2], 3088, 0, in[1], W1, 1024, 0, r / 96, r % 96, scr, lane); continue; } r -= I_A; \
            if (r < I_B) { cvt_item_la(in[2], in[3], in[1], W1, r / 16, r % 16, scr, lane); continue; } r -= I_B; \
            if (r < I_C) { cvt_item(in[6], 1024, 0, in[5], WO, 1024, 0, r / 32, r % 32, scr, lane, 255); continue; } r -= I_C; \
            if (r < I_D) { cvt_item(in[8], 2048, 0, in[7], WLI, 1024, 0, r / 64, r % 64, scr, lane); continue; } r -= I_D; \
            if (r < I_E) { cvt_item(in[16], 1024, 0, nullptr, WLO, 1024, 0, r / 32, r % 32, scr, lane); continue; } r -= I_E; \
            if (r < I_F) { const int seg = r / 16, q = r % 16, nb4 = seg >> 2, half = (seg >> 1) & 1, pn = seg & 1; \
                cvt_item((half ? in[13] : in[11]) + (size_t)nb4 * 65536, 256, pn * 128, nullptr, WG + (size_t)nb4 * 512 * 256, 256, pn * 256 + half * 128, q / 4, q % 4, scr, lane); continue; } r -= I_F; \
            if (r < I_G) { const int seg = r / 64, q = r % 64, le = seg >> 2, half = (seg >> 1) & 1, pn = seg & 1; \
                cvt_item((half ? in[21] : in[20]) + (size_t)le * 1024 * 256, 256, pn * 128, in[17] + (le >> 5) * D, WGU + (size_t)le * 512 * 1024, 1024, pn * 256 + half * 128, q / 4, q % 4, scr, lane); continue; } r -= I_G; \
            { const int le = r / 128, q = r % 128; cvt_item(in[22] + (size_t)le * 256 * 1024, 1024, 0, nullptr, WD + (size_t)le * 1024 * 256, 256, 0, q / 32, q % 32, scr, lane); } \
        } } while (0)
constexpr int CVT_W1_ITEMS = 1536 + 256, CVT_ALL_ITEMS = 1536 + 256 + 512 + 1024 + 512 + 256 + 16384 + 8192;
__global__ void __launch_bounds__(NTHR, 2) mega(MArgs args) {
    extern __shared__ __attribute__((aligned(16))) unsigned char lds_raw[];
    LAS unsigned char* lds = (LAS unsigned char*)lds_raw;
    volatile LAS unsigned* MISC = (volatile LAS unsigned*)(lds + LDS_MISC);
    const int wave = __builtin_amdgcn_readfirstlane((int)(threadIdx.x >> 6));
    const int G = gridDim.x, bx = blockIdx.x;
    unsigned char* ws = args.ws;
    unsigned* ctl = (unsigned*)(ws + WS_CTL);
    { const int tid0 = wave * 64 + lane_id_v();
      for (int u = tid0; u < (LDS_BYTES - LDS_MISC) / 4; u += NTHR) ((LAS unsigned*)(lds + LDS_MISC))[u] = 0u;
      __syncthreads(); }
    XcdBarrier bar = xcd_barrier_post(ctl + CW_BAR + args.li * XCD_BAR_WORDS, MISC + 8, wave == 0 && lane_id_v() == 0);
#define TIDLANE const int lane = lane_id_v(), tid = wave * 64 + lane; (void)tid; (void)lane;
    const int lo = args.ph_lo, hi = args.ph_hi;
#define IN(k) (lo <= (k) && (k) < hi)
#define BOTH(k) (IN(k) && IN((k) + 1))
    const float* const* in = args.in;
#define PH_PTRS unsigned char* wsp = args.ws; asm volatile("" : "+s"(wsp)); \
    float *RS0 = (float*)(wsp + WS_RS0), *RS1 = (float*)(wsp + WS_RS1), *RS2 = (float*)(wsp + WS_RS2), *RS3 = (float*)(wsp + WS_RS3); \
    float *EREF = (float*)(wsp + WS_EREF), *ELAST = (float*)(wsp + WS_ELAST), *ELR = (float*)(wsp + WS_ELR); \
    bf16 *S0 = (bf16*)(wsp + WS_S0), *S1 = (bf16*)(wsp + WS_S1), *S2 = (bf16*)(wsp + WS_S2), *S3 = (bf16*)(wsp + WS_S3), *S4 = (bf16*)(wsp + WS_S4), *S5 = (bf16*)(wsp + WS_S5); \
    bf16 *W1 = (bf16*)(wsp + WS_W1), *WO = (bf16*)(wsp + WS_WO), *WLI = (bf16*)(wsp + WS_WLI), *WLO = (bf16*)(wsp + WS_WLO), *WG = (bf16*)(wsp + WS_WG), *WGU = (bf16*)(wsp + WS_WGU), *WD = (bf16*)(wsp + WS_WD); \
    int* LIST = (int*)(wsp + WS_LIST); float* LW = (float*)(wsp + WS_LW); int* POS = (int*)(wsp + WS_POS); const bf16* WR = (const bf16*)(wsp + WS_WR); unsigned* ctlp = (unsigned*)(wsp + WS_CTL); \
    (void)RS0; (void)RS1; (void)RS2; (void)RS3; (void)EREF; (void)ELAST; (void)ELR; (void)S0; (void)S1; (void)S2; (void)S3; (void)S4; (void)S5; \
    (void)W1; (void)WO; (void)WLI; (void)WLO; (void)WG; (void)WGU; (void)WD; (void)LIST; (void)LW; (void)POS; (void)WR; (void)ctlp;

    if (IN(0)) { PH_PTRS TIDLANE
        const int gw = bx * NWAVES + wave, NGW = G * NWAVES;
        bf16* XB = S0;
        for (int row = gw; row < T; row += NGW) {
            const f32x4* xr = (const f32x4*)(in[0] + (size_t)row * D) + lane; f32x4 v[4]; float s = 0.f;
#pragma unroll
            for (int j = 0; j < 4; ++j) { v[j] = xr[64 * j]; s += (v[j].x * v[j].x + v[j].y * v[j].y) + (v[j].z * v[j].z + v[j].w * v[j].w); }
            s = wave_sum(s);
            u32x2* o8 = (u32x2*)(XB + (size_t)row * D) + lane;
#pragma unroll
            for (int j = 0; j < 4; ++j) { u32x2 w; w.x = cvt_pk_bf16(v[j].x, v[j].y); w.y = cvt_pk_bf16(v[j].z, v[j].w); o8[64 * j] = w; }
            if (lane == 0) RS0[row] = rsqrtf(s * (1.f / D) + EPS);
        }
        CVT_ITEMS(0, CVT_ALL_ITEMS, gw, NGW);
        float* SP = (float*)(wsp + WS_SP); bf16* WRw = (bf16*)(wsp + WS_WR);
        for (int i = bx * NTHR + tid; i < 1024; i += G * NTHR) { const float l = -in[15][i]; SP[i] = fmaxf(l, 0.f) + log1pf(__expf(-fabsf(l))); }
        for (int i = bx * NTHR + tid; i < 2 * 48 * 1024; i += G * NTHR) { const int l = i / (48 * 1024), n = (i / 1024) % 48, k = i % 1024; float v = 0.f;
            if (n < 4) v = in[18][(size_t)l * D * 4 + k * 4 + n]; else if (n < 36) v = in[19][(size_t)l * D * 32 + k * 32 + n - 4];
            WRw[i] = f2bf(v * in[17][l * D + k]); }
        if (BOTH(0)) xcd_barrier(bar, wave);
    }
    if (IN(1)) { PH_PTRS
        pg8::SchedDense S{128, 14, G, bx, (const char*)S0, (const char*)W1, (size_t)256 * 1024 * 2, (size_t)256 * 1024 * 2, 1, 0};
        EpiG1 E{S1, S1 + (size_t)T * 512, S2, S3, S4, S4 + (size_t)T * 512, EREF, ELAST, ELR, nullptr, RS0, in[4]};
        pg8::gemm_phase<EpiG1, pg8::SchedDense, false>(lds, 1024, 1024, 1024, S, E, wave);
        if (BOTH(1)) xcd_barrier(bar, wave);
    }
    if (IN(2)) { PH_PTRS
        gla_core_phase<false>(lds, S1, S1 + (size_t)T * 512, S2, S3, S4, S4 + (size_t)T * 512, EREF, ELAST, ELR, S0, (float*)S5, bx, G, wave);
        xcd_barrier(bar, wave);
        gla_core_phase<true>(lds, S1, S1 + (size_t)T * 512, S2, S3, S4, S4 + (size_t)T * 512, EREF, ELAST, ELR, S0, (float*)S5, bx, G, wave);
        if (BOTH(2)) xcd_barrier(bar, wave);
    }
    if (IN(3)) { PH_PTRS
        pg8::SchedDense S{128, 4, G, bx, (const char*)S0, (const char*)WO, (size_t)256 * 1024 * 2, (size_t)256 * 1024 * 2, 1, 0};
        EpiResidF E{in[0], nullptr, S1};
        pg8::gemm_phase<EpiResidF, pg8::SchedDense, false>(lds, 1024, 1024, 1024, S, E, wave);
        if (BOTH(3)) xcd_barrier(bar, wave);
    }

    LAS int* ts = (LAS int*)(lds + LDS_MISC + TS_OFF);
#define MOE_PHASES(P, LAYER, XIN, RSX, ACTB, YB, XOUT, RSOUT, FW, OUTP) \
    if (IN(P)) { PH_PTRS TIDLANE router_phase(lds, XIN, WR + (size_t)(LAYER) * 48 * 1024, RSX, ctlp + CW_CNT + 64 * (LAYER), LIST, LW, POS, bx, G, tid, lane, wave); if (BOTH(P)) xcd_barrier(bar, wave); } \
    if (IN(P + 1)) { PH_PTRS TIDLANE build_ts(ctlp + CW_CNT + 64 * (LAYER), ts, tid); \
        pg8::SchedMoe S{ts, G, bx, 2, (const char*)(XIN), (const char*)(WGU + (size_t)(LAYER) * 32 * 512 * 1024), LIST, (size_t)512 * 1024 * 2, (size_t)256 * 1024 * 2, 0, true}; \
        EpiM1 E{ACTB, LIST, LW, RSX}; \
        pg8::gemm_phase<EpiM1, pg8::SchedMoe, true>(lds, 1024, 1024, 1024, S, E, wave); if (BOTH(P + 1)) xcd_barrier(bar, wave); } \
    if (IN(P + 2)) { PH_PTRS TIDLANE build_ts(ctlp + CW_CNT + 64 * (LAYER), ts, tid); \
        pg8::SchedMoe S{ts, G, bx, 4, (const char*)(ACTB), (const char*)(WD + (size_t)(LAYER) * 32 * 1024 * 256), LIST, (size_t)1024 * 256 * 2, (size_t)256 * 256 * 2, (size_t)256 * 256 * 2, false}; \
        EpiStore E{YB, 1024, 0}; \
        pg8::gemm_phase<EpiStore, pg8::SchedMoe, false>(lds, 256, 256, 256, S, E, wave); if (BOTH(P + 2)) xcd_barrier(bar, wave); } \
    if (IN(P + 3)) { PH_PTRS TIDLANE build_ts(ctlp + CW_CNT + 64 * (LAYER), ts, tid); \
        combine_phase(ts, XIN, YB, POS, XOUT, RSOUT, FW, OUTP, bx, G, lane, wave); if (BOTH(P + 3)) xcd_barrier(bar, wave); }

    MOE_PHASES(4, 0, S1, RS1, S2, S3, S0, RS2, nullptr, nullptr)
    if (IN(8)) { PH_PTRS
        pg8::SchedDense S{128, 8, G, bx, (const char*)S0, (const char*)WLI, (size_t)256 * 1024 * 2, (size_t)256 * 1024 * 2, 1, 0};
        EpiL1 E{S1, S2, RS2};
        pg8::gemm_phase<EpiL1, pg8::SchedDense, false>(lds, 1024, 1024, 1024, S, E, wave);
        if (BOTH(8)) xcd_barrier(bar, wave);
    }
    if (IN(9)) { PH_PTRS TIDLANE conv_phase(S1, in[9], in[10], S3, bx, G, tid); if (BOTH(9)) xcd_barrier(bar, wave); }
    if (IN(10)) { PH_PTRS
        pg8::SchedDense S{128, 8, G, bx, (const char*)S3, (const char*)WG, (size_t)256 * 1024 * 2, (size_t)256 * 256 * 2, 2, (size_t)512};
        EpiL2 E{S3, S4, S5, in[12], in[14], (const float*)(wsp + WS_SP)};
        pg8::gemm_phase<EpiL2, pg8::SchedDense, false>(lds, 1024, 256, 256, S, E, wave);
        if (BOTH(10)) xcd_barrier(bar, wave);
    }
    if (IN(11)) { PH_PTRS TIDLANE scan_a_phase(lds, S4, S5, (float*)(wsp + WS_AGG), (float*)(wsp + WS_CARRY), bx, G, tid); if (BOTH(11)) xcd_barrier(bar, wave); }
    if (IN(12)) { PH_PTRS TIDLANE scan_c_phase(S4, S5, S2, (const float*)(wsp + WS_AGG), (const float*)(wsp + WS_CARRY), S1, bx, G, tid); if (BOTH(12)) xcd_barrier(bar, wave); }
    if (IN(13)) { PH_PTRS
        pg8::SchedDense S{128, 4, G, bx, (const char*)S1, (const char*)WLO, (size_t)256 * 1024 * 2, (size_t)256 * 1024 * 2, 1, 0};
        EpiResidF E{nullptr, S0, S5};
        pg8::gemm_phase<EpiResidF, pg8::SchedDense, false>(lds, 1024, 1024, 1024, S, E, wave);
        if (BOTH(13)) xcd_barrier(bar, wave);
    }
    MOE_PHASES(14, 1, S5, RS3, S3, S0, (bf16*)nullptr, (float*)nullptr, in[23], args.out)
#undef MOE_PHASES
#undef PH_PTRS
#undef TIDLANE
#undef CVT_ITEMS
#undef IN
#undef BOTH
}

static int mega_grid() {
    static int grid = 0;
    if (grid == 0) {
        int dev = 0, cus = 0;
        if (hipGetDevice(&dev) != hipSuccess || hipDeviceGetAttribute(&cus, hipDeviceAttributeMultiprocessorCount, dev) != hipSuccess) { grid = -1; return grid; }
        if (hipFuncSetAttribute((const void*)mega, hipFuncAttributeMaxDynamicSharedMemorySize, LDS_BYTES) != hipSuccess) { fprintf(stderr, "hipFuncSetAttribute failed\n"); grid = -1; return grid; }
        int per_cu = 0;
        if (hipOccupancyMaxActiveBlocksPerMultiprocessor(&per_cu, (const void*)mega, NTHR, LDS_BYTES) != hipSuccess || per_cu < 1) { fprintf(stderr, "occupancy query: %d\n", per_cu); (void)hipGetLastError(); }
        grid = cus;
    }
    return grid;
}
static void launch_mega(const MArgs& base, int lo, int hi, int li, hipStream_t stream) {
    MArgs a = base; a.ph_lo = lo; a.ph_hi = hi; a.li = li; a.pad = 0;
    hipLaunchKernelGGL(mega, dim3(mega_grid()), dim3(NTHR), LDS_BYTES, stream, a);
}
extern "C" void kernel_launch(void* const* d_in, const int* in_sizes, int n_in, void* d_out, int out_size, void* d_ws, size_t ws_size, hipStream_t stream) {
    if (n_in != 24 || out_size != T * D || ws_size < WS_END) { fprintf(stderr, "kernel_launch: unexpected shapes (n_in %d out %d ws %zu)\n", n_in, out_size, ws_size); return; }
    if (mega_grid() <= 0) return;
    const float* const* in = (const float* const*)d_in; unsigned char* ws = (unsigned char*)d_ws;
    (void)hipMemsetAsync(ws + WS_CTL, 0, 1 * MiB, stream);
    MArgs base{}; for (int i = 0; i < 24; ++i) base.in[i] = in[i]; base.out = (float*)d_out; base.ws = ws;
    launch_mega(base, 0, 18, 0, stream);
}
```

```cpp
#include <hip/hip_runtime.h>
#include <cstdio>
#include <cstdint>

typedef unsigned short bf16;
constexpr int T = 32768, D = 1024, SEQ = 4096, NB = 8;
constexpr float EPS = 1e-6f;
constexpr size_t MiB = 1u << 20;
constexpr size_t WS_CTL = 0;
constexpr size_t WS_RS0 = 1 * MiB, WS_RS1 = WS_RS0 + 128 * 1024, WS_RS2 = WS_RS1 + 128 * 1024, WS_RS3 = WS_RS2 + 128 * 1024;
constexpr size_t WS_EREF = 2 * MiB, WS_ELAST = 3 * MiB, WS_ELR = 4 * MiB;
constexpr size_t WS_S0 = 128 * MiB, WS_S1 = 192 * MiB, WS_S2 = 256 * MiB, WS_S3 = 320 * MiB, WS_S4 = 384 * MiB, WS_S5 = 448 * MiB, WS_END = 512 * MiB;

__device__ __forceinline__ float bf2f(bf16 b) { return __uint_as_float(((unsigned)b) << 16); }
__device__ __forceinline__ bf16 f2bf(float f) { unsigned u = __float_as_uint(f); u += 0x7fffu + ((u >> 16) & 1u); return (bf16)(u >> 16); }
__device__ __forceinline__ float wave_sum(float v) {
#pragma unroll
    for (int o = 1; o < 64; o <<= 1) v += __shfl_xor(v, o);
    return v;
}
__device__ __forceinline__ float sigmoidf_(float x) { return 1.f / (1.f + __expf(-x)); }
__device__ __forceinline__ float siluf_(float x) { return x / (1.f + __expf(-x)); }
__device__ __forceinline__ float logsigmoidf_(float x) { return fminf(x, 0.f) - log1pf(__expf(-fabsf(x))); }
__device__ __forceinline__ float softplusf_(float x) { return fmaxf(x, 0.f) + log1pf(__expf(-fabsf(x))); }
__device__ __forceinline__ float gelu_tanhf_(float x) { const float u = 0.7978845608028654f * (x + 0.044715f * x * x * x); return 0.5f * x * (1.f + tanhf(u)); }

__global__ void __launch_bounds__(256) n_prologue(const float* x, bf16* XB, float* RS) {
    const int row = blockIdx.x * 4 + (threadIdx.x >> 6), lane = threadIdx.x & 63;
    const float* xr = x + (size_t)row * D; float s = 0.f;
    for (int i = lane; i < D; i += 64) { const float v = xr[i]; s += v * v; XB[(size_t)row * D + i] = f2bf(v); }
    s = wave_sum(s);
    if (lane == 0) RS[row] = rsqrtf(s * (1.f / D) + EPS);
}

template <class Epi>
__global__ void __launch_bounds__(256) n_gemm(const bf16* A, int lda, const float* rs, const float* nw, const float* W, int ldw, int M, int N, int K, Epi epi) {
    __shared__ float As[16][65], Ws[16][64];
    const int tid = threadIdx.x, tx = tid & 15, ty = tid >> 4, m0 = blockIdx.y * 64, n0 = blockIdx.x * 64;
    float acc[4][4];
#pragma unroll
    for (int i = 0; i < 4; ++i)
#pragma unroll
        for (int j = 0; j < 4; ++j) acc[i][j] = 0.f;
    for (int k0 = 0; k0 < K; k0 += 16) {
#pragma unroll
        for (int i = 0; i < 4; ++i) { const int idx = tid + 256 * i, r = idx >> 4, kk = idx & 15; As[kk][r] = bf2f(A[(size_t)(m0 + r) * lda + k0 + kk]) * (nw ? nw[k0 + kk] : 1.f); }
#pragma unroll
        for (int i = 0; i < 4; ++i) { const int idx = tid + 256 * i, kk = idx >> 6, n = idx & 63; Ws[kk][n] = (n0 + n < N) ? W[(size_t)(k0 + kk) * ldw + n0 + n] : 0.f; }
        __syncthreads();
#pragma unroll
        for (int kk = 0; kk < 16; ++kk) {
            float a[4], b[4];
#pragma unroll
            for (int i = 0; i < 4; ++i) a[i] = As[kk][ty * 4 + i];
#pragma unroll
            for (int j = 0; j < 4; ++j) b[j] = Ws[kk][tx + 16 * j];
#pragma unroll
            for (int i = 0; i < 4; ++i)
#pragma unroll
                for (int j = 0; j < 4; ++j) acc[i][j] += a[i] * b[j];
        }
        __syncthreads();
    }
#pragma unroll
    for (int i = 0; i < 4; ++i) { const int r = m0 + ty * 4 + i; const float sc = rs ? rs[r] : 1.f;
#pragma unroll
        for (int j = 0; j < 4; ++j) { const int c = n0 + tx + 16 * j; if (c < N) epi(r, c, acc[i][j] * sc); } }
}
struct EpiGlaProj { bf16 *Q, *Kb, *V, *SG; float* LR;
    __device__ void operator()(int r, int c, float v) const {
        if (c < 512) Q[(size_t)r * 512 + c] = f2bf(v);
        else if (c < 1024) Kb[(size_t)r * 512 + c - 512] = f2bf(v);
        else if (c < 2048) V[(size_t)r * 1024 + c - 1024] = f2bf(v);
        else if (c < 3072) SG[(size_t)r * 1024 + c - 2048] = f2bf(siluf_(v));
        else LR[(size_t)r * 16 + c - 3072] = v; } };
struct EpiResid { const float* xf; const bf16* xb; bf16* out;
    __device__ void operator()(int r, int c, float v) const { const size_t i = (size_t)r * D + c; out[i] = f2bf((xf ? xf[i] : bf2f(xb[i])) + v); } };
struct EpiLruIn { bf16 *XBR, *GATE;
    __device__ void operator()(int r, int c, float v) const { if (c < 1024) XBR[(size_t)r * D + c] = f2bf(v); else GATE[(size_t)r * D + c - 1024] = f2bf(gelu_tanhf_(v)); } };
struct EpiGate { bf16* O; const float* bias; int coff; int pad;
    __device__ void operator()(int r, int c, float v) const { O[(size_t)r * D + coff + c] = f2bf(sigmoidf_(v + bias[coff + c])); } };

__global__ void __launch_bounds__(256) n_gla_prep(const float* LR, const float* w_alpha, const float* b_alpha, bf16* EQ, bf16* EK, float* EREF, float* ELAST, float* ELR, float* AF) {
    const int gi = blockIdx.x * 256 + threadIdx.x, chunk = gi >> 9, col = gi & 511;
    float wa[16];
#pragma unroll
    for (int r = 0; r < 16; ++r) wa[r] = w_alpha[r * 512 + col];
    const float ba = b_alpha[col];
    float cum = 0.f, ref = 0.f;
    for (int i = 0; i < 64; ++i) { const float* lr = LR + (size_t)(chunk * 64 + i) * 16; float z = ba;
#pragma unroll
        for (int r = 0; r < 16; ++r) z += lr[r] * wa[r];
        const float la = logsigmoidf_(z) * (1.f / 16.f); cum += la; if (i == 32) ref = cum; AF[(size_t)(chunk * 64 + i) * 512 + col] = __expf(la); }
    const float last = cum;
    EREF[chunk * 512 + col] = __expf(ref); ELAST[chunk * 512 + col] = __expf(last); ELR[chunk * 512 + col] = __expf(last - ref);
    cum = 0.f;
    for (int i = 0; i < 64; ++i) { const float* lr = LR + (size_t)(chunk * 64 + i) * 16; float z = ba;
#pragma unroll
        for (int r = 0; r < 16; ++r) z += lr[r] * wa[r];
        cum += logsigmoidf_(z) * (1.f / 16.f);
        const size_t o = (size_t)(chunk * 64 + i) * 512 + col;
        EQ[o] = f2bf(0.08838834764831845f * __expf(cum - ref)); EK[o] = f2bf(__expf(ref - cum)); }
}
__global__ void __launch_bounds__(256) n_gla_core(const bf16* Q, const bf16* Kb, const bf16* V, const bf16* SG, const float* AF, const float* hn, bf16* OG) {
    __shared__ float red[4];
    const int bh = blockIdx.x, b = bh >> 2, h = bh & 3, e = threadIdx.x, lane = e & 63, w = e >> 6;
    float S[128];
#pragma unroll
    for (int d = 0; d < 128; ++d) S[d] = 0.f;
    const float hw = hn[e];
    for (int t = 0; t < SEQ; ++t) {
        const size_t row = (size_t)b * SEQ + t;
        const float v = bf2f(V[row * 1024 + h * 256 + e]);
        const float* a = AF + row * 512 + h * 128; const bf16* k = Kb + row * 512 + h * 128; const bf16* q = Q + row * 512 + h * 128;
        float o = 0.f;
#pragma unroll
        for (int d = 0; d < 128; ++d) { S[d] = a[d] * S[d] + bf2f(k[d]) * v; o += bf2f(q[d]) * S[d]; }
        o *= 0.08838834764831845f;
        float ss = wave_sum(o * o);
        __syncthreads();
        if (lane == 0) red[w] = ss;
        __syncthreads();
        ss = red[0] + red[1] + red[2] + red[3];
        const float rstd = rsqrtf(ss * (1.f / 256.f) + EPS);
        OG[row * 1024 + h * 256 + e] = f2bf(o * rstd * hw * bf2f(SG[row * 1024 + h * 256 + e]));
    }
}
__global__ void __launch_bounds__(256) n_moe(const bf16* Xin, const float* nw, const float* wg, const float* we, const float* Wgate, const float* Wup, const float* Wdown,
                                             bf16* Xout, float* RSout, const float* final_w, float* out) {
    __shared__ float hs[1024], logit[36], act[256], red[4]; __shared__ int sel[2]; __shared__ float selw[2];
    const int t = blockIdx.x, tid = threadIdx.x, lane = tid & 63, w = tid >> 6;
    float xv[4]; float s = 0.f;
#pragma unroll
    for (int i = 0; i < 4; ++i) { xv[i] = bf2f(Xin[(size_t)t * D + tid + 256 * i]); s += xv[i] * xv[i]; }
    s = wave_sum(s); if (lane == 0) red[w] = s; __syncthreads();
    const float rstd = rsqrtf((red[0] + red[1] + red[2] + red[3]) * (1.f / D) + EPS);
#pragma unroll
    for (int i = 0; i < 4; ++i) hs[tid + 256 * i] = xv[i] * rstd * nw[tid + 256 * i];
    __syncthreads();
    for (int li = w * 9; li < w * 9 + 9; ++li) { float p = 0.f;
        for (int k = lane; k < D; k += 64) p += hs[k] * (li < 4 ? wg[k * 4 + li] : we[k * 32 + li - 4]);
        p = wave_sum(p); if (lane == 0) logit[li] = p; }
    __syncthreads();
    if (tid == 0) {
        int g = 0; float gm = logit[0];
        for (int i = 1; i < 4; ++i) if (logit[i] > gm) { gm = logit[i]; g = i; }
        float gs = 0.f; for (int i = 0; i < 4; ++i) gs += __expf(logit[i] - gm);
        const float pg = 1.f / gs;
        const float* el = logit + 4 + g * 8; int e0 = 0; float m0 = el[0];
        for (int i = 1; i < 8; ++i) if (el[i] > m0) { m0 = el[i]; e0 = i; }
        int e1 = -1; float m1 = -3.0e38f;
        for (int i = 0; i < 8; ++i) if (i != e0 && el[i] > m1) { m1 = el[i]; e1 = i; }
        const float p1 = __expf(m1 - m0), den = 1.f + p1;
        sel[0] = g * 8 + e0; sel[1] = g * 8 + e1; selw[0] = pg / den; selw[1] = pg * p1 / den;
    }
    __syncthreads();
    float oacc[4] = {0.f, 0.f, 0.f, 0.f};
    for (int kk = 0; kk < 2; ++kk) {
        const int e = sel[kk]; const float wt = selw[kk];
        const float* G = Wgate + (size_t)e * D * 256; const float* U = Wup + (size_t)e * D * 256; const float* Dn = Wdown + (size_t)e * 256 * D;
        float ga = 0.f, ua = 0.f;
        for (int k = 0; k < D; ++k) { const float hv = hs[k]; ga += hv * G[k * 256 + tid]; ua += hv * U[k * 256 + tid]; }
        __syncthreads();
        act[tid] = siluf_(ga) * ua;
        __syncthreads();
        float o4[4] = {0.f, 0.f, 0.f, 0.f};
        for (int f = 0; f < 256; ++f) { const float av = act[f];
#pragma unroll
            for (int i = 0; i < 4; ++i) o4[i] += av * Dn[(size_t)f * D + tid + 256 * i]; }
#pragma unroll
        for (int i = 0; i < 4; ++i) oacc[i] += wt * o4[i];
    }
    float s2 = 0.f;
#pragma unroll
    for (int i = 0; i < 4; ++i) { xv[i] += oacc[i]; s2 += xv[i] * xv[i]; }
    s2 = wave_sum(s2); __syncthreads(); if (lane == 0) red[w] = s2; __syncthreads();
    const float rstd2 = rsqrtf((red[0] + red[1] + red[2] + red[3]) * (1.f / D) + EPS);
    if (out) {
#pragma unroll
        for (int i = 0; i < 4; ++i) out[(size_t)t * D + tid + 256 * i] = xv[i] * rstd2 * final_w[tid + 256 * i];
    } else {
#pragma unroll
        for (int i = 0; i < 4; ++i) Xout[(size_t)t * D + tid + 256 * i] = f2bf(xv[i]);
        if (tid == 0) RSout[t] = rstd2;
    }
}
__global__ void __launch_bounds__(256) n_conv(const bf16* XBR, const float* cw, const float* cb, bf16* XC) {
    const size_t i = (size_t)blockIdx.x * 256 + threadIdx.x; const int c = (int)(i & 1023); const int row = (int)(i >> 10), s = row & (SEQ - 1);
    float v = cb[c];
#pragma unroll
    for (int tap = 0; tap < 4; ++tap) { const int ss = s - 3 + tap; if (ss >= 0) v += cw[tap * 1024 + c] * bf2f(XBR[(size_t)(row - 3 + tap) * D + c]); }
    XC[i] = f2bf(v);
}
__global__ void __launch_bounds__(256) n_lru_scan(const bf16* XC, const bf16* RG, const bf16* IG, const bf16* GATE, const float* lam, bf16* YL) {
    const int gi = blockIdx.x * 256 + threadIdx.x, b = gi >> 10, c = gi & 1023;
    const float sp = softplusf_(-lam[c]); float h = 0.f;
    for (int t = 0; t < SEQ; ++t) { const size_t i = ((size_t)b * SEQ + t) * D + c;
        const float la = -8.f * bf2f(RG[i]) * sp, a = __expf(la), mult = sqrtf(-expm1f(2.f * la));
        h = a * h + bf2f(XC[i]) * bf2f(IG[i]) * mult;
        YL[i] = f2bf(h * bf2f(GATE[i])); }
}


#define LAS __attribute__((address_space(3)))
#define GAS __attribute__((address_space(1)))
typedef short bf16x8 __attribute__((ext_vector_type(8)));
typedef float f32x4 __attribute__((ext_vector_type(4)));
typedef float f32x2 __attribute__((ext_vector_type(2)));
typedef unsigned u32x4 __attribute__((ext_vector_type(4)));
typedef unsigned u32x2 __attribute__((ext_vector_type(2)));
typedef GAS unsigned gu32;
#define RLX_AGENT __ATOMIC_RELAXED, __HIP_MEMORY_SCOPE_AGENT
constexpr int NWAVES = 8, NTHR = 512;
constexpr int LDS_STAGE = 131072, LDS_MISC = LDS_STAGE, LDS_BYTES = 147456;
constexpr float QSCALE = 0.08838834764831845f;

constexpr size_t WS_SP = 1 * MiB + 512 * 1024;
constexpr size_t WS_WR = 14 * MiB;
constexpr size_t WS_W1 = 16 * MiB;
constexpr size_t WS_WO = WS_W1 + (size_t)3584 * 1024 * 2;
constexpr size_t WS_WLI = WS_WO + (size_t)1024 * 1024 * 2;
constexpr size_t WS_WLO = WS_WLI + (size_t)2048 * 1024 * 2;
constexpr size_t WS_WG = WS_WLO + (size_t)1024 * 1024 * 2;
constexpr size_t WS_WGU = WS_WG + (size_t)4 * 512 * 256 * 2;
constexpr size_t WS_WD = WS_WGU + (size_t)64 * 512 * 1024 * 2;
static_assert(WS_WD + (size_t)64 * 1024 * 256 * 2 <= WS_S0, "weights fit below the activation slots");
constexpr int CW_TMO = 0, CW_BAR = 4096;

__device__ __forceinline__ unsigned cvt_pk_bf16(float lo, float hi) { unsigned r; asm volatile("v_cvt_pk_bf16_f32 %0, %1, %2" : "=v"(r) : "v"(lo), "v"(hi)); return r; }
__device__ __forceinline__ float fexp(float x) { return __builtin_amdgcn_exp2f(x * 1.4426950408889634f); }
__device__ __forceinline__ float flog(float x) { return __builtin_amdgcn_logf(x) * 0.6931471805599453f; }
__device__ __forceinline__ float frcp(float x) { return __builtin_amdgcn_rcpf(x); }
__device__ __forceinline__ float fsilu(float x) { return x * frcp(1.f + fexp(-x)); }
__device__ __forceinline__ float fsigmoid(float x) { return frcp(1.f + fexp(-x)); }
__device__ __forceinline__ float flogsigmoid(float x) { return fminf(x, 0.f) - flog(1.f + fexp(-fabsf(x))); }
__device__ __forceinline__ float fgelu_tanh(float x) { const float u = 1.5957691216057308f * (x + 0.044715f * x * x * x); return x * frcp(1.f + fexp(-u)); }
__device__ __forceinline__ int lane_id_v() { int l; asm volatile("v_mbcnt_lo_u32_b32 %0, -1, 0\n\tv_mbcnt_hi_u32_b32 %0, -1, %0" : "=v"(l)); return l; }
template <int N> __device__ __forceinline__ float dpp_shr(float v) {
    return __builtin_bit_cast(float, __builtin_amdgcn_update_dpp(0, __builtin_bit_cast(int, v), 0x110 + N, 0xf, 0xf, true)); }

#define XB_TMO      128
#define XB_XCNT(j)  (256  + 64 * (j))
#define XB_XSUB(j)  (1280 + 64 * (j))
#define XB_XGEN(j)  (2304 + 64 * (j))
#define XB_TOP      3328
#define XB_TOPGEN   3392
#define XCD_BAR_WORDS 3456
#define XB_SPIN_CAP (1u << 18)
__device__ __forceinline__ unsigned xb_ld(unsigned* p)              { return __hip_atomic_load(p, __ATOMIC_RELAXED, __HIP_MEMORY_SCOPE_AGENT); }
__device__ __forceinline__ unsigned xb_add(unsigned* p, unsigned v) { return __hip_atomic_fetch_add(p, v, __ATOMIC_RELAXED, __HIP_MEMORY_SCOPE_AGENT); }
__device__ __forceinline__ unsigned xb_xcc_id() { return (unsigned)__builtin_amdgcn_s_getreg((3 << 11) | 20) & 0xFu; }
#define XB_SPIN(cond, bar) do { unsigned _sp = 0; while (cond) { __builtin_amdgcn_s_sleep(1); \
    if ((++_sp & 255u) == 0u) { if (xb_ld(&(bar)[XB_TMO])) break; if (_sp > XB_SPIN_CAP) { atomicAdd(&(bar)[XB_TMO], 1u); break; } } } } while (0)
struct XcdBarrier { unsigned* bar; unsigned x; volatile LAS unsigned* st; };
__device__ __forceinline__ XcdBarrier xcd_barrier_post(unsigned* bar, volatile LAS unsigned* st, bool t0) {
    XcdBarrier b; b.bar = bar; b.x = xb_xcc_id(); b.st = st;
    if (t0) (void)xb_add(&bar[XB_XCNT(b.x)], 1u);
    return b;
}
__device__ __forceinline__ void xcd_barrier_complete(unsigned* bar, unsigned x, unsigned& nloc, unsigned& nx) {
    const unsigned G = gridDim.x * gridDim.y * gridDim.z;
    unsigned sum, cnt, mine, sp = 0u;
    for (;;) {
        sum = 0u; cnt = 0u; mine = 0u;
#pragma unroll
        for (unsigned j = 0; j < 16; ++j) { const unsigned c = xb_ld(&bar[XB_XCNT(j)]); sum += c; cnt += (c > 0u) ? 1u : 0u; mine = (j == x) ? c : mine; }
        if (sum == G) break;
        __builtin_amdgcn_s_sleep(1);
        if ((++sp & 255u) == 0u) { if (xb_ld(&bar[XB_TMO])) break; if (sp > XB_SPIN_CAP) { atomicAdd(&bar[XB_TMO], 1u); break; } }
    }
    nloc = mine > 0u ? mine : 1u; nx = cnt > 0u ? cnt : 1u;
}
__device__ __forceinline__ void xcd_barrier(const XcdBarrier& b, int wave_) {
    asm volatile("s_waitcnt vmcnt(0)" ::: "memory");
    __syncthreads();
    if (wave_ == 0 && lane_id_v() == 0) {
        unsigned* bar = b.bar;
        __builtin_amdgcn_s_waitcnt(0);
        unsigned nloc = b.st[0], nx = b.st[1];
        if (nloc == 0u) { xcd_barrier_complete(bar, b.x, nloc, nx); b.st[0] = nloc; b.st[1] = nx; }
        const unsigned old = xb_add(&bar[XB_XSUB(b.x)], 1u);
        const unsigned gen = old / nloc;
        if (old + 1u == (gen + 1u) * nloc) {
            __builtin_amdgcn_fence(__ATOMIC_RELEASE, "agent");
            asm volatile("s_waitcnt vmcnt(0)" ::: "memory");
            const unsigned og = xb_add(&bar[XB_TOP], 1u);
            const unsigned tg = og / nx;
            if (og + 1u == (tg + 1u) * nx) xb_add(&bar[XB_TOPGEN], 1u);
            else XB_SPIN(xb_ld(&bar[XB_TOPGEN]) == tg, bar);
            __builtin_amdgcn_fence(__ATOMIC_ACQUIRE, "agent");
            xb_add(&bar[XB_XGEN(b.x)], 1u);
            asm volatile("s_waitcnt vmcnt(0)" ::: "memory");
        } else {
            XB_SPIN(xb_ld(&bar[XB_XGEN(b.x)]) == gen, bar);
            __builtin_amdgcn_fence(__ATOMIC_ACQUIRE, "agent");
            asm volatile("s_waitcnt vmcnt(0)" ::: "memory");
        }
    }
    __syncthreads();
}

namespace pg8 {
constexpr int BM = 256, BK = 64, HALF = 128, HTB = HALF * BK * 2, NXCD = 8, WGM = 8;
__device__ __forceinline__ int lds_byte(int r, int c) { const int st = (r >> 4) * 2 + (c >> 5), rr = r & 15, cc = c & 31, ob = rr * 64 + cc * 2; return st * 1024 + (ob ^ (((ob >> 9) & 1) << 5)); }
__device__ __forceinline__ void stage_rc(int b, int& R, int& C) { const int st = b / 1024, sb = b % 1024, swz = sb ^ (((sb >> 9) & 1) << 5); R = (st >> 1) * 16 + swz / 64; C = (st & 1) * 32 + (swz % 64) / 2; }
__device__ __forceinline__ int perm32(int rho) { const int n = rho >> 4, i = rho & 15; return 8 * (i >> 2) + 4 * n + (i & 3); }
__device__ __forceinline__ void tile_order(int L, int nM, int nN, int& pm, int& pn) {
    const int nwg = nM * nN; int wgid = L; { const int q = nwg / NXCD, r = nwg % NXCD, xcd = wgid % NXCD, off = wgid / NXCD; wgid = (xcd < r ? xcd * (q + 1) : r * (q + 1) + (xcd - r) * q) + off; }
    const int nig = WGM * nN, gid = wgid / nig, fm = gid * WGM, gsz = (nM - fm) < WGM ? (nM - fm) : WGM;
    pm = fm + ((wgid % nig) % gsz); pn = (wgid % nig) / gsz;
}
struct Unit { const char* a; const char* b; const int* rows; int pm, pn, e; };

template <class Epi, class Sched, bool GATHER>
__device__ __forceinline__ void gemm_phase(LAS unsigned char* lds, const int lda, const int ldb, const int K, const Sched& S, const Epi& E, const int wid) {
    const int lane = lane_id_v(), tid = wid * 64 + lane, wr = wid >> 2, wc = wid & 3, fr = lane & 15, fq = lane >> 4;
    int nt = K / BK; asm volatile("" : "+s"(nt));
    int Rr[2], Cc[2]; unsigned voffB[2];
#pragma unroll
    for (int i = 0; i < 2; ++i) { int R, C; stage_rc(tid * 16 + i * 8192, R, C); Rr[i] = R; Cc[i] = C; const int Rb = (R & ~31) + perm32(R & 31); voffB[i] = (unsigned)(Rb * ldb + C) * 2u; }
    const size_t kstep = (size_t)(BK * 2);
    const size_t hstepB = (size_t)HALF * ldb * 2;
    const unsigned ldsw = (unsigned)wid * 1024u;
    const int aoff = lds_byte(wr * 64 + fr, fq * 8), boff = lds_byte(wc * 32 + fr, fq * 8);
#define PG8_SA(b, h) (((b) * 2 + (h)) * HTB)
#define PG8_SB(b, h) ((4 + (b) * 2 + (h)) * HTB)
#define PG8_STAGE(bufoff, gbase, voff) do { _Pragma("unroll") for (int _i = 0; _i < 2; ++_i) \
        __builtin_amdgcn_global_load_lds((const unsigned*)((const char*)(gbase) + (voff)[_i]), (LAS unsigned*)(lds + (bufoff) + ldsw + _i * 8192), 16, 0, 0); } while (0)
#define PG8_LDA(dst, b, h) do { _Pragma("unroll") for (int m = 0; m < 4; ++m) _Pragma("unroll") for (int k = 0; k < 2; ++k) dst[m][k] = *(const LAS bf16x8*)(lds + PG8_SA(b, h) + aoff + m * 2048 + k * 1024); } while (0)
#define PG8_LDB(dst, b, h) do { _Pragma("unroll") for (int n = 0; n < 2; ++n) _Pragma("unroll") for (int k = 0; k < 2; ++k) dst[n][k] = *(const LAS bf16x8*)(lds + PG8_SB(b, h) + boff + n * 2048 + k * 1024); } while (0)
#define PG8_MMA(ai, bj, At, Bt) do { __builtin_amdgcn_s_setprio(1); _Pragma("unroll") for (int m = 0; m < 4; ++m) _Pragma("unroll") for (int n = 0; n < 2; ++n) _Pragma("unroll") for (int k = 0; k < 2; ++k) \
        acc[ai][bj][m][n] = __builtin_amdgcn_mfma_f32_16x16x32_bf16(Bt[n][k], At[m][k], acc[ai][bj][m][n], 0, 0, 0); __builtin_amdgcn_s_setprio(0); } while (0)
#define PG8_WAIT_V(n) asm volatile("s_waitcnt vmcnt(" #n ")" ::: "memory")
#define PG8_WAIT_L(n) asm volatile("s_waitcnt lgkmcnt(" #n ")" ::: "memory")
#define PG8_BAR __builtin_amdgcn_s_barrier()
#define PG8_SCHED __builtin_amdgcn_sched_barrier(0)
#define PG8_SETVOFF(v, u) do { _Pragma("unroll") for (int _h = 0; _h < 2; ++_h) _Pragma("unroll") for (int _i = 0; _i < 2; ++_i) { \
        if (GATHER) { unsigned _tk = (unsigned)(u).rows[_h * HALF + Rr[_i]]; _tk = _tk < (unsigned)T ? _tk : 0u; (v)[_h][_i] = (_tk * (unsigned)lda + (unsigned)Cc[_i]) * 2u; } else (v)[_h][_i] = (unsigned)(((_h * HALF + Rr[_i]) * lda + Cc[_i]) * 2); } } while (0)
    Unit cur, nxt; int ui = 0;
    if (!S.next(0, cur)) return;
    f32x4 acc[2][2][4][2];
#pragma unroll
    for (int a = 0; a < 2; ++a)
#pragma unroll
        for (int b = 0; b < 2; ++b)
#pragma unroll
            for (int m = 0; m < 4; ++m)
#pragma unroll
                for (int n = 0; n < 2; ++n) acc[a][b][m][n] = (f32x4){0.f, 0.f, 0.f, 0.f};
    bf16x8 At[4][2], B0[2][2], B1[2][2];
    unsigned vA[2][2], vN[2][2];
    PG8_SETVOFF(vA, cur);
    if (GATHER) asm volatile("" :: "v"(vA[0][0]), "v"(vA[0][1]), "v"(vA[1][0]), "v"(vA[1][1]));
    const char* cA = cur.a; const char* cB = cur.b;
    PG8_STAGE(PG8_SB(0, 0), cB, voffB); PG8_STAGE(PG8_SB(0, 1), cB + hstepB, voffB); PG8_STAGE(PG8_SA(0, 0), cA, vA[0]); PG8_STAGE(PG8_SA(0, 1), cA, vA[1]);
    if (wr == 1) PG8_BAR;
    PG8_WAIT_V(2); PG8_BAR;
    PG8_STAGE(PG8_SB(1, 0), cB + kstep, voffB); PG8_STAGE(PG8_SA(1, 0), cA + kstep, vA[0]); PG8_STAGE(PG8_SB(1, 1), cB + hstepB + kstep, voffB);
    PG8_WAIT_V(6); PG8_BAR;
    for (;;) {
        const bool has_next = S.next(ui + 1, nxt);
        const char* nA = has_next ? nxt.a : cA; const char* nB = has_next ? nxt.b : cB;
        if (GATHER) {
            if (has_next) { PG8_SETVOFF(vN, nxt); } else {
#pragma unroll
                for (int h = 0; h < 2; ++h)
#pragma unroll
                    for (int i = 0; i < 2; ++i) vN[h][i] = vA[h][i]; }
            asm volatile("" :: "v"(vN[0][0]), "v"(vN[0][1]), "v"(vN[1][0]), "v"(vN[1][1]));
        }
#pragma nounroll
        for (int t = 0; t < nt; t += 2) {
            const bool last = (t == nt - 2);
            const char* a1 = cA + (size_t)(t + 1) * kstep;
            const char* a2 = last ? nA : cA + (size_t)(t + 2) * kstep; const char* b2 = last ? nB : cB + (size_t)(t + 2) * kstep;
            const char* a3 = a2 + kstep; const char* b3 = b2 + kstep;
            PG8_LDB(B0, 0, 0); PG8_LDB(B1, 0, 1); PG8_SCHED; PG8_LDA(At, 0, 0); PG8_STAGE(PG8_SA(1, 1), a1, vA[1]);
            if (GATHER && last) {
#pragma unroll
                for (int h = 0; h < 2; ++h)
#pragma unroll
                    for (int i = 0; i < 2; ++i) vA[h][i] = vN[h][i]; }
            PG8_WAIT_V(8); PG8_WAIT_L(0); PG8_BAR; PG8_MMA(0, 0, At, B0); PG8_MMA(0, 1, At, B1); PG8_BAR; PG8_SCHED;
            PG8_LDA(At, 0, 1); PG8_STAGE(PG8_SB(0, 0), b2, voffB); PG8_STAGE(PG8_SB(0, 1), b2 + hstepB, voffB); PG8_STAGE(PG8_SA(0, 0), a2, vA[0]);
            PG8_WAIT_V(8); PG8_WAIT_L(0); PG8_BAR; PG8_MMA(1, 0, At, B0); PG8_MMA(1, 1, At, B1); PG8_BAR; PG8_SCHED;
            PG8_LDB(B0, 1, 0); PG8_LDB(B1, 1, 1); PG8_SCHED; PG8_LDA(At, 1, 0); PG8_STAGE(PG8_SA(0, 1), a2, vA[1]);
            PG8_WAIT_V(8); PG8_WAIT_L(0); PG8_BAR; PG8_MMA(0, 0, At, B0); PG8_MMA(0, 1, At, B1); PG8_BAR; PG8_SCHED;
            PG8_LDA(At, 1, 1); PG8_STAGE(PG8_SB(1, 0), b3, voffB); PG8_STAGE(PG8_SB(1, 1), b3 + hstepB, voffB); PG8_STAGE(PG8_SA(1, 0), a3, vA[0]);
            PG8_WAIT_V(8); PG8_WAIT_L(0); PG8_BAR; PG8_MMA(1, 0, At, B0); PG8_MMA(1, 1, At, B1); PG8_BAR; PG8_SCHED;
        }
        if (wr == 0) PG8_BAR;
        E(acc, cur, wr, wc, fr, fq, lane);
        if (!has_next) break;
#pragma unroll
        for (int a = 0; a < 2; ++a)
#pragma unroll
            for (int b = 0; b < 2; ++b)
#pragma unroll
                for (int m = 0; m < 4; ++m)
#pragma unroll
                    for (int n = 0; n < 2; ++n) acc[a][b][m][n] = (f32x4){0.f, 0.f, 0.f, 0.f};
        cur = nxt; cA = nA; cB = nB; ++ui;
        if (wr == 1) PG8_BAR;
    }
    PG8_WAIT_V(0);
    PG8_BAR;
#undef PG8_SA
#undef PG8_SB
#undef PG8_STAGE
#undef PG8_LDA
#undef PG8_LDB
#undef PG8_MMA
#undef PG8_WAIT_V
#undef PG8_WAIT_L
#undef PG8_BAR
#undef PG8_SCHED
#undef PG8_SETVOFF
}
struct SchedDense {
    int nM, nN, G, c; const char* A; const char* B; size_t a_tile, b_tile; int pn_div; size_t a_pn_step;
    __device__ __forceinline__ bool next(int i, Unit& u) const {
        const long L = (long)i * G + c; if (L >= (long)nM * nN) return false;
        int pm, pn; tile_order((int)L, nM, nN, pm, pn);
        u.pm = pm; u.pn = pn; u.e = 0; u.rows = nullptr; u.a = A + (size_t)pm * a_tile + (size_t)(pn / pn_div) * a_pn_step; u.b = B + (size_t)pn * b_tile; return true;
    }
};
}

__device__ __forceinline__ void unpack8(const u32x4 p, f32x4& r0, f32x4& r1) {
    r0 = (f32x4){__uint_as_float(p.x << 16), __uint_as_float(p.x & 0xffff0000u), __uint_as_float(p.y << 16), __uint_as_float(p.y & 0xffff0000u)};
    r1 = (f32x4){__uint_as_float(p.z << 16), __uint_as_float(p.z & 0xffff0000u), __uint_as_float(p.w << 16), __uint_as_float(p.w & 0xffff0000u)}; }
__device__ __forceinline__ u32x4 pack8(const f32x4 v0, const f32x4 v1) { u32x4 w; w.x = cvt_pk_bf16(v0[0], v0[1]); w.y = cvt_pk_bf16(v0[2], v0[3]); w.z = cvt_pk_bf16(v1[0], v1[1]); w.w = cvt_pk_bf16(v1[2], v1[3]); return w; }

struct EpiG1 {
    bf16 *Q, *Kb, *V, *SG, *EQ, *EK; float *EREF, *ELAST, *ELR, *AF; const float* RS; const float* b_alpha;
    __device__ __forceinline__ void operator()(f32x4 (&acc)[2][2][4][2], const pg8::Unit& u, int wr, int wc, int fr, int fq, int lane) const {
        const int row0 = u.pm * 256 + wr * 64 + fr, pn = u.pn;
        if (pn < 12) {
            bf16* base; int ldc, colt; const bool act = pn >= 8;
            if (pn < 2) { base = Q; ldc = 512; colt = pn * 256; } else if (pn < 4) { base = Kb; ldc = 512; colt = (pn - 2) * 256; }
            else if (pn < 8) { base = V; ldc = 1024; colt = (pn - 4) * 256; } else { base = SG; ldc = 1024; colt = (pn - 8) * 256; }
            const int col0 = colt + wc * 32 + 8 * fq;
#pragma unroll
            for (int ai = 0; ai < 2; ++ai)
#pragma unroll
                for (int m = 0; m < 4; ++m) { const int row = row0 + ai * 128 + m * 16; const float rs = RS[row]; bf16* rowp = base + (size_t)row * ldc + col0;
#pragma unroll
                    for (int bj = 0; bj < 2; ++bj) { f32x4 v0 = acc[ai][bj][m][0] * rs, v1 = acc[ai][bj][m][1] * rs;
                        if (act) {
#pragma unroll
                            for (int j = 0; j < 4; ++j) { v0[j] = fsilu(v0[j]); v1[j] = fsilu(v1[j]); } }
                        u32x4 w; w.x = cvt_pk_bf16(v0[0], v0[1]); w.y = cvt_pk_bf16(v0[2], v0[3]); w.z = cvt_pk_bf16(v1[0], v1[1]); w.w = cvt_pk_bf16(v1[2], v1[3]);
                        *(u32x4*)(rowp + bj * 128) = w; } }
        } else {
            const int colt = (pn - 12) * 256;
#pragma unroll
            for (int ai = 0; ai < 2; ++ai) {
                const int chunk = u.pm * 4 + ai * 2 + wr; float rsv[4];
#pragma unroll
                for (int m = 0; m < 4; ++m) rsv[m] = RS[row0 + ai * 128 + m * 16];
#pragma unroll
                for (int bj = 0; bj < 2; ++bj)
#pragma unroll
                    for (int n = 0; n < 2; ++n) {
                        const int c = colt + bj * 128 + wc * 32 + 8 * fq + 4 * n;
                        const f32x4 ba = *(const f32x4*)(b_alpha + c);
                        f32x4 cum[4]; f32x4 run = (f32x4){0.f, 0.f, 0.f, 0.f};
#pragma unroll
                        for (int m = 0; m < 4; ++m) { const f32x4 z = acc[ai][bj][m][n] * rsv[m] + ba; f32x4 la;
#pragma unroll
                            for (int j = 0; j < 4; ++j) la[j] = flogsigmoid(z[j]) * 0.0625f;
                            if (AF) { f32x4 ea;
#pragma unroll
                                for (int j = 0; j < 4; ++j) ea[j] = fexp(la[j]);
                                *(f32x4*)(AF + (size_t)(row0 + ai * 128 + m * 16) * 512 + c) = ea; }
                            f32x4 tot;
#pragma unroll
                            for (int j = 0; j < 4; ++j) { float v = la[j]; v += dpp_shr<1>(v); v += dpp_shr<2>(v); v += dpp_shr<4>(v); v += dpp_shr<8>(v); la[j] = v; tot[j] = __shfl(v, lane | 15); }
                            cum[m] = la + run; run += tot; }
                        f32x4 ref;
#pragma unroll
                        for (int j = 0; j < 4; ++j) ref[j] = __shfl(cum[2][j], lane & 48);
#pragma unroll
                        for (int m = 0; m < 4; ++m) { const size_t o = (size_t)(row0 + ai * 128 + m * 16) * 512 + c; float q[4], k[4];
#pragma unroll
                            for (int j = 0; j < 4; ++j) { q[j] = QSCALE * fexp(cum[m][j] - ref[j]); k[j] = fexp(ref[j] - cum[m][j]); }
                            u32x2 wq, wk; wq.x = cvt_pk_bf16(q[0], q[1]); wq.y = cvt_pk_bf16(q[2], q[3]); wk.x = cvt_pk_bf16(k[0], k[1]); wk.y = cvt_pk_bf16(k[2], k[3]);
                            *(u32x2*)(EQ + o) = wq; *(u32x2*)(EK + o) = wk; }
                        { f32x4 er, el, elr;
#pragma unroll
                            for (int j = 0; j < 4; ++j) { er[j] = fexp(ref[j]); el[j] = fexp(run[j]); elr[j] = fexp(run[j] - ref[j]); }
                            asm volatile("" : "+v"(er), "+v"(el), "+v"(elr));
                            if (fr == 0) { *(f32x4*)(EREF + chunk * 512 + c) = er; *(f32x4*)(ELAST + chunk * 512 + c) = el; *(f32x4*)(ELR + chunk * 512 + c) = elr; } }
                    }
            }
        }
    }
};
__device__ __forceinline__ unsigned opaque_u0(unsigned v) { asm volatile("" : "+v"(v)); return v; }
struct EpiResidF {
    const float* xf; const bf16* xb; bf16* out;
    __device__ __forceinline__ void operator()(f32x4 (&acc)[2][2][4][2], const pg8::Unit& u, int wr, int wc, int fr, int fq, int lane) const {
        const size_t uo = (size_t)u.pm * 256 * 1024 + u.pn * 256;
        const char* xfb = (const char*)(xf + uo); const char* xbb = (const char*)(xb + uo); char* ob = (char*)(out + uo);
        const unsigned lo = opaque_u0((unsigned)((wr * 64 + fr) * 1024 + wc * 32 + 8 * fq) * 2u);
#pragma unroll
        for (int ai = 0; ai < 2; ++ai)
#pragma unroll
            for (int m = 0; m < 4; ++m)
#pragma unroll
                for (int bj = 0; bj < 2; ++bj) { const unsigned o = lo + (unsigned)((ai * 128 + m * 16) * 1024 + bj * 128) * 2u; f32x4 r0, r1;
                    if (xf) { r0 = *(const f32x4*)(xfb + 2u * o); r1 = *(const f32x4*)(xfb + (2u * o + 16u)); }
                    else unpack8(*(const u32x4*)(xbb + o), r0, r1);
                    *(u32x4*)(ob + o) = pack8(acc[ai][bj][m][0] + r0, acc[ai][bj][m][1] + r1); }
    }
};

__device__ __forceinline__ void cvt_item(const float* W, int ldn, int scol0, const float* kscale, bf16* dst, int dstK, int drow0, int kb, int nb, LAS float* scr, int lane, int kmask = 0x7fffffff) {
    const int k0 = 64 * kb, n0 = 32 * nb;
    float vv[32];
    const GAS float* wp = (const GAS float*)W + (size_t)(k0 + (lane >> 5)) * ldn + scol0 + n0 + (lane & 31);
#pragma unroll
    for (int i = 0; i < 32; ++i) vv[i] = wp[(size_t)(2 * i) * ldn];
#pragma unroll
    for (int i = 0; i < 32; ++i) { const int kk = 2 * i + (lane >> 5); float v = vv[i]; if (kscale) v *= kscale[(k0 + kk) & kmask]; scr[kk * 33 + (lane & 31)] = v; }
    asm volatile("s_waitcnt lgkmcnt(0)" ::: "memory");
    const int c = lane & 7;
#pragma unroll
    for (int j = 0; j < 4; ++j) { const int n = (lane >> 3) + 8 * j; const LAS float* s = scr + (8 * c) * 33 + n;
        u32x4 o; o.x = cvt_pk_bf16(s[0 * 33], s[1 * 33]); o.y = cvt_pk_bf16(s[2 * 33], s[3 * 33]); o.z = cvt_pk_bf16(s[4 * 33], s[5 * 33]); o.w = cvt_pk_bf16(s[6 * 33], s[7 * 33]);
        *(u32x4*)(dst + (size_t)(drow0 + n0 + n) * dstK + k0 + 8 * c) = o; }
    asm volatile("s_waitcnt lgkmcnt(0)" ::: "memory");
}
__device__ __forceinline__ void cvt_item_la(const float* Win, const float* wal, const float* kscale, bf16* dst, int kb, int nb, LAS float* scr, int lane) {
    const int k0 = 64 * kb, n0 = 32 * nb; float wa[16];
#pragma unroll
    for (int r = 0; r < 16; ++r) wa[r] = wal[r * 512 + n0 + (lane & 31)];
#pragma unroll 4
    for (int i = 0; i < 32; ++i) { const int kk = 2 * i + (lane >> 5); const float* lr = Win + (size_t)(k0 + kk) * 3088 + 3072; float v = 0.f;
#pragma unroll
        for (int r = 0; r < 16; ++r) v += lr[r] * wa[r];
        scr[kk * 33 + (lane & 31)] = v * kscale[k0 + kk]; }
    asm volatile("s_waitcnt lgkmcnt(0)" ::: "memory");
    const int c = lane & 7;
#pragma unroll
    for (int j = 0; j < 4; ++j) { const int n = (lane >> 3) + 8 * j; const LAS float* s = scr + (8 * c) * 33 + n;
        u32x4 o; o.x = cvt_pk_bf16(s[0 * 33], s[1 * 33]); o.y = cvt_pk_bf16(s[2 * 33], s[3 * 33]); o.z = cvt_pk_bf16(s[4 * 33], s[5 * 33]); o.w = cvt_pk_bf16(s[6 * 33], s[7 * 33]);
        *(u32x4*)(dst + (size_t)(3072 + n0 + n) * 1024 + k0 + 8 * c) = o; }
    asm volatile("s_waitcnt lgkmcnt(0)" ::: "memory");
}


constexpr int CAP = 32768;
constexpr size_t WS_LIST = 5 * MiB, WS_LW = 9 * MiB, WS_POS = 13 * MiB;
constexpr size_t WS_AGG = 13 * MiB + 512 * 1024;
constexpr size_t WS_CARRY = 5 * MiB;
constexpr int CW_CNT = 16384;
constexpr int TS_OFF = 256;

namespace pg8 {
struct SchedMoe {
    const LAS int* ts; int G, c, npn; const char* A; const char* B; const int* LIST; size_t b_exp, b_pn, a_tile; bool gather;
    __device__ __forceinline__ bool next(int i, Unit& u) const {
        const int NT = __builtin_amdgcn_readfirstlane(ts[32]); const long L = (long)i * G + c; if (L >= (long)NT * npn) return false;
        const int tg = (int)(L / npn), pn = (int)(L % npn);
        const int e = __builtin_amdgcn_readfirstlane(ts[64 + tg]);
        const int tile = tg - __builtin_amdgcn_readfirstlane(ts[e]);
        u.pm = tg; u.pn = pn; u.e = e; u.rows = LIST + (size_t)e * CAP + tile * 256; u.a = gather ? A : A + (size_t)tg * a_tile; u.b = B + (size_t)e * b_exp + (size_t)pn * b_pn; return true;
    }
};
}
__device__ __forceinline__ unsigned opaque_u(unsigned v) { asm volatile("" : "+v"(v)); return v; }
struct EpiM1 {
    bf16* ACT; const int* LIST; const float* LW; const float* RS;
    __device__ __forceinline__ void operator()(f32x4 (&acc)[2][2][4][2], const pg8::Unit& u, int wr, int wc, int fr, int fq, int lane) const {
        const char* rowsb = (const char*)u.rows; const char* lwb = (const char*)(LW + (u.rows - LIST)); const char* rsb = (const char*)RS;
        char* ob = (char*)(ACT + (size_t)u.pm * 256 * 256 + u.pn * 128);
        const unsigned r4 = opaque_u((unsigned)(wr * 64 + fr) * 4u), lo = opaque_u((unsigned)((wr * 64 + fr) * 256 + wc * 32 + 8 * fq) * 2u);
#pragma unroll
        for (int ai = 0; ai < 2; ++ai)
#pragma unroll
            for (int m = 0; m < 4; ++m) { const unsigned ro = r4 + (unsigned)(ai * 128 + m * 16) * 4u;
                unsigned tk = *(const unsigned*)(rowsb + ro); tk = tk < (unsigned)T ? tk : 0u;
                const float rs = *(const float*)(rsb + tk * 4u), w = *(const float*)(lwb + ro); f32x4 o[2];
#pragma unroll
                for (int n = 0; n < 2; ++n) { const f32x4 g = acc[ai][0][m][n] * rs, up = acc[ai][1][m][n] * rs;
#pragma unroll
                    for (int j = 0; j < 4; ++j) o[n][j] = fsilu(g[j]) * up[j] * w; }
                *(u32x4*)(ob + (lo + (unsigned)(ai * 128 + m * 16) * 512u)) = pack8(o[0], o[1]); }
    }
};
struct EpiStore {
    bf16* O; int ldc; int pad;
    __device__ __forceinline__ void operator()(f32x4 (&acc)[2][2][4][2], const pg8::Unit& u, int wr, int wc, int fr, int fq, int lane) const {
        char* ob = (char*)(O + (size_t)u.pm * 256 * 1024 + u.pn * 256);
        const unsigned lo = opaque_u((unsigned)((wr * 64 + fr) * 1024 + wc * 32 + 8 * fq) * 2u);
#pragma unroll
        for (int ai = 0; ai < 2; ++ai)
#pragma unroll
            for (int m = 0; m < 4; ++m)
#pragma unroll
                for (int bj = 0; bj < 2; ++bj) *(u32x4*)(ob + (lo + (unsigned)((ai * 128 + m * 16) * 1024 + bj * 128) * 2u)) = pack8(acc[ai][bj][m][0], acc[ai][bj][m][1]);
    }
};
struct EpiL1 {
    bf16 *XBR, *GATE; const float* RS;
    __device__ __forceinline__ void operator()(f32x4 (&acc)[2][2][4][2], const pg8::Unit& u, int wr, int wc, int fr, int fq, int lane) const {
        const bool act = u.pn >= 4; char* ob = (char*)((act ? GATE : XBR) + (size_t)u.pm * 256 * 1024 + (u.pn & 3) * 256); const char* rsb = (const char*)(RS + u.pm * 256);
        const unsigned r4 = opaque_u((unsigned)(wr * 64 + fr) * 4u), lo = opaque_u((unsigned)((wr * 64 + fr) * 1024 + wc * 32 + 8 * fq) * 2u);
#pragma unroll
        for (int ai = 0; ai < 2; ++ai)
#pragma unroll
            for (int m = 0; m < 4; ++m) { const float rs = *(const float*)(rsb + (r4 + (unsigned)(ai * 128 + m * 16) * 4u));
#pragma unroll
                for (int bj = 0; bj < 2; ++bj) { f32x4 v0 = acc[ai][bj][m][0] * rs, v1 = acc[ai][bj][m][1] * rs;
                    if (act) {
#pragma unroll
                        for (int j = 0; j < 4; ++j) { v0[j] = fgelu_tanh(v0[j]); v1[j] = fgelu_tanh(v1[j]); } }
                    *(u32x4*)(ob + (lo + (unsigned)((ai * 128 + m * 16) * 1024 + bj * 128) * 2u)) = pack8(v0, v1); } }
    }
};
struct EpiL2 {
    const bf16* XC; bf16 *LOGA, *XN; const float *br, *bi, *SP;
    __device__ __forceinline__ void operator()(f32x4 (&acc)[2][2][4][2], const pg8::Unit& u, int wr, int wc, int fr, int fq, int lane) const {
        const int cu = (u.pn >> 1) * 256 + (u.pn & 1) * 128; const size_t uo = (size_t)u.pm * 256 * 1024 + cu;
        const char* xcb = (const char*)(XC + uo); char* lab = (char*)(LOGA + uo); char* xnb = (char*)(XN + uo);
        const unsigned cl = opaque_u((unsigned)(wc * 32 + 8 * fq) * 4u), lo = opaque_u((unsigned)((wr * 64 + fr) * 1024 + wc * 32 + 8 * fq) * 2u);
        f32x4 vbr[2], vbi[2], vsp[2];
#pragma unroll
        for (int n = 0; n < 2; ++n) { vbr[n] = *(const f32x4*)((const char*)(br + cu) + (cl + 16u * n)); vbi[n] = *(const f32x4*)((const char*)(bi + cu) + (cl + 16u * n)); vsp[n] = *(const f32x4*)((const char*)(SP + cu) + (cl + 16u * n)); }
#pragma unroll
        for (int ai = 0; ai < 2; ++ai)
#pragma unroll
            for (int m = 0; m < 4; ++m) { const unsigned o = lo + (unsigned)((ai * 128 + m * 16) * 1024) * 2u;
                f32x4 xc[2]; unpack8(*(const u32x4*)(xcb + o), xc[0], xc[1]); f32x4 la[2], xn[2];
#pragma unroll
                for (int n = 0; n < 2; ++n)
#pragma unroll
                    for (int j = 0; j < 4; ++j) { const float r = fsigmoid(acc[ai][0][m][n][j] + vbr[n][j]), ig = fsigmoid(acc[ai][1][m][n][j] + vbi[n][j]);
                        const float l = -8.f * r * vsp[n][j]; la[n][j] = l; xn[n][j] = xc[n][j] * ig * sqrtf(fmaxf(1.f - fexp(2.f * l), 0.f)); }
                *(u32x4*)(lab + o) = pack8(la[0], la[1]); *(u32x4*)(xnb + o) = pack8(xn[0], xn[1]); }
    }
};

__device__ __forceinline__ void build_ts(unsigned* CNT, LAS int* ts, int tid) {
    __syncthreads();
    if (tid < 32) ts[400 + tid] = (int)((xb_ld(CNT + tid) + 255u) >> 8);
    __syncthreads();
    if (tid == 0) { int a = 0; for (int e = 0; e < 32; ++e) { ts[e] = a; a += ts[400 + e]; } ts[32] = a; }
    __syncthreads();
    if (tid < 32) { const int b = ts[tid], n = ts[tid + 1] - b; for (int k = 0; k < n; ++k) ts[64 + b + k] = tid; }
    __syncthreads();
}
__device__ __forceinline__ void router_phase(LAS unsigned char* lds, const bf16* X, const bf16* WRl, float* RS, unsigned* CNT, int* LIST, float* LW, int* POS, int bx, int G, int tid, int lane, int wave) {
    LAS float* lg = (LAS float*)lds + wave * (16 * 48);
    LAS float* rsl = (LAS float*)(lds + 24576) + wave * 16;
    LAS unsigned* cnt_l = (LAS unsigned*)(lds + 25600); LAS unsigned* base_l = cnt_l + 32;
    const int fr = lane & 15, fq = lane >> 4;
    for (int grp = bx; grp < T / 128; grp += G) {
        if (tid < 32) cnt_l[tid] = 0u;
        __syncthreads();
        const int t0 = grp * 128 + wave * 16;
        f32x4 a0 = (f32x4){0.f, 0.f, 0.f, 0.f}, a1 = a0, a2 = a0; float ss = 0.f;
        const bf16* xa = X + (size_t)(t0 + fr) * D + 8 * fq; const bf16* wb = WRl + (size_t)fr * D + 8 * fq;
#pragma unroll 8
        for (int s = 0; s < 32; ++s) {
            const bf16x8 a = *(const GAS bf16x8*)(xa + 32 * s), b0 = *(const GAS bf16x8*)(wb + 32 * s), b1 = *(const GAS bf16x8*)(wb + 16 * D + 32 * s), b2 = *(const GAS bf16x8*)(wb + 32 * D + 32 * s);
#pragma unroll
            for (int j = 0; j < 8; ++j) { const float v = bf2f((bf16)a[j]); ss += v * v; }
            a0 = __builtin_amdgcn_mfma_f32_16x16x32_bf16(a, b0, a0, 0, 0, 0); a1 = __builtin_amdgcn_mfma_f32_16x16x32_bf16(a, b1, a1, 0, 0, 0); a2 = __builtin_amdgcn_mfma_f32_16x16x32_bf16(a, b2, a2, 0, 0, 0);
        }
        ss += __shfl_xor(ss, 16); ss += __shfl_xor(ss, 32);
        const float rstd = rsqrtf(ss * (1.f / D) + EPS);
        if (fq == 0) { rsl[fr] = rstd; RS[t0 + fr] = rstd; }
#pragma unroll
        for (int r = 0; r < 4; ++r) { lg[(4 * fq + r) * 48 + fr] = a0[r]; lg[(4 * fq + r) * 48 + 16 + fr] = a1[r]; lg[(4 * fq + r) * 48 + 32 + fr] = a2[r]; }
        asm volatile("s_waitcnt lgkmcnt(0)" ::: "memory");
        int e0g = 0, e1g = 0; float w0 = 0.f, w1 = 0.f; unsigned rk0 = 0u, rk1 = 0u;
        if (lane < 16) {
            const LAS float* l = lg + lane * 48; const float rs = rsl[lane];
            int g = 0; float gm = l[0] * rs;
            for (int i = 1; i < 4; ++i) { const float v = l[i] * rs; if (v > gm) { gm = v; g = i; } }
            float gs = 0.f; for (int i = 0; i < 4; ++i) gs += fexp(l[i] * rs - gm);
            const float pg = 1.f / gs;
            const LAS float* el = l + 4 + g * 8; int e0 = 0; float m0 = el[0] * rs;
            for (int i = 1; i < 8; ++i) { const float v = el[i] * rs; if (v > m0) { m0 = v; e0 = i; } }
            int e1 = 0; float m1 = -3.0e38f;
            for (int i = 0; i < 8; ++i) { const float v = el[i] * rs; if (i != e0 && v > m1) { m1 = v; e1 = i; } }
            const float p1 = fexp(m1 - m0), den = 1.f / (1.f + p1);
            e0g = g * 8 + e0; e1g = g * 8 + e1; w0 = pg * den; w1 = pg * p1 * den;
            rk0 = __hip_atomic_fetch_add(cnt_l + e0g, 1u, __ATOMIC_RELAXED, __HIP_MEMORY_SCOPE_WORKGROUP);
            rk1 = __hip_atomic_fetch_add(cnt_l + e1g, 1u, __ATOMIC_RELAXED, __HIP_MEMORY_SCOPE_WORKGROUP);
        }
        __syncthreads();
        if (tid < 32) base_l[tid] = xb_add(CNT + tid, cnt_l[tid]);
        __syncthreads();
        if (lane < 16) { const int tok = t0 + lane; const int s0 = e0g * CAP + (int)(base_l[e0g] + rk0), s1 = e1g * CAP + (int)(base_l[e1g] + rk1);
            LIST[s0] = tok; LW[s0] = w0; LIST[s1] = tok; LW[s1] = w1; POS[2 * tok] = s0; POS[2 * tok + 1] = s1; }
        __syncthreads();
    }
}
__device__ __forceinline__ void combine_phase(const LAS int* ts, const bf16* X, const bf16* Y, const int* POS, bf16* Xn, float* RSn, const float* fw, float* out, int bx, int G, int lane, int wave) {
    const int NW = G * NWAVES;
    for (int t0 = bx * NWAVES + wave; t0 < T; t0 += 2 * NW) {
        int tk[2]; tk[0] = t0; tk[1] = t0 + NW < T ? t0 + NW : t0;
        size_t r0[2], r1[2];
#pragma unroll
        for (int q = 0; q < 2; ++q) { const int p0 = POS[2 * tk[q]], p1 = POS[2 * tk[q] + 1];
            r0[q] = (size_t)ts[p0 >> 15] * 256 + (p0 & (CAP - 1)); r1[q] = (size_t)ts[p1 >> 15] * 256 + (p1 & (CAP - 1)); }
        u32x4 lx[2][2], ly[2][2], lz[2][2];
#pragma unroll
        for (int q = 0; q < 2; ++q)
#pragma unroll
            for (int h = 0; h < 2; ++h) { const int c = h * 512 + lane * 8;
                lx[q][h] = *(const GAS u32x4*)(X + (size_t)tk[q] * D + c); ly[q][h] = *(const GAS u32x4*)(Y + r0[q] * D + c); lz[q][h] = *(const GAS u32x4*)(Y + r1[q] * D + c); }
#pragma unroll
        for (int q = 0; q < 2; ++q) { const int t = tk[q]; f32x4 v[4]; float ss = 0.f;
#pragma unroll
            for (int h = 0; h < 2; ++h) { f32x4 x0, x1, y0, y1, z0, z1; unpack8(lx[q][h], x0, x1); unpack8(ly[q][h], y0, y1); unpack8(lz[q][h], z0, z1);
                v[2 * h] = x0 + y0 + z0; v[2 * h + 1] = x1 + y1 + z1;
#pragma unroll
                for (int j = 0; j < 4; ++j) ss += v[2 * h][j] * v[2 * h][j] + v[2 * h + 1][j] * v[2 * h + 1][j]; }
            ss = wave_sum(ss); const float rstd = rsqrtf(ss * (1.f / D) + EPS);
            if (out) {
#pragma unroll
                for (int h = 0; h < 2; ++h) { const int c = h * 512 + lane * 8; const f32x4 f0 = *(const f32x4*)(fw + c), f1 = *(const f32x4*)(fw + c + 4);
                    *(GAS f32x4*)(out + (size_t)t * D + c) = v[2 * h] * rstd * f0; *(GAS f32x4*)(out + (size_t)t * D + c + 4) = v[2 * h + 1] * rstd * f1; }
            } else {
#pragma unroll
                for (int h = 0; h < 2; ++h) *(GAS u32x4*)(Xn + (size_t)t * D + h * 512 + lane * 8) = pack8(v[2 * h], v[2 * h + 1]);
                if (lane == 0) RSn[t] = rstd;
            }
        }
    }
}
__device__ __forceinline__ void conv_phase(const bf16* XBR, const float* cw, const float* cb, bf16* XC, int bx, int G, int tid) {
    for (int item = bx * NTHR + tid; item < (T / 32) * 128; item += G * NTHR) {
        const int cg = item & 127, run = item >> 7, c = cg * 8, t0 = run * 32;
        f32x4 w[4][2], b[2];
#pragma unroll
        for (int k = 0; k < 4; ++k) { w[k][0] = *(const f32x4*)(cw + k * D + c); w[k][1] = *(const f32x4*)(cw + k * D + c + 4); }
        b[0] = *(const f32x4*)(cb + c); b[1] = *(const f32x4*)(cb + c + 4);
        f32x4 h0[2], h1[2], h2[2];
        const bool first = (t0 & (SEQ - 1)) == 0;
        if (first) { h0[0] = h0[1] = h1[0] = h1[1] = h2[0] = h2[1] = (f32x4){0.f, 0.f, 0.f, 0.f}; }
        else { unpack8(*(const u32x4*)(XBR + (size_t)(t0 - 3) * D + c), h0[0], h0[1]); unpack8(*(const u32x4*)(XBR + (size_t)(t0 - 2) * D + c), h1[0], h1[1]); unpack8(*(const u32x4*)(XBR + (size_t)(t0 - 1) * D + c), h2[0], h2[1]); }
#pragma unroll 16
        for (int i = 0; i < 32; ++i) { f32x4 x[2]; unpack8(*(const GAS u32x4*)(XBR + (size_t)(t0 + i) * D + c), x[0], x[1]); f32x4 o[2];
#pragma unroll
            for (int q = 0; q < 2; ++q) { o[q] = b[q] + w[0][q] * h0[q] + w[1][q] * h1[q] + w[2][q] * h2[q] + w[3][q] * x[q]; h0[q] = h1[q]; h1[q] = h2[q]; h2[q] = x[q]; }
            *(u32x4*)(XC + (size_t)(t0 + i) * D + c) = pack8(o[0], o[1]); }
    }
}
__device__ __forceinline__ void scan_a_phase(LAS unsigned char* lds, const bf16* LOGA, const bf16* XN, float* AGG, float* CARRY, int bx, int G, int tid) {
    LAS float* sA = (LAS float*)lds; LAS float* sH = sA + 64 * 64;
    for (int item = bx; item < 256; item += G) {
        const int b = item >> 5, slab = (item >> 1) & 15, half = item & 1, seg = tid >> 3, cg = tid & 7, c = slab * 64 + cg * 8;
        const size_t row0 = (size_t)b * SEQ + half * 2048 + seg * 32;
        f32x4 A[2], H[2]; A[0] = A[1] = (f32x4){0.f, 0.f, 0.f, 0.f}; H[0] = H[1] = A[0];
#pragma unroll 8
        for (int i = 0; i < 32; ++i) { f32x4 la[2], xn[2]; unpack8(*(const GAS u32x4*)(LOGA + (row0 + i) * D + c), la[0], la[1]); unpack8(*(const GAS u32x4*)(XN + (row0 + i) * D + c), xn[0], xn[1]);
#pragma unroll
            for (int q = 0; q < 2; ++q) { A[q] += la[q];
#pragma unroll
                for (int j = 0; j < 4; ++j) H[q][j] = fexp(la[q][j]) * H[q][j] + xn[q][j]; } }
        __syncthreads();
#pragma unroll
        for (int q = 0; q < 2; ++q) { *(LAS f32x4*)(sA + seg * 64 + cg * 8 + 4 * q) = A[q]; *(LAS f32x4*)(sH + seg * 64 + cg * 8 + 4 * q) = H[q]; }
        __syncthreads();
        if (tid < 64) { float pl = 0.f, h = 0.f; float* cr = CARRY + (size_t)item * 64 * 128;
            for (int sgi = 0; sgi < 64; ++sgi) { cr[sgi * 128 + tid] = pl; cr[sgi * 128 + 64 + tid] = h; const float a = sA[sgi * 64 + tid]; h = fexp(a) * h + sH[sgi * 64 + tid]; pl += a; }
            AGG[item * 128 + tid] = pl; AGG[item * 128 + 64 + tid] = h; }
    }
}
__device__ __forceinline__ void scan_c_phase(const bf16* LOGA, const bf16* XN, const bf16* GATE, const float* AGG, const float* CARRY, bf16* YL, int bx, int G, int tid) {
    for (int item = bx; item < 256; item += G) {
        const int b = item >> 5, slab = (item >> 1) & 15, half = item & 1, seg = tid >> 3, cg = tid & 7, c = slab * 64 + cg * 8;
        const size_t row0 = (size_t)b * SEQ + half * 2048 + seg * 32;
        const float* cr = CARRY + (size_t)item * 64 * 128 + seg * 128 + cg * 8;
        f32x4 h[2];
#pragma unroll
        for (int q = 0; q < 2; ++q) { const f32x4 pl = *(const f32x4*)(cr + 4 * q), hl = *(const f32x4*)(cr + 64 + 4 * q);
            f32x4 hw = (f32x4){0.f, 0.f, 0.f, 0.f}; if (half) hw = *(const f32x4*)(AGG + (item - 1) * 128 + 64 + cg * 8 + 4 * q);
#pragma unroll
            for (int j = 0; j < 4; ++j) h[q][j] = hl[j] + fexp(pl[j]) * hw[j]; }
#pragma unroll 8
        for (int i = 0; i < 32; ++i) { f32x4 la[2], xn[2], g[2], y[2]; const size_t o = (row0 + i) * D + c;
            unpack8(*(const GAS u32x4*)(LOGA + o), la[0], la[1]); unpack8(*(const GAS u32x4*)(XN + o), xn[0], xn[1]); unpack8(*(const GAS u32x4*)(GATE + o), g[0], g[1]);
#pragma unroll
            for (int q = 0; q < 2; ++q)
#pragma unroll
                for (int j = 0; j < 4; ++j) { h[q][j] = fexp(la[q][j]) * h[q][j] + xn[q][j]; y[q][j] = h[q][j] * g[q][j]; }
            *(u32x4*)(YL + o) = pack8(y[0], y[1]); }
    }
}


__device__ __forceinline__ void gla_core_ref_phase(LAS unsigned char* lds, const bf16* Q, const bf16* Kb, const bf16* V, const bf16* SG, const float* AF, const float* hn, bf16* OG, int bx, int G, int tid) {
    LAS float* part = (LAS float*)lds;
    LAS float* red = part + 512;
    const int e = tid & 255, hf = tid >> 8, lane = tid & 63, w4 = (tid >> 6) & 3;
    for (int bh = bx; bh < 32; bh += G) {
        const int b = bh >> 2, h = bh & 3;
        float S[64];
#pragma unroll
        for (int d = 0; d < 64; ++d) S[d] = 0.f;
        const float hw = hn[e];
        for (int t = 0; t < SEQ; ++t) {
            const size_t row = (size_t)b * SEQ + t;
            const float v = bf2f(V[row * 1024 + h * 256 + e]);
            const float* a = AF + row * 512 + h * 128 + hf * 64; const bf16* k = Kb + row * 512 + h * 128 + hf * 64; const bf16* q = Q + row * 512 + h * 128 + hf * 64;
            float o = 0.f;
#pragma unroll
            for (int d = 0; d < 64; ++d) { S[d] = a[d] * S[d] + bf2f(k[d]) * v; o += bf2f(q[d]) * S[d]; }
            part[hf * 256 + e] = o;
            __syncthreads();
            o = (part[e] + part[256 + e]) * QSCALE;
            float ss = wave_sum(o * o);
            if (hf == 0 && lane == 0) red[w4] = ss;
            __syncthreads();
            ss = red[0] + red[1] + red[2] + red[3];
            const float rstd = rsqrtf(ss * (1.f / 256.f) + EPS);
            if (hf == 0) OG[row * 1024 + h * 256 + e] = f2bf(o * rstd * hw * bf2f(SG[row * 1024 + h * 256 + e]));
        }
        __syncthreads();
    }
}


typedef float f32x16 __attribute__((ext_vector_type(16)));
typedef short s16x4 __attribute__((ext_vector_type(4)));
typedef short v4i16_t __attribute__((ext_vector_type(4)));
typedef __bf16 bf16x2_t __attribute__((ext_vector_type(2)));
__device__ __forceinline__ unsigned cvtpk2(float lo, float hi) { f32x2 v = {lo, hi}; bf16x2_t b = __builtin_convertvector(v, bf16x2_t); return __builtin_bit_cast(unsigned, b); }
__device__ __forceinline__ s16x4 vtr(const LAS unsigned char* p) { return __builtin_bit_cast(s16x4, __builtin_amdgcn_ds_read_tr16_b64_v4i16((LAS v4i16_t*)p)); }
__device__ __forceinline__ bf16x8 tr_frag(const LAS unsigned char* a, int P) { const s16x4 lo = vtr(a), hi = vtr(a + 4 * P); return __builtin_shufflevector(lo, hi, 0, 1, 2, 3, 4, 5, 6, 7); }
__device__ __forceinline__ int crow(int r, int hh) { return (r & 3) + 8 * (r >> 2) + 4 * hh; }
#define MFMA32(a, b, c) __builtin_amdgcn_mfma_f32_32x32x16_bf16((a), (b), (c), 0, 0, 0)
#define CORE_BAR() asm volatile("s_waitcnt lgkmcnt(0)\n\ts_barrier" ::: "memory")

template <bool FULL>
__device__ __forceinline__ void gla_core_phase(LAS unsigned char* lds, const bf16* Q, const bf16* Kb, const bf16* V, const bf16* SG, const bf16* EQ, const bf16* EK,
                                               const float* EREF, const float* ELAST, const float* ELR, bf16* OG, float* USEG, int bx, int G, int wave) {
    constexpr int NSEG = 8, SEGC = 8;
    constexpr int TP = 272, VP = 80, PP = 144;
    constexpr int O_QP = 0, O_KP = 17408, O_QC = 34816, O_KST = 52224, O_V = 69632, O_P = 110592, O_PART = 119808, O_VEC = 121856;
    const int lane = lane_id_v(), tid = wave * 64 + lane, hh = lane >> 5, l31 = lane & 31;
    const int ptok = tid >> 3, pdp = tid & 7;
    LAS unsigned char* vsl = lds + O_V + wave * (64 * VP);
    const int troff = (8 * hh + ((lane & 15) >> 2)) * 1 ;
    const int trcol = 32 * ((lane >> 4) & 1) + 8 * (lane & 3);
    LAS float* part = (LAS float*)(lds + O_PART);
    for (int un = bx; un < 32 * NSEG; un += G) {
        const int bh = un & 31, seg = un >> 5, c0 = seg * SEGC, b = bh >> 2, h = bh & 3;
        if (!FULL && seg == NSEG - 1) continue;
        const size_t seq0 = (size_t)b * SEQ;
        f32x16 S[4];
#pragma unroll
        for (int dt = 0; dt < 4; ++dt)
#pragma unroll
            for (int r = 0; r < 16; ++r) S[dt][r] = 0.f;
        if (FULL) {
            for (int sg = 0; sg < seg; ++sg) {
                CORE_BAR();
                if (tid < 128) { float a = 1.f; const float* ep = ELAST + ((size_t)(b * 64 + sg * SEGC)) * 512 + h * 128 + tid;
#pragma unroll
                    for (int q = 0; q < SEGC; ++q) a *= *(const GAS float*)(ep + q * 512);
                    ((LAS float*)(lds + O_VEC))[256 + tid] = a; }
                CORE_BAR();
                const LAS float* el = (const LAS float*)(lds + O_VEC) + 256;
                const GAS float* up = (const GAS float*)USEG + (((size_t)(bh * NSEG + sg) * 8 + wave) * 64) * 64 + lane;
#pragma unroll
                for (int dt = 0; dt < 4; ++dt)
#pragma unroll
                    for (int g = 0; g < 4; ++g) { const f32x4 e4 = *(const LAS f32x4*)(el + 32 * dt + 8 * g + 4 * hh);
#pragma unroll
                        for (int j = 0; j < 4; ++j) S[dt][4 * g + j] = S[dt][4 * g + j] * e4[j] + up[(dt * 16 + 4 * g + j) * 64]; }
            }
            CORE_BAR();
        }
        u32x4 pq[2], pk[2], peq[2], pek[2], pv[4]; float ve[3] = {0.f, 0.f, 0.f};
#define CORE_LOAD(cc) do { const size_t rr = seq0 + (size_t)(cc) * 64; \
            { const size_t o = (rr + ptok) * 512 + h * 128 + pdp * 16; \
              if (FULL) { pq[0] = *(const GAS u32x4*)(Q + o); pq[1] = *(const GAS u32x4*)(Q + o + 8); peq[0] = *(const GAS u32x4*)(EQ + o); peq[1] = *(const GAS u32x4*)(EQ + o + 8); } pk[0] = *(const GAS u32x4*)(Kb + o); pk[1] = *(const GAS u32x4*)(Kb + o + 8); \
              pek[0] = *(const GAS u32x4*)(EK + o); pek[1] = *(const GAS u32x4*)(EK + o + 8); } \
            { const bf16* vp = V + (rr + lane) * 1024 + h * 256 + wave * 32; pv[0] = *(const GAS u32x4*)vp; pv[1] = *(const GAS u32x4*)(vp + 8); pv[2] = *(const GAS u32x4*)(vp + 16); pv[3] = *(const GAS u32x4*)(vp + 24); } \
            if (tid < 128) { const size_t vo = (rr >> 6) * 512 + h * 128 + tid; ve[0] = *(const GAS float*)(EREF + vo); ve[1] = *(const GAS float*)(ELR + vo); ve[2] = *(const GAS float*)(ELAST + vo); } } while (0)
#define CORE_VEC(par) do { if (tid < 128) { LAS float* vv = (LAS float*)(lds + O_VEC) + (par) * 384; vv[tid] = ve[0]; vv[128 + tid] = ve[1]; vv[256 + tid] = ve[2]; } } while (0)
#define CORE_PREP(par) do { const LAS float* vv = (const LAS float*)(lds + O_VEC) + (par) * 384 + pdp * 16; \
            _Pragma("unroll") for (int q2 = 0; q2 < 2; ++q2) { f32x4 q0, q1, e0, e1, k0, k1, g0, g1; if (FULL) { unpack8(pq[q2], q0, q1); unpack8(peq[q2], e0, e1); } unpack8(pk[q2], k0, k1); unpack8(pek[q2], g0, g1); \
                const f32x4 er0 = *(const LAS f32x4*)(vv + q2 * 8), er1 = *(const LAS f32x4*)(vv + q2 * 8 + 4), lr0 = *(const LAS f32x4*)(vv + 128 + q2 * 8), lr1 = *(const LAS f32x4*)(vv + 128 + q2 * 8 + 4); \
                k0 = k0 * g0; k1 = k1 * g1; \
                const int lo_ = ptok * TP + (pdp * 16 + q2 * 8) * 2; \
                if (FULL) { q0 = q0 * e0; q1 = q1 * e1; *(LAS u32x4*)(lds + O_QP + lo_) = pack8(q0, q1); *(LAS u32x4*)(lds + O_KP + lo_) = pack8(k0, k1); *(LAS u32x4*)(lds + O_QC + lo_) = pack8(q0 * er0, q1 * er1); } \
                *(LAS u32x4*)(lds + O_KST + lo_) = pack8(k0 * lr0, k1 * lr1); } \
            _Pragma("unroll") for (int i_ = 0; i_ < 4; ++i_) *(LAS u32x4*)(vsl + lane * VP + i_ * 16) = pv[i_]; } while (0)
        CORE_LOAD(c0); CORE_VEC(0);
        CORE_BAR();
        CORE_PREP(0);
        CORE_BAR();
        for (int c = c0; c < c0 + SEGC; ++c) {
            const int par = (c - c0) & 1; const size_t row0 = seq0 + (size_t)c * 64;
            u32x4 psg[4];
            if (FULL)
#pragma unroll
            for (int q = 0; q < 4; ++q) psg[q] = *(const GAS u32x4*)(SG + (row0 + 16 * q + (lane >> 2)) * 1024 + h * 256 + wave * 32 + 8 * (lane & 3));
            CORE_LOAD(c < c0 + SEGC - 1 ? c + 1 : c0 + SEGC - 1);
            if (FULL && wave < 3) { const int jt = wave == 2 ? 1 : 0, it = wave >= 1 ? 1 : 0; f32x16 p;
#pragma unroll
                for (int r = 0; r < 16; ++r) p[r] = 0.f;
#pragma unroll
                for (int ks = 0; ks < 8; ++ks) { const bf16x8 a = *(const LAS bf16x8*)(lds + O_KP + (32 * jt + l31) * TP + (16 * ks + 8 * hh) * 2), bq = *(const LAS bf16x8*)(lds + O_QP + (32 * it + l31) * TP + (16 * ks + 8 * hh) * 2);
                    p = MFMA32(a, bq, p); }
                if (jt == it) {
#pragma unroll
                    for (int r = 0; r < 16; ++r) p[r] = crow(r, hh) <= l31 ? p[r] : 0.f; }
#pragma unroll
                for (int g = 0; g < 4; ++g) { u32x2 w; w.x = cvtpk2(p[4 * g], p[4 * g + 1]); w.y = cvtpk2(p[4 * g + 2], p[4 * g + 3]);
                    *(LAS u32x2*)(lds + O_P + (32 * it + l31) * PP + (32 * jt + 8 * g + 4 * hh) * 2) = w; }
            }
            f32x16 o[2];
#pragma unroll
            for (int it = 0; it < 2; ++it)
#pragma unroll
                for (int r = 0; r < 16; ++r) o[it][r] = 0.f;
            if (FULL)
#pragma unroll
            for (int ks = 0; ks < 8; ++ks) { const int dt = ks >> 1, s2 = ks & 1; u32x4 ap;
                ap.x = cvtpk2(S[dt][8 * s2 + 0], S[dt][8 * s2 + 1]); ap.y = cvtpk2(S[dt][8 * s2 + 2], S[dt][8 * s2 + 3]); ap.z = cvtpk2(S[dt][8 * s2 + 4], S[dt][8 * s2 + 5]); ap.w = cvtpk2(S[dt][8 * s2 + 6], S[dt][8 * s2 + 7]);
                const bf16x8 a = __builtin_bit_cast(bf16x8, ap);
#pragma unroll
                for (int it = 0; it < 2; ++it) { const LAS unsigned char* qa = lds + O_QC + (32 * it + l31) * TP + (32 * dt + 16 * s2 + 4 * hh) * 2;
                    const s16x4 lo = *(const LAS s16x4*)qa, hi = *(const LAS s16x4*)(qa + 16);
                    o[it] = MFMA32(a, __builtin_shufflevector(lo, hi, 0, 1, 2, 3, 4, 5, 6, 7), o[it]); } }
            if (FULL) CORE_BAR();
            bf16x8 vf[4];
#pragma unroll
            for (int s4 = 0; s4 < 4; ++s4) vf[s4] = tr_frag(vsl + (16 * s4 + troff) * VP + trcol, VP);
            if (FULL)
#pragma unroll
            for (int it = 0; it < 2; ++it)
#pragma unroll
                for (int s4 = 0; s4 < 4; ++s4) { if (it == 0 && s4 >= 2) continue;
                    const bf16x8 pb = *(const LAS bf16x8*)(lds + O_P + (32 * it + l31) * PP + (16 * s4 + 8 * hh) * 2);
                    o[it] = MFMA32(vf[s4], pb, o[it]); }
            if (FULL)
#pragma unroll
            for (int it = 0; it < 2; ++it) { float ss = 0.f;
#pragma unroll
                for (int r = 0; r < 16; ++r) ss += o[it][r] * o[it][r];
                ss += __shfl_xor(ss, 32);
                if (hh == 0) part[wave * 64 + 32 * it + l31] = ss; }
            { const LAS float* el = (const LAS float*)(lds + O_VEC) + par * 384 + 256;
#pragma unroll
              for (int dt = 0; dt < 4; ++dt)
#pragma unroll
                for (int g = 0; g < 4; ++g) { const f32x4 e4 = *(const LAS f32x4*)(el + 32 * dt + 8 * g + 4 * hh);
#pragma unroll
                    for (int j = 0; j < 4; ++j) S[dt][4 * g + j] *= e4[j]; }
#pragma unroll
              for (int dt = 0; dt < 4; ++dt)
#pragma unroll
                for (int s4 = 0; s4 < 4; ++s4) S[dt] = MFMA32(tr_frag(lds + O_KST + (16 * s4 + troff) * TP + 64 * dt + trcol, TP), vf[s4], S[dt]); }
            CORE_VEC(par ^ 1);
            CORE_BAR();
            if (FULL) {
#pragma unroll
                for (int it = 0; it < 2; ++it) { float tot = 0.f;
#pragma unroll
                    for (int w8 = 0; w8 < 8; ++w8) tot += part[w8 * 64 + 32 * it + l31];
                    const float rstd = rsqrtf(tot * (1.f / 256.f) + EPS);
#pragma unroll
                    for (int g = 0; g < 4; ++g) { u32x2 w; w.x = cvtpk2(o[it][4 * g] * rstd, o[it][4 * g + 1] * rstd); w.y = cvtpk2(o[it][4 * g + 2] * rstd, o[it][4 * g + 3] * rstd);
                        *(LAS u32x2*)(vsl + (32 * it + l31) * VP + (8 * g + 4 * hh) * 2) = w; } }
                asm volatile("s_waitcnt lgkmcnt(0)" ::: "memory");
#pragma unroll
                for (int q = 0; q < 4; ++q) { const int rw = 16 * q + (lane >> 2); f32x4 a0, a1, g0, g1;
                    unpack8(*(const LAS u32x4*)(vsl + rw * VP + 16 * (lane & 3)), a0, a1); unpack8(psg[q], g0, g1);
                    *(GAS u32x4*)(OG + (row0 + rw) * 1024 + h * 256 + wave * 32 + 8 * (lane & 3)) = pack8(a0 * g0, a1 * g1); }
            }
            CORE_PREP(par ^ 1);
            CORE_BAR();
        }
        if (!FULL) { GAS float* up = (GAS float*)USEG + (((size_t)(bh * NSEG + seg) * 8 + wave) * 64) * 64 + lane;
#pragma unroll
            for (int dt = 0; dt < 4; ++dt)
#pragma unroll
                for (int r = 0; r < 16; ++r) up[(dt * 16 + r) * 64] = S[dt][r]; }
#undef CORE_LOAD
#undef CORE_VEC
#undef CORE_PREP
    }
}

struct MArgs { const float* in[24]; float* out; unsigned char* ws; int ph_lo, ph_hi, li, pad; };

#define CVT_ITEMS(IT_LO, IT_HI, GW_, NGW_) do { \
        LAS float* scr = (LAS float*)(lds + wave * 16384); \
        constexpr int I_A = 1536, I_B = 256, I_C = 512, I_D = 1024, I_E = 512, I_F = 256, I_G = 16384; \
        for (int it = (IT_LO) + (GW_); it < (IT_HI); it += (NGW_)) { \
            int r = it; \
            if (r < I_A) { cvt_item(in[2], 3088, 0, in[1], W1, 1024, 0, r / 96, r % 96, scr, lane); continue; } r -= I_A; \
            if (r < I_B) { cvt_item_la(in[2], in[3], in[1], W1, r / 16, r % 16, scr, lane); continue; } r -= I_B; \
            if (r < I_C) { cvt_item(in[6], 1024, 0, in[5], WO, 1024, 0, r / 32, r % 32, scr, lane, 255); continue; } r -= I_C; \
            if (r < I_D) { cvt_item(in[8], 2048, 0, in[7], WLI, 1024, 0, r / 64, r % 64, scr, lane); continue; } r -= I_D; \
            if (r < I_E) { cvt_item(in[16], 1024, 0, nullptr, WLO, 1024, 0, r / 32, r % 32, scr, lane); continue; } r -= I_E; \
            if (r < I_F) { const int seg = r / 16, q = r % 16, nb4 = seg >> 2, half = (seg >> 1) & 1, pn = seg & 1; \
                cvt_item((half ? in[13] : in[11]) + (size_t)nb4 * 65536, 256, pn * 128, nullptr, WG + (size_t)nb4 * 512 * 256, 256, pn * 256 + half * 128, q / 4, q % 4, scr, lane); continue; } r -= I_F; \
            if (r < I_G) { const int seg = r / 64, q = r % 64, le = seg >> 2, half = (seg >> 1) & 1, pn = seg & 1; \
                cvt_item((half ? in[21] : in[20]) + (size_t)le * 1024 * 256, 256, pn * 128, in[17] + (le >> 5) * D, WGU + (size_t)le * 512 * 1024, 1024, pn * 256 + half * 128, q / 4, q % 4, scr, lane); continue; } r -= I_G; \
            { const int le = r / 128, q = r % 128; cvt_item(in[22] + (size_t)le * 256 * 1024, 1024, 0, nullptr, WD + (size_t)le * 1024 * 256, 256, 0, q / 32, q % 32, scr, lane); } \
        } } while (0)
constexpr int CVT_W1_ITEMS = 1536 + 256, CVT_ALL_ITEMS = 1536 + 256 + 512 + 1024 + 512 + 256 + 16384 + 8192;
__global__ void __launch_bounds__(NTHR, 2) mega(MArgs args) {
    extern __shared__ __attribute__((aligned(16))) unsigned char lds_raw[];
    LAS unsigned char* lds = (LAS unsigned char*)lds_raw;
    volatile LAS unsigned* MISC = (volatile LAS unsigned*)(lds + LDS_MISC);
    const int wave = __builtin_amdgcn_readfirstlane((int)(threadIdx.x >> 6));
    const int G = gridDim.x, bx = blockIdx.x;
    unsigned char* ws = args.ws;
    unsigned* ctl = (unsigned*)(ws + WS_CTL);
    { const int tid0 = wave * 64 + lane_id_v();
      for (int u = tid0; u < (LDS_BYTES - LDS_MISC) / 4; u += NTHR) ((LAS unsigned*)(lds + LDS_MISC))[u] = 0u;
      __syncthreads(); }
    XcdBarrier bar = xcd_barrier_post(ctl + CW_BAR + args.li * XCD_BAR_WORDS, MISC + 8, wave == 0 && lane_id_v() == 0);
#define TIDLANE const int lane = lane_id_v(), tid = wave * 64 + lane; (void)tid; (void)lane;
    const int lo = args.ph_lo, hi = args.ph_hi;
#define IN(k) (lo <= (k) && (k) < hi)
#define BOTH(k) (IN(k) && IN((k) + 1))
    const float* const* in = args.in;
#define PH_PTRS unsigned char* wsp = args.ws; asm volatile("" : "+s"(wsp)); \
    float *RS0 = (float*)(wsp + WS_RS0), *RS1 = (float*)(wsp + WS_RS1), *RS2 = (float*)(wsp + WS_RS2), *RS3 = (float*)(wsp + WS_RS3); \
    float *EREF = (float*)(wsp + WS_EREF), *ELAST = (float*)(wsp + WS_ELAST), *ELR = (float*)(wsp + WS_ELR); \
    bf16 *S0 = (bf16*)(wsp + WS_S0), *S1 = (bf16*)(wsp + WS_S1), *S2 = (bf16*)(wsp + WS_S2), *S3 = (bf16*)(wsp + WS_S3), *S4 = (bf16*)(wsp + WS_S4), *S5 = (bf16*)(wsp + WS_S5); \
    bf16 *W1 = (bf16*)(wsp + WS_W1), *WO = (bf16*)(wsp + WS_WO), *WLI = (bf16*)(wsp + WS_WLI), *WLO = (bf16*)(wsp + WS_WLO), *WG = (bf16*)(wsp + WS_WG), *WGU = (bf16*)(wsp + WS_WGU), *WD = (bf16*)(wsp + WS_WD); \
    int* LIST = (int*)(wsp + WS_LIST); float* LW = (float*)(wsp + WS_LW); int* POS = (int*)(wsp + WS_POS); const bf16* WR = (const bf16*)(wsp + WS_WR); unsigned* ctlp = (unsigned*)(wsp + WS_CTL); \
    (void)RS0; (void)RS1; (void)RS2; (void)RS3; (void)EREF; (void)ELAST; (void)ELR; (void)S0; (void)S1; (void)S2; (void)S3; (void)S4; (void)S5; \
    (void)W1; (void)WO; (void)WLI; (void)WLO; (void)WG; (void)WGU; (void)WD; (void)LIST; (void)LW; (void)POS; (void)WR; (void)ctlp;

    if (IN(0)) { PH_PTRS TIDLANE
        const int gw = bx * NWAVES + wave, NGW = G * NWAVES;
        bf16* XB = S0;
        for (int row = gw; row < T; row += 2 * NGW) {
            const int row2 = row + NGW < T ? row + NGW : row;
            const GAS f32x4* xr = (const GAS f32x4*)(in[0] + (size_t)row * D) + lane; const GAS f32x4* xr2 = (const GAS f32x4*)(in[0] + (size_t)row2 * D) + lane; f32x4 v[4], v2[4]; float s = 0.f, s2 = 0.f;
#pragma unroll
            for (int j = 0; j < 4; ++j) { v[j] = xr[64 * j]; v2[j] = xr2[64 * j]; }
#pragma unroll
            for (int j = 0; j < 4; ++j) { s += (v[j].x * v[j].x + v[j].y * v[j].y) + (v[j].z * v[j].z + v[j].w * v[j].w); s2 += (v2[j].x * v2[j].x + v2[j].y * v2[j].y) + (v2[j].z * v2[j].z + v2[j].w * v2[j].w); }
            s = wave_sum(s); s2 = wave_sum(s2);
            GAS u32x2* o8 = (GAS u32x2*)(XB + (size_t)row * D) + lane; GAS u32x2* o82 = (GAS u32x2*)(XB + (size_t)row2 * D) + lane;
#pragma unroll
            for (int j = 0; j < 4; ++j) { u32x2 w; w.x = cvt_pk_bf16(v[j].x, v[j].y); w.y = cvt_pk_bf16(v[j].z, v[j].w); o8[64 * j] = w; u32x2 w2; w2.x = cvt_pk_bf16(v2[j].x, v2[j].y); w2.y = cvt_pk_bf16(v2[j].z, v2[j].w); o82[64 * j] = w2; }
            if (lane == 0) { RS0[row] = rsqrtf(s * (1.f / D) + EPS); RS0[row2] = rsqrtf(s2 * (1.f / D) + EPS); }
        }
        CVT_ITEMS(0, CVT_ALL_ITEMS, gw, NGW);
        float* SP = (float*)(wsp + WS_SP); bf16* WRw = (bf16*)(wsp + WS_WR);
        for (int i = bx * NTHR + tid; i < 1024; i += G * NTHR) { const float l = -in[15][i]; SP[i] = fmaxf(l, 0.f) + log1pf(__expf(-fabsf(l))); }
        for (int i = bx * NTHR + tid; i < 2 * 48 * 1024; i += G * NTHR) { const int l = i / (48 * 1024), n = (i / 1024) % 48, k = i % 1024; float v = 0.f;
            if (n < 4) v = in[18][(size_t)l * D * 4 + k * 4 + n]; else if (n < 36) v = in[19][(size_t)l * D * 32 + k * 32 + n - 4];
            WRw[i] = f2bf(v * in[17][l * D + k]); }
        if (BOTH(0)) xcd_barrier(bar, wave);
    }
    if (IN(1)) { PH_PTRS
        pg8::SchedDense S{128, 14, G, bx, (const char*)S0, (const char*)W1, (size_t)256 * 1024 * 2, (size_t)256 * 1024 * 2, 1, 0};
        EpiG1 E{S1, S1 + (size_t)T * 512, S2, S3, S4, S4 + (size_t)T * 512, EREF, ELAST, ELR, nullptr, RS0, in[4]};
        pg8::gemm_phase<EpiG1, pg8::SchedDense, false>(lds, 1024, 1024, 1024, S, E, wave);
        if (BOTH(1)) xcd_barrier(bar, wave);
    }
    if (IN(2)) { PH_PTRS
        gla_core_phase<false>(lds, S1, S1 + (size_t)T * 512, S2, S3, S4, S4 + (size_t)T * 512, EREF, ELAST, ELR, S0, (float*)S5, bx, G, wave);
        xcd_barrier(bar, wave);
        gla_core_phase<true>(lds, S1, S1 + (size_t)T * 512, S2, S3, S4, S4 + (size_t)T * 512, EREF, ELAST, ELR, S0, (float*)S5, bx, G, wave);
        if (BOTH(2)) xcd_barrier(bar, wave);
    }
    if (IN(3)) { PH_PTRS
        pg8::SchedDense S{128, 4, G, bx, (const char*)S0, (const char*)WO, (size_t)256 * 1024 * 2, (size_t)256 * 1024 * 2, 1, 0};
        EpiResidF E{in[0], nullptr, S1};
        pg8::gemm_phase<EpiResidF, pg8::SchedDense, false>(lds, 1024, 1024, 1024, S, E, wave);
        if (BOTH(3)) xcd_barrier(bar, wave);
    }

    LAS int* ts = (LAS int*)(lds + LDS_MISC + TS_OFF);
#define MOE_PHASES(P, LAYER, XIN, RSX, ACTB, YB, XOUT, RSOUT, FW, OUTP) \
    if (IN(P)) { PH_PTRS TIDLANE router_phase(lds, XIN, WR + (size_t)(LAYER) * 48 * 1024, RSX, ctlp + CW_CNT + 64 * (LAYER), LIST, LW, POS, bx, G, tid, lane, wave); if (BOTH(P)) xcd_barrier(bar, wave); } \
    if (IN(P + 1)) { PH_PTRS TIDLANE build_ts(ctlp + CW_CNT + 64 * (LAYER), ts, tid); \
        pg8::SchedMoe S{ts, G, bx, 2, (const char*)(XIN), (const char*)(WGU + (size_t)(LAYER) * 32 * 512 * 1024), LIST, (size_t)512 * 1024 * 2, (size_t)256 * 1024 * 2, 0, true}; \
        EpiM1 E{ACTB, LIST, LW, RSX}; \
        pg8::gemm_phase<EpiM1, pg8::SchedMoe, true>(lds, 1024, 1024, 1024, S, E, wave); if (BOTH(P + 1)) xcd_barrier(bar, wave); } \
    if (IN(P + 2)) { PH_PTRS TIDLANE build_ts(ctlp + CW_CNT + 64 * (LAYER), ts, tid); \
        pg8::SchedMoe S{ts, G, bx, 4, (const char*)(ACTB), (const char*)(WD + (size_t)(LAYER) * 32 * 1024 * 256), LIST, (size_t)1024 * 256 * 2, (size_t)256 * 256 * 2, (size_t)256 * 256 * 2, false}; \
        EpiStore E{YB, 1024, 0}; \
        pg8::gemm_phase<EpiStore, pg8::SchedMoe, false>(lds, 256, 256, 256, S, E, wave); if (BOTH(P + 2)) xcd_barrier(bar, wave); } \
    if (IN(P + 3)) { PH_PTRS TIDLANE build_ts(ctlp + CW_CNT + 64 * (LAYER), ts, tid); \
        combine_phase(ts, XIN, YB, POS, XOUT, RSOUT, FW, OUTP, bx, G, lane, wave); if (BOTH(P + 3)) xcd_barrier(bar, wave); }

    MOE_PHASES(4, 0, S1, RS1, S2, S3, S0, RS2, nullptr, nullptr)
    if (IN(8)) { PH_PTRS
        pg8::SchedDense S{128, 8, G, bx, (const char*)S0, (const char*)WLI, (size_t)256 * 1024 * 2, (size_t)256 * 1024 * 2, 1, 0};
        EpiL1 E{S1, S2, RS2};
        pg8::gemm_phase<EpiL1, pg8::SchedDense, false>(lds, 1024, 1024, 1024, S, E, wave);
        if (BOTH(8)) xcd_barrier(bar, wave);
    }
    if (IN(9)) { PH_PTRS TIDLANE conv_phase(S1, in[9], in[10], S3, bx, G, tid); if (BOTH(9)) xcd_barrier(bar, wave); }
    if (IN(10)) { PH_PTRS
        pg8::SchedDense S{128, 8, G, bx, (const char*)S3, (const char*)WG, (size_t)256 * 1024 * 2, (size_t)256 * 256 * 2, 2, (size_t)512};
        EpiL2 E{S3, S4, S5, in[12], in[14], (const float*)(wsp + WS_SP)};
        pg8::gemm_phase<EpiL2, pg8::SchedDense, false>(lds, 1024, 256, 256, S, E, wave);
        if (BOTH(10)) xcd_barrier(bar, wave);
    }
    if (IN(11)) { PH_PTRS TIDLANE scan_a_phase(lds, S4, S5, (float*)(wsp + WS_AGG), (float*)(wsp + WS_CARRY), bx, G, tid); if (BOTH(11)) xcd_barrier(bar, wave); }
    if (IN(12)) { PH_PTRS TIDLANE scan_c_phase(S4, S5, S2, (const float*)(wsp + WS_AGG), (const float*)(wsp + WS_CARRY), S1, bx, G, tid); if (BOTH(12)) xcd_barrier(bar, wave); }
    if (IN(13)) { PH_PTRS
        pg8::SchedDense S{128, 4, G, bx, (const char*)S1, (const char*)WLO, (size_t)256 * 1024 * 2, (size_t)256 * 1024 * 2, 1, 0};
        EpiResidF E{nullptr, S0, S5};
        pg8::gemm_phase<EpiResidF, pg8::SchedDense, false>(lds, 1024, 1024, 1024, S, E, wave);
        if (BOTH(13)) xcd_barrier(bar, wave);
    }
    MOE_PHASES(14, 1, S5, RS3, S3, S0, (bf16*)nullptr, (float*)nullptr, in[23], args.out)
#undef MOE_PHASES
#undef PH_PTRS
#undef TIDLANE
#undef CVT_ITEMS
#undef IN
#undef BOTH
}

static int mega_grid() {
    static int grid = 0;
    if (grid == 0) {
        int dev = 0, cus = 0;
        if (hipGetDevice(&dev) != hipSuccess || hipDeviceGetAttribute(&cus, hipDeviceAttributeMultiprocessorCount, dev) != hipSuccess) { grid = -1; return grid; }
        if (hipFuncSetAttribute((const void*)mega, hipFuncAttributeMaxDynamicSharedMemorySize, LDS_BYTES) != hipSuccess) { fprintf(stderr, "hipFuncSetAttribute failed\n"); grid = -1; return grid; }
        int per_cu = 0;
        if (hipOccupancyMaxActiveBlocksPerMultiprocessor(&per_cu, (const void*)mega, NTHR, LDS_BYTES) != hipSuccess || per_cu < 1) { fprintf(stderr, "occupancy query: %d\n", per_cu); (void)hipGetLastError(); }
        grid = cus;
    }
    return grid;
}
static void launch_mega(const MArgs& base, int lo, int hi, int li, hipStream_t stream) {
    MArgs a = base; a.ph_lo = lo; a.ph_hi = hi; a.li = li; a.pad = 0;
    hipLaunchKernelGGL(mega, dim3(mega_grid()), dim3(NTHR), LDS_BYTES, stream, a);
}
extern "C" void kernel_launch(void* const* d_in, const int* in_sizes, int n_in, void* d_out, int out_size, void* d_ws, size_t ws_size, hipStream_t stream) {
    if (n_in != 24 || out_size != T * D || ws_size < WS_END) { fprintf(stderr, "kernel_launch: unexpected shapes (n_in %d out %d ws %zu)\n", n_in, out_size, ws_size); return; }
    if (mega_grid() <= 0) return;
    const float* const* in = (const float* const*)d_in; unsigned char* ws = (unsigned char*)d_ws;
    (void)hipMemsetAsync(ws + WS_CTL, 0, 1 * MiB, stream);
    MArgs base{}; for (int i = 0; i < 24; ++i) base.in[i] = in[i]; base.out = (float*)d_out; base.ws = ws;
    launch_mega(base, 0, 18, 0, stream);
}
```

```cpp
#include <hip/hip_runtime.h>
#include <cstdio>
#include <cstdint>

typedef unsigned short bf16;
constexpr int T = 32768, D = 1024, SEQ = 4096, NB = 8;
constexpr float EPS = 1e-6f;
constexpr size_t MiB = 1u << 20;
constexpr size_t WS_CTL = 0;
constexpr size_t WS_RS0 = 1 * MiB, WS_RS1 = WS_RS0 + 128 * 1024, WS_RS2 = WS_RS1 + 128 * 1024, WS_RS3 = WS_RS2 + 128 * 1024;
constexpr size_t WS_EREF = 2 * MiB, WS_ELAST = 3 * MiB, WS_ELR = 4 * MiB;
constexpr size_t WS_S0 = 128 * MiB, WS_S1 = 192 * MiB, WS_S2 = 256 * MiB, WS_S3 = 320 * MiB, WS_S4 = 384 * MiB, WS_S5 = 448 * MiB, WS_END = 512 * MiB;

__device__ __forceinline__ float bf2f(bf16 b) { return __uint_as_float(((unsigned)b) << 16); }
__device__ __forceinline__ bf16 f2bf(float f) { unsigned u = __float_as_uint(f); u += 0x7fffu + ((u >> 16) & 1u); return (bf16)(u >> 16); }
__device__ __forceinline__ float wave_sum(float v) {
#pragma unroll
    for (int o = 1; o < 64; o <<= 1) v += __shfl_xor(v, o);
    return v;
}
__device__ __forceinline__ float sigmoidf_(float x) { return 1.f / (1.f + __expf(-x)); }
__device__ __forceinline__ float siluf_(float x) { return x / (1.f + __expf(-x)); }
__device__ __forceinline__ float logsigmoidf_(float x) { return fminf(x, 0.f) - log1pf(__expf(-fabsf(x))); }
__device__ __forceinline__ float softplusf_(float x) { return fmaxf(x, 0.f) + log1pf(__expf(-fabsf(x))); }
__device__ __forceinline__ float gelu_tanhf_(float x) { const float u = 0.7978845608028654f * (x + 0.044715f * x * x * x); return 0.5f * x * (1.f + tanhf(u)); }

__global__ void __launch_bounds__(256) n_prologue(const float* x, bf16* XB, float* RS) {
    const int row = blockIdx.x * 4 + (threadIdx.x >> 6), lane = threadIdx.x & 63;
    const float* xr = x + (size_t)row * D; float s = 0.f;
    for (int i = lane; i < D; i += 64) { const float v = xr[i]; s += v * v; XB[(size_t)row * D + i] = f2bf(v); }
    s = wave_sum(s);
    if (lane == 0) RS[row] = rsqrtf(s * (1.f / D) + EPS);
}

template <class Epi>
__global__ void __launch_bounds__(256) n_gemm(const bf16* A, int lda, const float* rs, const float* nw, const float* W, int ldw, int M, int N, int K, Epi epi) {
    __shared__ float As[16][65], Ws[16][64];
    const int tid = threadIdx.x, tx = tid & 15, ty = tid >> 4, m0 = blockIdx.y * 64, n0 = blockIdx.x * 64;
    float acc[4][4];
#pragma unroll
    for (int i = 0; i < 4; ++i)
#pragma unroll
        for (int j = 0; j < 4; ++j) acc[i][j] = 0.f;
    for (int k0 = 0; k0 < K; k0 += 16) {
#pragma unroll
        for (int i = 0; i < 4; ++i) { const int idx = tid + 256 * i, r = idx >> 4, kk = idx & 15; As[kk][r] = bf2f(A[(size_t)(m0 + r) * lda + k0 + kk]) * (nw ? nw[k0 + kk] : 1.f); }
#pragma unroll
        for (int i = 0; i < 4; ++i) { const int idx = tid + 256 * i, kk = idx >> 6, n = idx & 63; Ws[kk][n] = (n0 + n < N) ? W[(size_t)(k0 + kk) * ldw + n0 + n] : 0.f; }
        __syncthreads();
#pragma unroll
        for (int kk = 0; kk < 16; ++kk) {
            float a[4], b[4];
#pragma unroll
            for (int i = 0; i < 4; ++i) a[i] = As[kk][ty * 4 + i];
#pragma unroll
            for (int j = 0; j < 4; ++j) b[j] = Ws[kk][tx + 16 * j];
#pragma unroll
            for (int i = 0; i < 4; ++i)
#pragma unroll
                for (int j = 0; j < 4; ++j) acc[i][j] += a[i] * b[j];
        }
        __syncthreads();
    }
#pragma unroll
    for (int i = 0; i < 4; ++i) { const int r = m0 + ty * 4 + i; const float sc = rs ? rs[r] : 1.f;
#pragma unroll
        for (int j = 0; j < 4; ++j) { const int c = n0 + tx + 16 * j; if (c < N) epi(r, c, acc[i][j] * sc); } }
}
struct EpiGlaProj { bf16 *Q, *Kb, *V, *SG; float* LR;
    __device__ void operator()(int r, int c, float v) const {
        if (c < 512) Q[(size_t)r * 512 + c] = f2bf(v);
        else if (c < 1024) Kb[(size_t)r * 512 + c - 512] = f2bf(v);
        else if (c < 2048) V[(size_t)r * 1024 + c - 1024] = f2bf(v);
        else if (c < 3072) SG[(size_t)r * 1024 + c - 2048] = f2bf(siluf_(v));
        else LR[(size_t)r * 16 + c - 3072] = v; } };
struct EpiResid { const float* xf; const bf16* xb; bf16* out;
    __device__ void operator()(int r, int c, float v) const { const size_t i = (size_t)r * D + c; out[i] = f2bf((xf ? xf[i] : bf2f(xb[i])) + v); } };
struct EpiLruIn { bf16 *XBR, *GATE;
    __device__ void operator()(int r, int c, float v) const { if (c < 1024) XBR[(size_t)r * D + c] = f2bf(v); else GATE[(size_t)r * D + c - 1024] = f2bf(gelu_tanhf_(v)); } };
struct EpiGate { bf16* O; const float* bias; int coff; int pad;
    __device__ void operator()(int r, int c, float v) const { O[(size_t)r * D + coff + c] = f2bf(sigmoidf_(v + bias[coff + c])); } };

__global__ void __launch_bounds__(256) n_gla_prep(const float* LR, const float* w_alpha, const float* b_alpha, bf16* EQ, bf16* EK, float* EREF, float* ELAST, float* ELR, float* AF) {
    const int gi = blockIdx.x * 256 + threadIdx.x, chunk = gi >> 9, col = gi & 511;
    float wa[16];
#pragma unroll
    for (int r = 0; r < 16; ++r) wa[r] = w_alpha[r * 512 + col];
    const float ba = b_alpha[col];
    float cum = 0.f, ref = 0.f;
    for (int i = 0; i < 64; ++i) { const float* lr = LR + (size_t)(chunk * 64 + i) * 16; float z = ba;
#pragma unroll
        for (int r = 0; r < 16; ++r) z += lr[r] * wa[r];
        const float la = logsigmoidf_(z) * (1.f / 16.f); cum += la; if (i == 32) ref = cum; AF[(size_t)(chunk * 64 + i) * 512 + col] = __expf(la); }
    const float last = cum;
    EREF[chunk * 512 + col] = __expf(ref); ELAST[chunk * 512 + col] = __expf(last); ELR[chunk * 512 + col] = __expf(last - ref);
    cum = 0.f;
    for (int i = 0; i < 64; ++i) { const float* lr = LR + (size_t)(chunk * 64 + i) * 16; float z = ba;
#pragma unroll
        for (int r = 0; r < 16; ++r) z += lr[r] * wa[r];
        cum += logsigmoidf_(z) * (1.f / 16.f);
        const size_t o = (size_t)(chunk * 64 + i) * 512 + col;
        EQ[o] = f2bf(0.08838834764831845f * __expf(cum - ref)); EK[o] = f2bf(__expf(ref - cum)); }
}
__global__ void __launch_bounds__(256) n_gla_core(const bf16* Q, const bf16* Kb, const bf16* V, const bf16* SG, const float* AF, const float* hn, bf16* OG) {
    __shared__ float red[4];
    const int bh = blockIdx.x, b = bh >> 2, h = bh & 3, e = threadIdx.x, lane = e & 63, w = e >> 6;
    float S[128];
#pragma unroll
    for (int d = 0; d < 128; ++d) S[d] = 0.f;
    const float hw = hn[e];
    for (int t = 0; t < SEQ; ++t) {
        const size_t row = (size_t)b * SEQ + t;
        const float v = bf2f(V[row * 1024 + h * 256 + e]);
        const float* a = AF + row * 512 + h * 128; const bf16* k = Kb + row * 512 + h * 128; const bf16* q = Q + row * 512 + h * 128;
        float o = 0.f;
#pragma unroll
        for (int d = 0; d < 128; ++d) { S[d] = a[d] * S[d] + bf2f(k[d]) * v; o += bf2f(q[d]) * S[d]; }
        o *= 0.08838834764831845f;
        float ss = wave_sum(o * o);
        __syncthreads();
        if (lane == 0) red[w] = ss;
        __syncthreads();
        ss = red[0] + red[1] + red[2] + red[3];
        const float rstd = rsqrtf(ss * (1.f / 256.f) + EPS);
        OG[row * 1024 + h * 256 + e] = f2bf(o * rstd * hw * bf2f(SG[row * 1024 + h * 256 + e]));
    }
}
__global__ void __launch_bounds__(256) n_moe(const bf16* Xin, const float* nw, const float* wg, const float* we, const float* Wgate, const float* Wup, const float* Wdown,
                                             bf16* Xout, float* RSout, const float* final_w, float* out) {
    __shared__ float hs[1024], logit[36], act[256], red[4]; __shared__ int sel[2]; __shared__ float selw[2];
    const int t = blockIdx.x, tid = threadIdx.x, lane = tid & 63, w = tid >> 6;
    float xv[4]; float s = 0.f;
#pragma unroll
    for (int i = 0; i < 4; ++i) { xv[i] = bf2f(Xin[(size_t)t * D + tid + 256 * i]); s += xv[i] * xv[i]; }
    s = wave_sum(s); if (lane == 0) red[w] = s; __syncthreads();
    const float rstd = rsqrtf((red[0] + red[1] + red[2] + red[3]) * (1.f / D) + EPS);
#pragma unroll
    for (int i = 0; i < 4; ++i) hs[tid + 256 * i] = xv[i] * rstd * nw[tid + 256 * i];
    __syncthreads();
    for (int li = w * 9; li < w * 9 + 9; ++li) { float p = 0.f;
        for (int k = lane; k < D; k += 64) p += hs[k] * (li < 4 ? wg[k * 4 + li] : we[k * 32 + li - 4]);
        p = wave_sum(p); if (lane == 0) logit[li] = p; }
    __syncthreads();
    if (tid == 0) {
        int g = 0; float gm = logit[0];
        for (int i = 1; i < 4; ++i) if (logit[i] > gm) { gm = logit[i]; g = i; }
        float gs = 0.f; for (int i = 0; i < 4; ++i) gs += __expf(logit[i] - gm);
        const float pg = 1.f / gs;
        const float* el = logit + 4 + g * 8; int e0 = 0; float m0 = el[0];
        for (int i = 1; i < 8; ++i) if (el[i] > m0) { m0 = el[i]; e0 = i; }
        int e1 = -1; float m1 = -3.0e38f;
        for (int i = 0; i < 8; ++i) if (i != e0 && el[i] > m1) { m1 = el[i]; e1 = i; }
        const float p1 = __expf(m1 - m0), den = 1.f + p1;
        sel[0] = g * 8 + e0; sel[1] = g * 8 + e1; selw[0] = pg / den; selw[1] = pg * p1 / den;
    }
    __syncthreads();
    float oacc[4] = {0.f, 0.f, 0.f, 0.f};
    for (int kk = 0; kk < 2; ++kk) {
        const int e = sel[kk]; const float wt = selw[kk];
        const float* G = Wgate + (size_t)e * D * 256; const float* U = Wup + (size_t)e * D * 256; const float* Dn = Wdown + (size_t)e * 256 * D;
        float ga = 0.f, ua = 0.f;
        for (int k = 0; k < D; ++k) { const float hv = hs[k]; ga += hv * G[k * 256 + tid]; ua += hv * U[k * 256 + tid]; }
        __syncthreads();
        act[tid] = siluf_(ga) * ua;
        __syncthreads();
        float o4[4] = {0.f, 0.f, 0.f, 0.f};
        for (int f = 0; f < 256; ++f) { const float av = act[f];
#pragma unroll
            for (int i = 0; i < 4; ++i) o4[i] += av * Dn[(size_t)f * D + tid + 256 * i]; }
#pragma unroll
        for (int i = 0; i < 4; ++i) oacc[i] += wt * o4[i];
    }
    float s2 = 0.f;
#pragma unroll
    for (int i = 0; i < 4; ++i) { xv[i] += oacc[i]; s2 += xv[i] * xv[i]; }
    s2 = wave_sum(s2); __syncthreads(); if (lane == 0) red[w] = s2; __syncthreads();
    const float rstd2 = rsqrtf((red[0] + red[1] + red[2] + red[3]) * (1.f / D) + EPS);
    if (out) {
#pragma unroll
        for (int i = 0; i < 4; ++i) out[(size_t)t * D + tid + 256 * i] = xv[i] * rstd2 * final_w[tid + 256 * i];
    } else {
#pragma unroll
        for (int i = 0; i < 4; ++i) Xout[(size_t)t * D + tid + 256 * i] = f2bf(xv[i]);
        if (tid == 0) RSout[t] = rstd2;
    }
}
__global__ void __launch_bounds__(256) n_conv(const bf16* XBR, const float* cw, const float* cb, bf16* XC) {
    const size_t i = (size_t)blockIdx.x * 256 + threadIdx.x; const int c = (int)(i & 1023); const int row = (int)(i >> 10), s = row & (SEQ - 1);
    float v = cb[c];
#pragma unroll
    for (int tap = 0; tap < 4; ++tap) { const int ss = s - 3 + tap; if (ss >= 0) v += cw[tap * 1024 + c] * bf2f(XBR[(size_t)(row - 3 + tap) * D + c]); }
    XC[i] = f2bf(v);
}
__global__ void __launch_bounds__(256) n_lru_scan(const bf16* XC, const bf16* RG, const bf16* IG, const bf16* GATE, const float* lam, bf16* YL) {
    const int gi = blockIdx.x * 256 + threadIdx.x, b = gi >> 10, c = gi & 1023;
    const float sp = softplusf_(-lam[c]); float h = 0.f;
    for (int t = 0; t < SEQ; ++t) { const size_t i = ((size_t)b * SEQ + t) * D + c;
        const float la = -8.f * bf2f(RG[i]) * sp, a = __expf(la), mult = sqrtf(-expm1f(2.f * la));
        h = a * h + bf2f(XC[i]) * bf2f(IG[i]) * mult;
        YL[i] = f2bf(h * bf2f(GATE[i])); }
}


#define LAS __attribute__((address_space(3)))
#define GAS __attribute__((address_space(1)))
typedef short bf16x8 __attribute__((ext_vector_type(8)));
typedef float f32x4 __attribute__((ext_vector_type(4)));
typedef float f32x2 __attribute__((ext_vector_type(2)));
typedef unsigned u32x4 __attribute__((ext_vector_type(4)));
typedef unsigned u32x2 __attribute__((ext_vector_type(2)));
typedef GAS unsigned gu32;
#define RLX_AGENT __ATOMIC_RELAXED, __HIP_MEMORY_SCOPE_AGENT
constexpr int NWAVES = 8, NTHR = 512;
constexpr int LDS_STAGE = 131072, LDS_MISC = LDS_STAGE, LDS_BYTES = 147456;
constexpr float QSCALE = 0.08838834764831845f;

constexpr size_t WS_SP = 1 * MiB + 512 * 1024;
constexpr size_t WS_WR = 14 * MiB;
constexpr size_t WS_W1 = 16 * MiB;
constexpr size_t WS_WO = WS_W1 + (size_t)3584 * 1024 * 2;
constexpr size_t WS_WLI = WS_WO + (size_t)1024 * 1024 * 2;
constexpr size_t WS_WLO = WS_WLI + (size_t)2048 * 1024 * 2;
constexpr size_t WS_WG = WS_WLO + (size_t)1024 * 1024 * 2;
constexpr size_t WS_WGU = WS_WG + (size_t)4 * 512 * 256 * 2;
constexpr size_t WS_WD = WS_WGU + (size_t)64 * 512 * 1024 * 2;
static_assert(WS_WD + (size_t)64 * 1024 * 256 * 2 <= WS_S0, "weights fit below the activation slots");
constexpr int CW_TMO = 0, CW_BAR = 4096;

__device__ __forceinline__ unsigned cvt_pk_bf16(float lo, float hi) { unsigned r; asm volatile("v_cvt_pk_bf16_f32 %0, %1, %2" : "=v"(r) : "v"(lo), "v"(hi)); return r; }
__device__ __forceinline__ float fexp(float x) { return __builtin_amdgcn_exp2f(x * 1.4426950408889634f); }
__device__ __forceinline__ float flog(float x) { return __builtin_amdgcn_logf(x) * 0.6931471805599453f; }
__device__ __forceinline__ float frcp(float x) { return __builtin_amdgcn_rcpf(x); }
__device__ __forceinline__ float fsilu(float x) { return x * frcp(1.f + fexp(-x)); }
__device__ __forceinline__ float fsigmoid(float x) { return frcp(1.f + fexp(-x)); }
__device__ __forceinline__ float flogsigmoid(float x) { return fminf(x, 0.f) - flog(1.f + fexp(-fabsf(x))); }
__device__ __forceinline__ float fgelu_tanh(float x) { const float u = 1.5957691216057308f * (x + 0.044715f * x * x * x); return x * frcp(1.f + fexp(-u)); }
__device__ __forceinline__ int lane_id_v() { int l; asm volatile("v_mbcnt_lo_u32_b32 %0, -1, 0\n\tv_mbcnt_hi_u32_b32 %0, -1, %0" : "=v"(l)); return l; }
template <int N> __device__ __forceinline__ float dpp_shr(float v) {
    return __builtin_bit_cast(float, __builtin_amdgcn_update_dpp(0, __builtin_bit_cast(int, v), 0x110 + N, 0xf, 0xf, true)); }

#define XB_TMO      128
#define XB_XCNT(j)  (256  + 64 * (j))
#define XB_XSUB(j)  (1280 + 64 * (j))
#define XB_XGEN(j)  (2304 + 64 * (j))
#define XB_TOP      3328
#define XB_TOPGEN   3392
#define XCD_BAR_WORDS 3456
#define XB_SPIN_CAP (1u << 18)
__device__ __forceinline__ unsigned xb_ld(unsigned* p)              { return __hip_atomic_load(p, __ATOMIC_RELAXED, __HIP_MEMORY_SCOPE_AGENT); }
__device__ __forceinline__ unsigned xb_add(unsigned* p, unsigned v) { return __hip_atomic_fetch_add(p, v, __ATOMIC_RELAXED, __HIP_MEMORY_SCOPE_AGENT); }
__device__ __forceinline__ unsigned xb_xcc_id() { return (unsigned)__builtin_amdgcn_s_getreg((3 << 11) | 20) & 0xFu; }
#define XB_SPIN(cond, bar) do { unsigned _sp = 0; while (cond) { __builtin_amdgcn_s_sleep(1); \
    if ((++_sp & 255u) == 0u) { if (xb_ld(&(bar)[XB_TMO])) break; if (_sp > XB_SPIN_CAP) { atomicAdd(&(bar)[XB_TMO], 1u); break; } } } } while (0)
struct XcdBarrier { unsigned* bar; unsigned x; volatile LAS unsigned* st; };
__device__ __forceinline__ XcdBarrier xcd_barrier_post(unsigned* bar, volatile LAS unsigned* st, bool t0) {
    XcdBarrier b; b.bar = bar; b.x = xb_xcc_id(); b.st = st;
    if (t0) (void)xb_add(&bar[XB_XCNT(b.x)], 1u);
    return b;
}
__device__ __forceinline__ void xcd_barrier_complete(unsigned* bar, unsigned x, unsigned& nloc, unsigned& nx) {
    const unsigned G = gridDim.x * gridDim.y * gridDim.z;
    unsigned sum, cnt, mine, sp = 0u;
    for (;;) {
        sum = 0u; cnt = 0u; mine = 0u;
#pragma unroll
        for (unsigned j = 0; j < 16; ++j) { const unsigned c = xb_ld(&bar[XB_XCNT(j)]); sum += c; cnt += (c > 0u) ? 1u : 0u; mine = (j == x) ? c : mine; }
        if (sum == G) break;
        __builtin_amdgcn_s_sleep(1);
        if ((++sp & 255u) == 0u) { if (xb_ld(&bar[XB_TMO])) break; if (sp > XB_SPIN_CAP) { atomicAdd(&bar[XB_TMO], 1u); break; } }
    }
    nloc = mine > 0u ? mine : 1u; nx = cnt > 0u ? cnt : 1u;
}
__device__ __forceinline__ void xcd_barrier(const XcdBarrier& b, int wave_) {
    asm volatile("s_waitcnt vmcnt(0)" ::: "memory");
    __syncthreads();
    if (wave_ == 0 && lane_id_v() == 0) {
        unsigned* bar = b.bar;
        __builtin_amdgcn_s_waitcnt(0);
        unsigned nloc = b.st[0], nx = b.st[1];
        if (nloc == 0u) { xcd_barrier_complete(bar, b.x, nloc, nx); b.st[0] = nloc; b.st[1] = nx; }
        const unsigned old = xb_add(&bar[XB_XSUB(b.x)], 1u);
        const unsigned gen = old / nloc;
        if (old + 1u == (gen + 1u) * nloc) {
            __builtin_amdgcn_fence(__ATOMIC_RELEASE, "agent");
            asm volatile("s_waitcnt vmcnt(0)" ::: "memory");
            const unsigned og = xb_add(&bar[XB_TOP], 1u);
            const unsigned tg = og / nx;
            if (og + 1u == (tg + 1u) * nx) xb_add(&bar[XB_TOPGEN], 1u);
            else XB_SPIN(xb_ld(&bar[XB_TOPGEN]) == tg, bar);
            __builtin_amdgcn_fence(__ATOMIC_ACQUIRE, "agent");
            xb_add(&bar[XB_XGEN(b.x)], 1u);
            asm volatile("s_waitcnt vmcnt(0)" ::: "memory");
        } else {
            XB_SPIN(xb_ld(&bar[XB_XGEN(b.x)]) == gen, bar);
            __builtin_amdgcn_fence(__ATOMIC_ACQUIRE, "agent");
            asm volatile("s_waitcnt vmcnt(0)" ::: "memory");
        }
    }
    __syncthreads();
}

namespace pg8 {
constexpr int BM = 256, BK = 64, HALF = 128, HTB = HALF * BK * 2, NXCD = 8, WGM = 8;
__device__ __forceinline__ int lds_byte(int r, int c) { const int st = (r >> 4) * 2 + (c >> 5), rr = r & 15, cc = c & 31, ob = rr * 64 + cc * 2; return st * 1024 + (ob ^ (((ob >> 9) & 1) << 5)); }
__device__ __forceinline__ void stage_rc(int b, int& R, int& C) { const int st = b / 1024, sb = b % 1024, swz = sb ^ (((sb >> 9) & 1) << 5); R = (st >> 1) * 16 + swz / 64; C = (st & 1) * 32 + (swz % 64) / 2; }
__device__ __forceinline__ int perm32(int rho) { const int n = rho >> 4, i = rho & 15; return 8 * (i >> 2) + 4 * n + (i & 3); }
__device__ __forceinline__ void tile_order(int L, int nM, int nN, int& pm, int& pn) {
    const int nwg = nM * nN; int wgid = L; { const int q = nwg / NXCD, r = nwg % NXCD, xcd = wgid % NXCD, off = wgid / NXCD; wgid = (xcd < r ? xcd * (q + 1) : r * (q + 1) + (xcd - r) * q) + off; }
    const int nig = WGM * nN, gid = wgid / nig, fm = gid * WGM, gsz = (nM - fm) < WGM ? (nM - fm) : WGM;
    pm = fm + ((wgid % nig) % gsz); pn = (wgid % nig) / gsz;
}
struct Unit { const char* a; const char* b; const int* rows; int pm, pn, e; };

template <class Epi, class Sched, bool GATHER>
__device__ __forceinline__ void gemm_phase(LAS unsigned char* lds, const int lda, const int ldb, const int K, const Sched& S, const Epi& E, const int wid) {
    const int lane = lane_id_v(), tid = wid * 64 + lane, wr = wid >> 2, wc = wid & 3, fr = lane & 15, fq = lane >> 4;
    int nt = K / BK; asm volatile("" : "+s"(nt));
    int Rr[2], Cc[2]; unsigned voffB[2];
#pragma unroll
    for (int i = 0; i < 2; ++i) { int R, C; stage_rc(tid * 16 + i * 8192, R, C); Rr[i] = R; Cc[i] = C; const int Rb = (R & ~31) + perm32(R & 31); voffB[i] = (unsigned)(Rb * ldb + C) * 2u; }
    const size_t kstep = (size_t)(BK * 2);
    const size_t hstepB = (size_t)HALF * ldb * 2;
    const unsigned ldsw = (unsigned)wid * 1024u;
    const int aoff = lds_byte(wr * 64 + fr, fq * 8), boff = lds_byte(wc * 32 + fr, fq * 8);
#define PG8_SA(b, h) (((b) * 2 + (h)) * HTB)
#define PG8_SB(b, h) ((4 + (b) * 2 + (h)) * HTB)
#define PG8_STAGE(bufoff, gbase, voff) do { _Pragma("unroll") for (int _i = 0; _i < 2; ++_i) \
        __builtin_amdgcn_global_load_lds((const unsigned*)((const char*)(gbase) + (voff)[_i]), (LAS unsigned*)(lds + (bufoff) + ldsw + _i * 8192), 16, 0, 0); } while (0)
#define PG8_LDA(dst, b, h) do { _Pragma("unroll") for (int m = 0; m < 4; ++m) _Pragma("unroll") for (int k = 0; k < 2; ++k) dst[m][k] = *(const LAS bf16x8*)(lds + PG8_SA(b, h) + aoff + m * 2048 + k * 1024); } while (0)
#define PG8_LDB(dst, b, h) do { _Pragma("unroll") for (int n = 0; n < 2; ++n) _Pragma("unroll") for (int k = 0; k < 2; ++k) dst[n][k] = *(const LAS bf16x8*)(lds + PG8_SB(b, h) + boff + n * 2048 + k * 1024); } while (0)
#define PG8_MMA(ai, bj, At, Bt) do { __builtin_amdgcn_s_setprio(1); _Pragma("unroll") for (int m = 0; m < 4; ++m) _Pragma("unroll") for (int n = 0; n < 2; ++n) _Pragma("unroll") for (int k = 0; k < 2; ++k) \
        acc[ai][bj][m][n] = __builtin_amdgcn_mfma_f32_16x16x32_bf16(Bt[n][k], At[m][k], acc[ai][bj][m][n], 0, 0, 0); __builtin_amdgcn_s_setprio(0); } while (0)
#define PG8_WAIT_V(n) asm volatile("s_waitcnt vmcnt(" #n ")" ::: "memory")
#define PG8_WAIT_L(n) asm volatile("s_waitcnt lgkmcnt(" #n ")" ::: "memory")
#define PG8_BAR __builtin_amdgcn_s_barrier()
#define PG8_SCHED __builtin_amdgcn_sched_barrier(0)
#define PG8_SETVOFF(v, u) do { _Pragma("unroll") for (int _h = 0; _h < 2; ++_h) _Pragma("unroll") for (int _i = 0; _i < 2; ++_i) { \
        if (GATHER) { unsigned _tk = (unsigned)(u).rows[_h * HALF + Rr[_i]]; _tk = _tk < (unsigned)T ? _tk : 0u; (v)[_h][_i] = (_tk * (unsigned)lda + (unsigned)Cc[_i]) * 2u; } else (v)[_h][_i] = (unsigned)(((_h * HALF + Rr[_i]) * lda + Cc[_i]) * 2); } } while (0)
    Unit cur, nxt; int ui = 0;
    if (!S.next(0, cur)) return;
    f32x4 acc[2][2][4][2];
#pragma unroll
    for (int a = 0; a < 2; ++a)
#pragma unroll
        for (int b = 0; b < 2; ++b)
#pragma unroll
            for (int m = 0; m < 4; ++m)
#pragma unroll
                for (int n = 0; n < 2; ++n) acc[a][b][m][n] = (f32x4){0.f, 0.f, 0.f, 0.f};
    bf16x8 At[4][2], B0[2][2], B1[2][2];
    unsigned vA[2][2], vN[2][2];
    PG8_SETVOFF(vA, cur);
    if (GATHER) asm volatile("" :: "v"(vA[0][0]), "v"(vA[0][1]), "v"(vA[1][0]), "v"(vA[1][1]));
    const char* cA = cur.a; const char* cB = cur.b;
    PG8_STAGE(PG8_SB(0, 0), cB, voffB); PG8_STAGE(PG8_SB(0, 1), cB + hstepB, voffB); PG8_STAGE(PG8_SA(0, 0), cA, vA[0]); PG8_STAGE(PG8_SA(0, 1), cA, vA[1]);
    if (wr == 1) PG8_BAR;
    PG8_WAIT_V(2); PG8_BAR;
    PG8_STAGE(PG8_SB(1, 0), cB + kstep, voffB); PG8_STAGE(PG8_SA(1, 0), cA + kstep, vA[0]); PG8_STAGE(PG8_SB(1, 1), cB + hstepB + kstep, voffB);
    PG8_WAIT_V(6); PG8_BAR;
    for (;;) {
        const bool has_next = S.next(ui + 1, nxt);
        const char* nA = has_next ? nxt.a : cA; const char* nB = has_next ? nxt.b : cB;
        if (GATHER) {
            if (has_next) { PG8_SETVOFF(vN, nxt); } else {
#pragma unroll
                for (int h = 0; h < 2; ++h)
#pragma unroll
                    for (int i = 0; i < 2; ++i) vN[h][i] = vA[h][i]; }
            asm volatile("" :: "v"(vN[0][0]), "v"(vN[0][1]), "v"(vN[1][0]), "v"(vN[1][1]));
        }
#pragma nounroll
        for (int t = 0; t < nt; t += 2) {
            const bool last = (t == nt - 2);
            const char* a1 = cA + (size_t)(t + 1) * kstep;
            const char* a2 = last ? nA : cA + (size_t)(t + 2) * kstep; const char* b2 = last ? nB : cB + (size_t)(t + 2) * kstep;
            const char* a3 = a2 + kstep; const char* b3 = b2 + kstep;
            PG8_LDB(B0, 0, 0); PG8_LDB(B1, 0, 1); PG8_SCHED; PG8_LDA(At, 0, 0); PG8_STAGE(PG8_SA(1, 1), a1, vA[1]);
            if (GATHER && last) {
#pragma unroll
                for (int h = 0; h < 2; ++h)
#pragma unroll
                    for (int i = 0; i < 2; ++i) vA[h][i] = vN[h][i]; }
            PG8_WAIT_V(8); PG8_WAIT_L(0); PG8_BAR; PG8_MMA(0, 0, At, B0); PG8_MMA(0, 1, At, B1); PG8_BAR; PG8_SCHED;
            PG8_LDA(At, 0, 1); PG8_STAGE(PG8_SB(0, 0), b2, voffB); PG8_STAGE(PG8_SB(0, 1), b2 + hstepB, voffB); PG8_STAGE(PG8_SA(0, 0), a2, vA[0]);
            PG8_WAIT_V(8); PG8_WAIT_L(0); PG8_BAR; PG8_MMA(1, 0, At, B0); PG8_MMA(1, 1, At, B1); PG8_BAR; PG8_SCHED;
            PG8_LDB(B0, 1, 0); PG8_LDB(B1, 1, 1); PG8_SCHED; PG8_LDA(At, 1, 0); PG8_STAGE(PG8_SA(0, 1), a2, vA[1]);
            PG8_WAIT_V(8); PG8_WAIT_L(0); PG8_BAR; PG8_MMA(0, 0, At, B0); PG8_MMA(0, 1, At, B1); PG8_BAR; PG8_SCHED;
            PG8_LDA(At, 1, 1); PG8_STAGE(PG8_SB(1, 0), b3, voffB); PG8_STAGE(PG8_SB(1, 1), b3 + hstepB, voffB); PG8_STAGE(PG8_SA(1, 0), a3, vA[0]);
            PG8_WAIT_V(8); PG8_WAIT_L(0); PG8_BAR; PG8_MMA(1, 0, At, B0); PG8_MMA(1, 1, At, B1); PG8_BAR; PG8_SCHED;
        }
        if (wr == 0) PG8_BAR;
        E(acc, cur, wr, wc, fr, fq, lane);
        if (!has_next) break;
#pragma unroll
        for (int a = 0; a < 2; ++a)
#pragma unroll
            for (int b = 0; b < 2; ++b)
#pragma unroll
                for (int m = 0; m < 4; ++m)
#pragma unroll
                    for (int n = 0; n < 2; ++n) acc[a][b][m][n] = (f32x4){0.f, 0.f, 0.f, 0.f};
        cur = nxt; cA = nA; cB = nB; ++ui;
        if (wr == 1) PG8_BAR;
    }
    PG8_WAIT_V(0);
    PG8_BAR;
#undef PG8_SA
#undef PG8_SB
#undef PG8_STAGE
#undef PG8_LDA
#undef PG8_LDB
#undef PG8_MMA
#undef PG8_WAIT_V
#undef PG8_WAIT_L
#undef PG8_BAR
#undef PG8_SCHED
#undef PG8_SETVOFF
}
struct SchedDense {
    int nM, nN, G, c; const char* A; const char* B; size_t a_tile, b_tile; int pn_div; size_t a_pn_step;
    __device__ __forceinline__ bool next(int i, Unit& u) const {
        const long L = (long)i * G + c; if (L >= (long)nM * nN) return false;
        int pm, pn; tile_order((int)L, nM, nN, pm, pn);
        u.pm = pm; u.pn = pn; u.e = 0; u.rows = nullptr; u.a = A + (size_t)pm * a_tile + (size_t)(pn / pn_div) * a_pn_step; u.b = B + (size_t)pn * b_tile; return true;
    }
};
}

__device__ __forceinline__ void unpack8(const u32x4 p, f32x4& r0, f32x4& r1) {
    r0 = (f32x4){__uint_as_float(p.x << 16), __uint_as_float(p.x & 0xffff0000u), __uint_as_float(p.y << 16), __uint_as_float(p.y & 0xffff0000u)};
    r1 = (f32x4){__uint_as_float(p.z << 16), __uint_as_float(p.z & 0xffff0000u), __uint_as_float(p.w << 16), __uint_as_float(p.w & 0xffff0000u)}; }
__device__ __forceinline__ u32x4 pack8(const f32x4 v0, const f32x4 v1) { u32x4 w; w.x = cvt_pk_bf16(v0[0], v0[1]); w.y = cvt_pk_bf16(v0[2], v0[3]); w.z = cvt_pk_bf16(v1[0], v1[1]); w.w = cvt_pk_bf16(v1[2], v1[3]); return w; }

struct EpiG1 {
    bf16 *Q, *Kb, *V, *SG, *EQ, *EK; float *EREF, *ELAST, *ELR, *AF; const float* RS; const float* b_alpha;
    __device__ __forceinline__ void operator()(f32x4 (&acc)[2][2][4][2], const pg8::Unit& u, int wr, int wc, int fr, int fq, int lane) const {
        const int row0 = u.pm * 256 + wr * 64 + fr, pn = u.pn;
        if (pn < 12) {
            bf16* base; int ldc, colt; const bool act = pn >= 8;
            if (pn < 2) { base = Q; ldc = 512; colt = pn * 256; } else if (pn < 4) { base = Kb; ldc = 512; colt = (pn - 2) * 256; }
            else if (pn < 8) { base = V; ldc = 1024; colt = (pn - 4) * 256; } else { base = SG; ldc = 1024; colt = (pn - 8) * 256; }
            const int col0 = colt + wc * 32 + 8 * fq;
            float rsv8[2][4];
#pragma unroll
            for (int ai = 0; ai < 2; ++ai)
#pragma unroll
                for (int m = 0; m < 4; ++m) rsv8[ai][m] = RS[row0 + ai * 128 + m * 16];
#pragma unroll
            for (int ai = 0; ai < 2; ++ai)
#pragma unroll
                for (int m = 0; m < 4; ++m) { const int row = row0 + ai * 128 + m * 16; const float rs = rsv8[ai][m]; bf16* rowp = base + (size_t)row * ldc + col0;
#pragma unroll
                    for (int bj = 0; bj < 2; ++bj) { f32x4 v0 = acc[ai][bj][m][0] * rs, v1 = acc[ai][bj][m][1] * rs;
                        if (act) {
#pragma unroll
                            for (int j = 0; j < 4; ++j) { v0[j] = fsilu(v0[j]); v1[j] = fsilu(v1[j]); } }
                        u32x4 w; w.x = cvt_pk_bf16(v0[0], v0[1]); w.y = cvt_pk_bf16(v0[2], v0[3]); w.z = cvt_pk_bf16(v1[0], v1[1]); w.w = cvt_pk_bf16(v1[2], v1[3]);
                        *(u32x4*)(rowp + bj * 128) = w; } }
        } else {
            const int colt = (pn - 12) * 256;
#pragma unroll
            for (int ai = 0; ai < 2; ++ai) {
                const int chunk = u.pm * 4 + ai * 2 + wr; float rsv[4];
#pragma unroll
                for (int m = 0; m < 4; ++m) rsv[m] = RS[row0 + ai * 128 + m * 16];
#pragma unroll
                for (int bj = 0; bj < 2; ++bj)
#pragma unroll
                    for (int n = 0; n < 2; ++n) {
                        const int c = colt + bj * 128 + wc * 32 + 8 * fq + 4 * n;
                        const f32x4 ba = *(const f32x4*)(b_alpha + c);
                        f32x4 cum[4]; f32x4 run = (f32x4){0.f, 0.f, 0.f, 0.f};
#pragma unroll
                        for (int m = 0; m < 4; ++m) { const f32x4 z = acc[ai][bj][m][n] * rsv[m] + ba; f32x4 la;
#pragma unroll
                            for (int j = 0; j < 4; ++j) la[j] = flogsigmoid(z[j]) * 0.0625f;
                            if (AF) { f32x4 ea;
#pragma unroll
                                for (int j = 0; j < 4; ++j) ea[j] = fexp(la[j]);
                                *(f32x4*)(AF + (size_t)(row0 + ai * 128 + m * 16) * 512 + c) = ea; }
                            f32x4 tot;
#pragma unroll
                            for (int j = 0; j < 4; ++j) { float v = la[j]; v += dpp_shr<1>(v); v += dpp_shr<2>(v); v += dpp_shr<4>(v); v += dpp_shr<8>(v); la[j] = v; tot[j] = __shfl(v, lane | 15); }
                            cum[m] = la + run; run += tot; }
                        f32x4 ref;
#pragma unroll
                        for (int j = 0; j < 4; ++j) ref[j] = __shfl(cum[2][j], lane & 48);
#pragma unroll
                        for (int m = 0; m < 4; ++m) { const size_t o = (size_t)(row0 + ai * 128 + m * 16) * 512 + c; float q[4], k[4];
#pragma unroll
                            for (int j = 0; j < 4; ++j) { q[j] = QSCALE * fexp(cum[m][j] - ref[j]); k[j] = fexp(ref[j] - cum[m][j]); }
                            u32x2 wq, wk; wq.x = cvt_pk_bf16(q[0], q[1]); wq.y = cvt_pk_bf16(q[2], q[3]); wk.x = cvt_pk_bf16(k[0], k[1]); wk.y = cvt_pk_bf16(k[2], k[3]);
                            *(u32x2*)(EQ + o) = wq; *(u32x2*)(EK + o) = wk; }
                        { f32x4 er, el, elr;
#pragma unroll
                            for (int j = 0; j < 4; ++j) { er[j] = fexp(ref[j]); el[j] = fexp(run[j]); elr[j] = fexp(run[j] - ref[j]); }
                            asm volatile("" : "+v"(er), "+v"(el), "+v"(elr));
                            if (fr == 0) { *(f32x4*)(EREF + chunk * 512 + c) = er; *(f32x4*)(ELAST + chunk * 512 + c) = el; *(f32x4*)(ELR + chunk * 512 + c) = elr; } }
                    }
            }
        }
    }
};
__device__ __forceinline__ unsigned opaque_u0(unsigned v) { asm volatile("" : "+v"(v)); return v; }
struct EpiResidF {
    const float* xf; const bf16* xb; bf16* out;
    __device__ __forceinline__ void operator()(f32x4 (&acc)[2][2][4][2], const pg8::Unit& u, int wr, int wc, int fr, int fq, int lane) const {
        const size_t uo = (size_t)u.pm * 256 * 1024 + u.pn * 256;
        const char* xfb = (const char*)(xf + uo); const char* xbb = (const char*)(xb + uo); char* ob = (char*)(out + uo);
        const unsigned lo = opaque_u0((unsigned)((wr * 64 + fr) * 1024 + wc * 32 + 8 * fq) * 2u);
#pragma unroll
        for (int ai = 0; ai < 2; ++ai) {
            f32x4 r0[4][2], r1[4][2];
#pragma unroll
            for (int m = 0; m < 4; ++m)
#pragma unroll
                for (int bj = 0; bj < 2; ++bj) { const unsigned o = lo + (unsigned)((ai * 128 + m * 16) * 1024 + bj * 128) * 2u;
                    if (xf) { r0[m][bj] = *(const f32x4*)(xfb + 2u * o); r1[m][bj] = *(const f32x4*)(xfb + (2u * o + 16u)); }
                    else unpack8(*(const u32x4*)(xbb + o), r0[m][bj], r1[m][bj]); }
#pragma unroll
            for (int m = 0; m < 4; ++m)
#pragma unroll
                for (int bj = 0; bj < 2; ++bj) { const unsigned o = lo + (unsigned)((ai * 128 + m * 16) * 1024 + bj * 128) * 2u;
                    *(u32x4*)(ob + o) = pack8(acc[ai][bj][m][0] + r0[m][bj], acc[ai][bj][m][1] + r1[m][bj]); } }
    }
};

__device__ __forceinline__ void cvt_item(const float* W, int ldn, int scol0, const float* kscale, bf16* dst, int dstK, int drow0, int kb, int nb, LAS float* scr, int lane, int kmask = 0x7fffffff) {
    const int k0 = 64 * kb, n0 = 32 * nb;
    float vv[32];
    const GAS float* wp = (const GAS float*)W + (size_t)(k0 + (lane >> 5)) * ldn + scol0 + n0 + (lane & 31);
#pragma unroll
    for (int i = 0; i < 32; ++i) vv[i] = wp[(size_t)(2 * i) * ldn];
#pragma unroll
    for (int i = 0; i < 32; ++i) { const int kk = 2 * i + (lane >> 5); float v = vv[i]; if (kscale) v *= kscale[(k0 + kk) & kmask]; scr[kk * 33 + (lane & 31)] = v; }
    asm volatile("s_waitcnt lgkmcnt(0)" ::: "memory");
    const int c = lane & 7;
#pragma unroll
    for (int j = 0; j < 4; ++j) { const int n = (lane >> 3) + 8 * j; const LAS float* s = scr + (8 * c) * 33 + n;
        u32x4 o; o.x = cvt_pk_bf16(s[0 * 33], s[1 * 33]); o.y = cvt_pk_bf16(s[2 * 33], s[3 * 33]); o.z = cvt_pk_bf16(s[4 * 33], s[5 * 33]); o.w = cvt_pk_bf16(s[6 * 33], s[7 * 33]);
        *(u32x4*)(dst + (size_t)(drow0 + n0 + n) * dstK + k0 + 8 * c) = o; }
    asm volatile("s_waitcnt lgkmcnt(0)" ::: "memory");
}
__device__ __forceinline__ void cvt_item_la(const float* Win, const float* wal, const float* kscale, bf16* dst, int kb, int nb, LAS float* scr, int lane) {
    const int k0 = 64 * kb, n0 = 32 * nb; float wa[16];
#pragma unroll
    for (int r = 0; r < 16; ++r) wa[r] = wal[r * 512 + n0 + (lane & 31)];
#pragma unroll 4
    for (int i = 0; i < 32; ++i) { const int kk = 2 * i + (lane >> 5); const float* lr = Win + (size_t)(k0 + kk) * 3088 + 3072; float v = 0.f;
#pragma unroll
        for (int r = 0; r < 16; ++r) v += lr[r] * wa[r];
        scr[kk * 33 + (lane & 31)] = v * kscale[k0 + kk]; }
    asm volatile("s_waitcnt lgkmcnt(0)" ::: "memory");
    const int c = lane & 7;
#pragma unroll
    for (int j = 0; j < 4; ++j) { const int n = (lane >> 3) + 8 * j; const LAS float* s = scr + (8 * c) * 33 + n;
        u32x4 o; o.x = cvt_pk_bf16(s[0 * 33], s[1 * 33]); o.y = cvt_pk_bf16(s[2 * 33], s[3 * 33]); o.z = cvt_pk_bf16(s[4 * 33], s[5 * 33]); o.w = cvt_pk_bf16(s[6 * 33], s[7 * 33]);
        *(u32x4*)(dst + (size_t)(3072 + n0 + n) * 1024 + k0 + 8 * c) = o; }
    asm volatile("s_waitcnt lgkmcnt(0)" ::: "memory");
}


constexpr int CAP = 32768;
constexpr size_t WS_LIST = 5 * MiB, WS_LW = 9 * MiB, WS_POS = 13 * MiB;
constexpr size_t WS_AGG = 13 * MiB + 512 * 1024;
constexpr size_t WS_CARRY = 5 * MiB;
constexpr int CW_CNT = 16384;
constexpr int TS_OFF = 256;

namespace pg8 {
struct SchedMoe {
    const LAS int* ts; int G, c, npn; const char* A; const char* B; const int* LIST; size_t b_exp, b_pn, a_tile; bool gather;
    __device__ __forceinline__ bool next(int i, Unit& u) const {
        const int NT = __builtin_amdgcn_readfirstlane(ts[32]); const long L = (long)i * G + c; if (L >= (long)NT * npn) return false;
        const int tg = (int)(L / npn), pn = (int)(L % npn);
        const int e = __builtin_amdgcn_readfirstlane(ts[64 + tg]);
        const int tile = tg - __builtin_amdgcn_readfirstlane(ts[e]);
        u.pm = tg; u.pn = pn; u.e = e; u.rows = LIST + (size_t)e * CAP + tile * 256; u.a = gather ? A : A + (size_t)tg * a_tile; u.b = B + (size_t)e * b_exp + (size_t)pn * b_pn; return true;
    }
};
}
__device__ __forceinline__ unsigned opaque_u(unsigned v) { asm volatile("" : "+v"(v)); return v; }
struct EpiM1 {
    bf16* ACT; const int* LIST; const float* LW; const float* RS;
    __device__ __forceinline__ void operator()(f32x4 (&acc)[2][2][4][2], const pg8::Unit& u, int wr, int wc, int fr, int fq, int lane) const {
        const char* rowsb = (const char*)u.rows; const char* lwb = (const char*)(LW + (u.rows - LIST)); const char* rsb = (const char*)RS;
        char* ob = (char*)(ACT + (size_t)u.pm * 256 * 256 + u.pn * 128);
        const unsigned r4 = opaque_u((unsigned)(wr * 64 + fr) * 4u), lo = opaque_u((unsigned)((wr * 64 + fr) * 256 + wc * 32 + 8 * fq) * 2u);
        unsigned tk8[2][4]; float rs8[2][4], w8[2][4];
#pragma unroll
        for (int ai = 0; ai < 2; ++ai)
#pragma unroll
            for (int m = 0; m < 4; ++m) { const unsigned ro = r4 + (unsigned)(ai * 128 + m * 16) * 4u; tk8[ai][m] = *(const unsigned*)(rowsb + ro); w8[ai][m] = *(const float*)(lwb + ro); }
#pragma unroll
        for (int ai = 0; ai < 2; ++ai)
#pragma unroll
            for (int m = 0; m < 4; ++m) { const unsigned tk = tk8[ai][m] < (unsigned)T ? tk8[ai][m] : 0u; rs8[ai][m] = *(const float*)(rsb + tk * 4u); }
#pragma unroll
        for (int ai = 0; ai < 2; ++ai)
#pragma unroll
            for (int m = 0; m < 4; ++m) { const float rs = rs8[ai][m], w = w8[ai][m]; f32x4 o[2];
#pragma unroll
                for (int n = 0; n < 2; ++n) { const f32x4 g = acc[ai][0][m][n] * rs, up = acc[ai][1][m][n] * rs;
#pragma unroll
                    for (int j = 0; j < 4; ++j) o[n][j] = fsilu(g[j]) * up[j] * w; }
                *(u32x4*)(ob + (lo + (unsigned)(ai * 128 + m * 16) * 512u)) = pack8(o[0], o[1]); }
    }
};
struct EpiStore {
    bf16* O; int ldc; int pad;
    __device__ __forceinline__ void operator()(f32x4 (&acc)[2][2][4][2], const pg8::Unit& u, int wr, int wc, int fr, int fq, int lane) const {
        char* ob = (char*)(O + (size_t)u.pm * 256 * 1024 + u.pn * 256);
        const unsigned lo = opaque_u((unsigned)((wr * 64 + fr) * 1024 + wc * 32 + 8 * fq) * 2u);
#pragma unroll
        for (int ai = 0; ai < 2; ++ai)
#pragma unroll
            for (int m = 0; m < 4; ++m)
#pragma unroll
                for (int bj = 0; bj < 2; ++bj) *(u32x4*)(ob + (lo + (unsigned)((ai * 128 + m * 16) * 1024 + bj * 128) * 2u)) = pack8(acc[ai][bj][m][0], acc[ai][bj][m][1]);
    }
};
struct EpiL1 {
    bf16 *XBR, *GATE; const float* RS;
    __device__ __forceinline__ void operator()(f32x4 (&acc)[2][2][4][2], const pg8::Unit& u, int wr, int wc, int fr, int fq, int lane) const {
        const bool act = u.pn >= 4; char* ob = (char*)((act ? GATE : XBR) + (size_t)u.pm * 256 * 1024 + (u.pn & 3) * 256); const char* rsb = (const char*)(RS + u.pm * 256);
        const unsigned r4 = opaque_u((unsigned)(wr * 64 + fr) * 4u), lo = opaque_u((unsigned)((wr * 64 + fr) * 1024 + wc * 32 + 8 * fq) * 2u);
        float rs8[2][4];
#pragma unroll
        for (int ai = 0; ai < 2; ++ai)
#pragma unroll
            for (int m = 0; m < 4; ++m) rs8[ai][m] = *(const float*)(rsb + (r4 + (unsigned)(ai * 128 + m * 16) * 4u));
#pragma unroll
        for (int ai = 0; ai < 2; ++ai)
#pragma unroll
            for (int m = 0; m < 4; ++m) { const float rs = rs8[ai][m];
#pragma unroll
                for (int bj = 0; bj < 2; ++bj) { f32x4 v0 = acc[ai][bj][m][0] * rs, v1 = acc[ai][bj][m][1] * rs;
                    if (act) {
#pragma unroll
                        for (int j = 0; j < 4; ++j) { v0[j] = fgelu_tanh(v0[j]); v1[j] = fgelu_tanh(v1[j]); } }
                    *(u32x4*)(ob + (lo + (unsigned)((ai * 128 + m * 16) * 1024 + bj * 128) * 2u)) = pack8(v0, v1); } }
    }
};
struct EpiL2 {
    const bf16* XC; bf16 *LOGA, *XN; const float *br, *bi, *SP;
    __device__ __forceinline__ void operator()(f32x4 (&acc)[2][2][4][2], const pg8::Unit& u, int wr, int wc, int fr, int fq, int lane) const {
        const int cu = (u.pn >> 1) * 256 + (u.pn & 1) * 128; const size_t uo = (size_t)u.pm * 256 * 1024 + cu;
        const char* xcb = (const char*)(XC + uo); char* lab = (char*)(LOGA + uo); char* xnb = (char*)(XN + uo);
        const unsigned cl = opaque_u((unsigned)(wc * 32 + 8 * fq) * 4u), lo = opaque_u((unsigned)((wr * 64 + fr) * 1024 + wc * 32 + 8 * fq) * 2u);
        f32x4 vbr[2], vbi[2], vsp[2];
#pragma unroll
        for (int n = 0; n < 2; ++n) { vbr[n] = *(const f32x4*)((const char*)(br + cu) + (cl + 16u * n)); vbi[n] = *(const f32x4*)((const char*)(bi + cu) + (cl + 16u * n)); vsp[n] = *(const f32x4*)((const char*)(SP + cu) + (cl + 16u * n)); }
        u32x4 xc8[2][4];
#pragma unroll
        for (int ai = 0; ai < 2; ++ai)
#pragma unroll
            for (int m = 0; m < 4; ++m) xc8[ai][m] = *(const u32x4*)(xcb + (lo + (unsigned)((ai * 128 + m * 16) * 1024) * 2u));
#pragma unroll
        for (int ai = 0; ai < 2; ++ai)
#pragma unroll
            for (int m = 0; m < 4; ++m) { const unsigned o = lo + (unsigned)((ai * 128 + m * 16) * 1024) * 2u;
                f32x4 xc[2]; unpack8(xc8[ai][m], xc[0], xc[1]); f32x4 la[2], xn[2];
#pragma unroll
                for (int n = 0; n < 2; ++n)
#pragma unroll
                    for (int j = 0; j < 4; ++j) { const float r = fsigmoid(acc[ai][0][m][n][j] + vbr[n][j]), ig = fsigmoid(acc[ai][1][m][n][j] + vbi[n][j]);
                        const float l = -8.f * r * vsp[n][j]; la[n][j] = l; xn[n][j] = xc[n][j] * ig * sqrtf(fmaxf(1.f - fexp(2.f * l), 0.f)); }
                *(u32x4*)(lab + o) = pack8(la[0], la[1]); *(u32x4*)(xnb + o) = pack8(xn[0], xn[1]); }
    }
};

__device__ __forceinline__ void build_ts(unsigned* CNT, LAS int* ts, int tid) {
    __syncthreads();
    if (tid < 32) ts[400 + tid] = (int)((xb_ld(CNT + tid) + 255u) >> 8);
    __syncthreads();
    if (tid == 0) { int a = 0; for (int e = 0; e < 32; ++e) { ts[e] = a; a += ts[400 + e]; } ts[32] = a; }
    __syncthreads();
    if (tid < 32) { const int b = ts[tid], n = ts[tid + 1] - b; for (int k = 0; k < n; ++k) ts[64 + b + k] = tid; }
    __syncthreads();
}
__device__ __forceinline__ void router_phase(LAS unsigned char* lds, const bf16* X, const bf16* WRl, float* RS, unsigned* CNT, int* LIST, float* LW, int* POS, int bx, int G, int tid, int lane, int wave) {
    LAS float* lg = (LAS float*)lds + wave * (16 * 48);
    LAS float* rsl = (LAS float*)(lds + 24576) + wave * 16;
    LAS unsigned* cnt_l = (LAS unsigned*)(lds + 25600); LAS unsigned* base_l = cnt_l + 32;
    const int fr = lane & 15, fq = lane >> 4;
    for (int grp = bx; grp < T / 128; grp += G) {
        if (tid < 32) cnt_l[tid] = 0u;
        __syncthreads();
        const int t0 = grp * 128 + wave * 16;
        f32x4 a0 = (f32x4){0.f, 0.f, 0.f, 0.f}, a1 = a0, a2 = a0; float ss = 0.f;
        const bf16* xa = X + (size_t)(t0 + fr) * D + 8 * fq; const bf16* wb = WRl + (size_t)fr * D + 8 * fq;
#pragma unroll 8
        for (int s = 0; s < 32; ++s) {
            const bf16x8 a = *(const GAS bf16x8*)(xa + 32 * s), b0 = *(const GAS bf16x8*)(wb + 32 * s), b1 = *(const GAS bf16x8*)(wb + 16 * D + 32 * s), b2 = *(const GAS bf16x8*)(wb + 32 * D + 32 * s);
#pragma unroll
            for (int j = 0; j < 8; ++j) { const float v = bf2f((bf16)a[j]); ss += v * v; }
            a0 = __builtin_amdgcn_mfma_f32_16x16x32_bf16(a, b0, a0, 0, 0, 0); a1 = __builtin_amdgcn_mfma_f32_16x16x32_bf16(a, b1, a1, 0, 0, 0); a2 = __builtin_amdgcn_mfma_f32_16x16x32_bf16(a, b2, a2, 0, 0, 0);
        }
        ss += __shfl_xor(ss, 16); ss += __shfl_xor(ss, 32);
        const float rstd = rsqrtf(ss * (1.f / D) + EPS);
        if (fq == 0) { rsl[fr] = rstd; RS[t0 + fr] = rstd; }
#pragma unroll
        for (int r = 0; r < 4; ++r) { lg[(4 * fq + r) * 48 + fr] = a0[r]; lg[(4 * fq + r) * 48 + 16 + fr] = a1[r]; lg[(4 * fq + r) * 48 + 32 + fr] = a2[r]; }
        asm volatile("s_waitcnt lgkmcnt(0)" ::: "memory");
        int e0g = 0, e1g = 0; float w0 = 0.f, w1 = 0.f; unsigned rk0 = 0u, rk1 = 0u;
        if (lane < 16) {
            const LAS float* l = lg + lane * 48; const float rs = rsl[lane];
            int g = 0; float gm = l[0] * rs;
            for (int i = 1; i < 4; ++i) { const float v = l[i] * rs; if (v > gm) { gm = v; g = i; } }
            float gs = 0.f; for (int i = 0; i < 4; ++i) gs += fexp(l[i] * rs - gm);
            const float pg = 1.f / gs;
            const LAS float* el = l + 4 + g * 8; int e0 = 0; float m0 = el[0] * rs;
            for (int i = 1; i < 8; ++i) { const float v = el[i] * rs; if (v > m0) { m0 = v; e0 = i; } }
            int e1 = 0; float m1 = -3.0e38f;
            for (int i = 0; i < 8; ++i) { const float v = el[i] * rs; if (i != e0 && v > m1) { m1 = v; e1 = i; } }
            const float p1 = fexp(m1 - m0), den = 1.f / (1.f + p1);
            e0g = g * 8 + e0; e1g = g * 8 + e1; w0 = pg * den; w1 = pg * p1 * den;
            rk0 = __hip_atomic_fetch_add(cnt_l + e0g, 1u, __ATOMIC_RELAXED, __HIP_MEMORY_SCOPE_WORKGROUP);
            rk1 = __hip_atomic_fetch_add(cnt_l + e1g, 1u, __ATOMIC_RELAXED, __HIP_MEMORY_SCOPE_WORKGROUP);
        }
        __syncthreads();
        if (tid < 32) base_l[tid] = xb_add(CNT + tid, cnt_l[tid]);
        __syncthreads();
        if (lane < 16) { const int tok = t0 + lane; const int s0 = e0g * CAP + (int)(base_l[e0g] + rk0), s1 = e1g * CAP + (int)(base_l[e1g] + rk1);
            LIST[s0] = tok; LW[s0] = w0; LIST[s1] = tok; LW[s1] = w1; POS[2 * tok] = s0; POS[2 * tok + 1] = s1; }
        __syncthreads();
    }
}
__device__ __forceinline__ void combine_phase(const LAS int* ts, const bf16* X, const bf16* Y, const int* POS, bf16* Xn, float* RSn, const float* fw, float* out, int bx, int G, int lane, int wave) {
    const int NW = G * NWAVES;
    for (int t0 = bx * NWAVES + wave; t0 < T; t0 += 2 * NW) {
        int tk[2]; tk[0] = t0; tk[1] = t0 + NW < T ? t0 + NW : t0;
        size_t r0[2], r1[2];
#pragma unroll
        for (int q = 0; q < 2; ++q) { const int p0 = POS[2 * tk[q]], p1 = POS[2 * tk[q] + 1];
            r0[q] = (size_t)ts[p0 >> 15] * 256 + (p0 & (CAP - 1)); r1[q] = (size_t)ts[p1 >> 15] * 256 + (p1 & (CAP - 1)); }
        u32x4 lx[2][2], ly[2][2], lz[2][2];
#pragma unroll
        for (int q = 0; q < 2; ++q)
#pragma unroll
            for (int h = 0; h < 2; ++h) { const int c = h * 512 + lane * 8;
                lx[q][h] = *(const GAS u32x4*)(X + (size_t)tk[q] * D + c); ly[q][h] = *(const GAS u32x4*)(Y + r0[q] * D + c); lz[q][h] = *(const GAS u32x4*)(Y + r1[q] * D + c); }
#pragma unroll
        for (int q = 0; q < 2; ++q) { const int t = tk[q]; f32x4 v[4]; float ss = 0.f;
#pragma unroll
            for (int h = 0; h < 2; ++h) { f32x4 x0, x1, y0, y1, z0, z1; unpack8(lx[q][h], x0, x1); unpack8(ly[q][h], y0, y1); unpack8(lz[q][h], z0, z1);
                v[2 * h] = x0 + y0 + z0; v[2 * h + 1] = x1 + y1 + z1;
#pragma unroll
                for (int j = 0; j < 4; ++j) ss += v[2 * h][j] * v[2 * h][j] + v[2 * h + 1][j] * v[2 * h + 1][j]; }
            ss = wave_sum(ss); const float rstd = rsqrtf(ss * (1.f / D) + EPS);
            if (out) {
#pragma unroll
                for (int h = 0; h < 2; ++h) { const int c = h * 512 + lane * 8; const f32x4 f0 = *(const f32x4*)(fw + c), f1 = *(const f32x4*)(fw + c + 4);
                    *(GAS f32x4*)(out + (size_t)t * D + c) = v[2 * h] * rstd * f0; *(GAS f32x4*)(out + (size_t)t * D + c + 4) = v[2 * h + 1] * rstd * f1; }
            } else {
#pragma unroll
                for (int h = 0; h < 2; ++h) *(GAS u32x4*)(Xn + (size_t)t * D + h * 512 + lane * 8) = pack8(v[2 * h], v[2 * h + 1]);
                if (lane == 0) RSn[t] = rstd;
            }
        }
    }
}
__device__ __forceinline__ void conv_phase(const bf16* XBR, const float* cw, const float* cb, bf16* XC, int bx, int G, int tid) {
    for (int item = bx * NTHR + tid; item < (T / 32) * 128; item += G * NTHR) {
        const int cg = item & 127, run = item >> 7, c = cg * 8, t0 = run * 32;
        f32x4 w[4][2], b[2];
#pragma unroll
        for (int k = 0; k < 4; ++k) { w[k][0] = *(const f32x4*)(cw + k * D + c); w[k][1] = *(const f32x4*)(cw + k * D + c + 4); }
        b[0] = *(const f32x4*)(cb + c); b[1] = *(const f32x4*)(cb + c + 4);
        f32x4 h0[2], h1[2], h2[2];
        const bool first = (t0 & (SEQ - 1)) == 0;
        if (first) { h0[0] = h0[1] = h1[0] = h1[1] = h2[0] = h2[1] = (f32x4){0.f, 0.f, 0.f, 0.f}; }
        else { unpack8(*(const u32x4*)(XBR + (size_t)(t0 - 3) * D + c), h0[0], h0[1]); unpack8(*(const u32x4*)(XBR + (size_t)(t0 - 2) * D + c), h1[0], h1[1]); unpack8(*(const u32x4*)(XBR + (size_t)(t0 - 1) * D + c), h2[0], h2[1]); }
#pragma unroll 16
        for (int i = 0; i < 32; ++i) { f32x4 x[2]; unpack8(*(const GAS u32x4*)(XBR + (size_t)(t0 + i) * D + c), x[0], x[1]); f32x4 o[2];
#pragma unroll
            for (int q = 0; q < 2; ++q) { o[q] = b[q] + w[0][q] * h0[q] + w[1][q] * h1[q] + w[2][q] * h2[q] + w[3][q] * x[q]; h0[q] = h1[q]; h1[q] = h2[q]; h2[q] = x[q]; }
            *(u32x4*)(XC + (size_t)(t0 + i) * D + c) = pack8(o[0], o[1]); }
    }
}
__device__ __forceinline__ void scan_a_phase(LAS unsigned char* lds, const bf16* LOGA, const bf16* XN, float* AGG, float* CARRY, int bx, int G, int tid) {
    LAS float* sA = (LAS float*)lds; LAS float* sH = sA + 64 * 64;
    for (int item = bx; item < 256; item += G) {
        const int b = item >> 5, slab = (item >> 1) & 15, half = item & 1, seg = tid >> 3, cg = tid & 7, c = slab * 64 + cg * 8;
        const size_t row0 = (size_t)b * SEQ + half * 2048 + seg * 32;
        f32x4 A[2], H[2]; A[0] = A[1] = (f32x4){0.f, 0.f, 0.f, 0.f}; H[0] = H[1] = A[0];
#pragma unroll 8
        for (int i = 0; i < 32; ++i) { f32x4 la[2], xn[2]; unpack8(*(const GAS u32x4*)(LOGA + (row0 + i) * D + c), la[0], la[1]); unpack8(*(const GAS u32x4*)(XN + (row0 + i) * D + c), xn[0], xn[1]);
#pragma unroll
            for (int q = 0; q < 2; ++q) { A[q] += la[q];
#pragma unroll
                for (int j = 0; j < 4; ++j) H[q][j] = fexp(la[q][j]) * H[q][j] + xn[q][j]; } }
        __syncthreads();
#pragma unroll
        for (int q = 0; q < 2; ++q) { *(LAS f32x4*)(sA + seg * 64 + cg * 8 + 4 * q) = A[q]; *(LAS f32x4*)(sH + seg * 64 + cg * 8 + 4 * q) = H[q]; }
        __syncthreads();
        if (tid < 64) { float pl = 0.f, h = 0.f; float* cr = CARRY + (size_t)item * 64 * 128;
            for (int sgi = 0; sgi < 64; ++sgi) { cr[sgi * 128 + tid] = pl; cr[sgi * 128 + 64 + tid] = h; const float a = sA[sgi * 64 + tid]; h = fexp(a) * h + sH[sgi * 64 + tid]; pl += a; }
            AGG[item * 128 + tid] = pl; AGG[item * 128 + 64 + tid] = h; }
    }
}
__device__ __forceinline__ void scan_c_phase(const bf16* LOGA, const bf16* XN, const bf16* GATE, const float* AGG, const float* CARRY, bf16* YL, int bx, int G, int tid) {
    for (int item = bx; item < 256; item += G) {
        const int b = item >> 5, slab = (item >> 1) & 15, half = item & 1, seg = tid >> 3, cg = tid & 7, c = slab * 64 + cg * 8;
        const size_t row0 = (size_t)b * SEQ + half * 2048 + seg * 32;
        const float* cr = CARRY + (size_t)item * 64 * 128 + seg * 128 + cg * 8;
        f32x4 h[2];
#pragma unroll
        for (int q = 0; q < 2; ++q) { const f32x4 pl = *(const f32x4*)(cr + 4 * q), hl = *(const f32x4*)(cr + 64 + 4 * q);
            f32x4 hw = (f32x4){0.f, 0.f, 0.f, 0.f}; if (half) hw = *(const f32x4*)(AGG + (item - 1) * 128 + 64 + cg * 8 + 4 * q);
#pragma unroll
            for (int j = 0; j < 4; ++j) h[q][j] = hl[j] + fexp(pl[j]) * hw[j]; }
#pragma unroll 8
        for (int i = 0; i < 32; ++i) { f32x4 la[2], xn[2], g[2], y[2]; const size_t o = (row0 + i) * D + c;
            unpack8(*(const GAS u32x4*)(LOGA + o), la[0], la[1]); unpack8(*(const GAS u32x4*)(XN + o), xn[0], xn[1]); unpack8(*(const GAS u32x4*)(GATE + o), g[0], g[1]);
#pragma unroll
            for (int q = 0; q < 2; ++q)
#pragma unroll
                for (int j = 0; j < 4; ++j) { h[q][j] = fexp(la[q][j]) * h[q][j] + xn[q][j]; y[q][j] = h[q][j] * g[q][j]; }
            *(u32x4*)(YL + o) = pack8(y[0], y[1]); }
    }
}


__device__ __forceinline__ void gla_core_ref_phase(LAS unsigned char* lds, const bf16* Q, const bf16* Kb, const bf16* V, const bf16* SG, const float* AF, const float* hn, bf16* OG, int bx, int G, int tid) {
    LAS float* part = (LAS float*)lds;
    LAS float* red = part + 512;
    const int e = tid & 255, hf = tid >> 8, lane = tid & 63, w4 = (tid >> 6) & 3;
    for (int bh = bx; bh < 32; bh += G) {
        const int b = bh >> 2, h = bh & 3;
        float S[64];
#pragma unroll
        for (int d = 0; d < 64; ++d) S[d] = 0.f;
        const float hw = hn[e];
        for (int t = 0; t < SEQ; ++t) {
            const size_t row = (size_t)b * SEQ + t;
            const float v = bf2f(V[row * 1024 + h * 256 + e]);
            const float* a = AF + row * 512 + h * 128 + hf * 64; const bf16* k = Kb + row * 512 + h * 128 + hf * 64; const bf16* q = Q + row * 512 + h * 128 + hf * 64;
            float o = 0.f;
#pragma unroll
            for (int d = 0; d < 64; ++d) { S[d] = a[d] * S[d] + bf2f(k[d]) * v; o += bf2f(q[d]) * S[d]; }
            part[hf * 256 + e] = o;
            __syncthreads();
            o = (part[e] + part[256 + e]) * QSCALE;
            float ss = wave_sum(o * o);
            if (hf == 0 && lane == 0) red[w4] = ss;
            __syncthreads();
            ss = red[0] + red[1] + red[2] + red[3];
            const float rstd = rsqrtf(ss * (1.f / 256.f) + EPS);
            if (hf == 0) OG[row * 1024 + h * 256 + e] = f2bf(o * rstd * hw * bf2f(SG[row * 1024 + h * 256 + e]));
        }
        __syncthreads();
    }
}


typedef float f32x16 __attribute__((ext_vector_type(16)));
typedef short s16x4 __attribute__((ext_vector_type(4)));
typedef short v4i16_t __attribute__((ext_vector_type(4)));
typedef __bf16 bf16x2_t __attribute__((ext_vector_type(2)));
__device__ __forceinline__ unsigned cvtpk2(float lo, float hi) { f32x2 v = {lo, hi}; bf16x2_t b = __builtin_convertvector(v, bf16x2_t); return __builtin_bit_cast(unsigned, b); }
__device__ __forceinline__ s16x4 vtr(const LAS unsigned char* p) { return __builtin_bit_cast(s16x4, __builtin_amdgcn_ds_read_tr16_b64_v4i16((LAS v4i16_t*)p)); }
__device__ __forceinline__ bf16x8 tr_frag(const LAS unsigned char* a, int P) { const s16x4 lo = vtr(a), hi = vtr(a + 4 * P); return __builtin_shufflevector(lo, hi, 0, 1, 2, 3, 4, 5, 6, 7); }
__device__ __forceinline__ int crow(int r, int hh) { return (r & 3) + 8 * (r >> 2) + 4 * hh; }
#define MFMA32(a, b, c) __builtin_amdgcn_mfma_f32_32x32x16_bf16((a), (b), (c), 0, 0, 0)
#define CORE_BAR() asm volatile("s_waitcnt lgkmcnt(0)\n\ts_barrier" ::: "memory")

template <bool FULL>
__device__ __forceinline__ void gla_core_phase(LAS unsigned char* lds, const bf16* Q, const bf16* Kb, const bf16* V, const bf16* SG, const bf16* EQ, const bf16* EK,
                                               const float* EREF, const float* ELAST, const float* ELR, bf16* OG, float* USEG, int bx, int G, int wave) {
    constexpr int NSEG = 8, SEGC = 8;
    constexpr int TP = 272, VP = 80, PP = 144;
    constexpr int O_QP = 0, O_KP = 17408, O_QC = 34816, O_KST = 52224, O_V = 69632, O_P = 110592, O_PART = 119808, O_VEC = 121856;
    const int lane = lane_id_v(), tid = wave * 64 + lane, hh = lane >> 5, l31 = lane & 31;
    const int ptok = tid >> 3, pdp = tid & 7;
    LAS unsigned char* vsl = lds + O_V + wave * (64 * VP);
    const int troff = (8 * hh + ((lane & 15) >> 2)) * 1 ;
    const int trcol = 32 * ((lane >> 4) & 1) + 8 * (lane & 3);
    LAS float* part = (LAS float*)(lds + O_PART);
    for (int un = bx; un < 32 * NSEG; un += G) {
        const int bh = un & 31, seg = un >> 5, c0 = seg * SEGC, b = bh >> 2, h = bh & 3;
        if (!FULL && seg == NSEG - 1) continue;
        const size_t seq0 = (size_t)b * SEQ;
        f32x16 S[4];
#pragma unroll
        for (int dt = 0; dt < 4; ++dt)
#pragma unroll
            for (int r = 0; r < 16; ++r) S[dt][r] = 0.f;
        if (FULL) {
            for (int sg = 0; sg < seg; ++sg) {
                CORE_BAR();
                if (tid < 128) { float a = 1.f; const float* ep = ELAST + ((size_t)(b * 64 + sg * SEGC)) * 512 + h * 128 + tid;
#pragma unroll
                    for (int q = 0; q < SEGC; ++q) a *= *(const GAS float*)(ep + q * 512);
                    ((LAS float*)(lds + O_VEC))[256 + tid] = a; }
                CORE_BAR();
                const LAS float* el = (const LAS float*)(lds + O_VEC) + 256;
                const GAS float* up = (const GAS float*)USEG + (((size_t)(bh * NSEG + sg) * 8 + wave) * 64) * 64 + lane;
#pragma unroll
                for (int dt = 0; dt < 4; ++dt)
#pragma unroll
                    for (int g = 0; g < 4; ++g) { const f32x4 e4 = *(const LAS f32x4*)(el + 32 * dt + 8 * g + 4 * hh);
#pragma unroll
                        for (int j = 0; j < 4; ++j) S[dt][4 * g + j] = S[dt][4 * g + j] * e4[j] + up[(dt * 16 + 4 * g + j) * 64]; }
            }
            CORE_BAR();
        }
        u32x4 pq[2], pk[2], peq[2], pek[2], pv[4]; float ve[3] = {0.f, 0.f, 0.f};
#define CORE_LOAD(cc) do { const size_t rr = seq0 + (size_t)(cc) * 64; \
            { const size_t o = (rr + ptok) * 512 + h * 128 + pdp * 16; \
              if (FULL) { pq[0] = *(const GAS u32x4*)(Q + o); pq[1] = *(const GAS u32x4*)(Q + o + 8); peq[0] = *(const GAS u32x4*)(EQ + o); peq[1] = *(const GAS u32x4*)(EQ + o + 8); } pk[0] = *(const GAS u32x4*)(Kb + o); pk[1] = *(const GAS u32x4*)(Kb + o + 8); \
              pek[0] = *(const GAS u32x4*)(EK + o); pek[1] = *(const GAS u32x4*)(EK + o + 8); } \
            { const bf16* vp = V + (rr + lane) * 1024 + h * 256 + wave * 32; pv[0] = *(const GAS u32x4*)vp; pv[1] = *(const GAS u32x4*)(vp + 8); pv[2] = *(const GAS u32x4*)(vp + 16); pv[3] = *(const GAS u32x4*)(vp + 24); } \
            if (tid < 128) { const size_t vo = (rr >> 6) * 512 + h * 128 + tid; ve[0] = *(const GAS float*)(EREF + vo); ve[1] = *(const GAS float*)(ELR + vo); ve[2] = *(const GAS float*)(ELAST + vo); } } while (0)
#define CORE_VEC(par) do { if (tid < 128) { LAS float* vv = (LAS float*)(lds + O_VEC) + (par) * 384; vv[tid] = ve[0]; vv[128 + tid] = ve[1]; vv[256 + tid] = ve[2]; } } while (0)
#define CORE_PREP(par) do { const LAS float* vv = (const LAS float*)(lds + O_VEC) + (par) * 384 + pdp * 16; \
            _Pragma("unroll") for (int q2 = 0; q2 < 2; ++q2) { f32x4 q0, q1, e0, e1, k0, k1, g0, g1; if (FULL) { unpack8(pq[q2], q0, q1); unpack8(peq[q2], e0, e1); } unpack8(pk[q2], k0, k1); unpack8(pek[q2], g0, g1); \
                const f32x4 er0 = *(const LAS f32x4*)(vv + q2 * 8), er1 = *(const LAS f32x4*)(vv + q2 * 8 + 4), lr0 = *(const LAS f32x4*)(vv + 128 + q2 * 8), lr1 = *(const LAS f32x4*)(vv + 128 + q2 * 8 + 4); \
                k0 = k0 * g0; k1 = k1 * g1; \
                const int lo_ = ptok * TP + (pdp * 16 + q2 * 8) * 2; \
                if (FULL) { q0 = q0 * e0; q1 = q1 * e1; *(LAS u32x4*)(lds + O_QP + lo_) = pack8(q0, q1); *(LAS u32x4*)(lds + O_KP + lo_) = pack8(k0, k1); *(LAS u32x4*)(lds + O_QC + lo_) = pack8(q0 * er0, q1 * er1); } \
                *(LAS u32x4*)(lds + O_KST + lo_) = pack8(k0 * lr0, k1 * lr1); } \
            _Pragma("unroll") for (int i_ = 0; i_ < 4; ++i_) *(LAS u32x4*)(vsl + lane * VP + i_ * 16) = pv[i_]; } while (0)
        CORE_LOAD(c0); CORE_VEC(0);
        CORE_BAR();
        CORE_PREP(0);
        CORE_BAR();
        for (int c = c0; c < c0 + SEGC; ++c) {
            const int par = (c - c0) & 1; const size_t row0 = seq0 + (size_t)c * 64;
            u32x4 psg[4];
            if (FULL)
#pragma unroll
            for (int q = 0; q < 4; ++q) psg[q] = *(const GAS u32x4*)(SG + (row0 + 16 * q + (lane >> 2)) * 1024 + h * 256 + wave * 32 + 8 * (lane & 3));
            CORE_LOAD(c < c0 + SEGC - 1 ? c + 1 : c0 + SEGC - 1);
            if (FULL && wave < 3) { const int jt = wave == 2 ? 1 : 0, it = wave >= 1 ? 1 : 0; f32x16 p;
#pragma unroll
                for (int r = 0; r < 16; ++r) p[r] = 0.f;
#pragma unroll
                for (int ks = 0; ks < 8; ++ks) { const bf16x8 a = *(const LAS bf16x8*)(lds + O_KP + (32 * jt + l31) * TP + (16 * ks + 8 * hh) * 2), bq = *(const LAS bf16x8*)(lds + O_QP + (32 * it + l31) * TP + (16 * ks + 8 * hh) * 2);
                    p = MFMA32(a, bq, p); }
                if (jt == it) {
#pragma unroll
                    for (int r = 0; r < 16; ++r) p[r] = crow(r, hh) <= l31 ? p[r] : 0.f; }
#pragma unroll
                for (int g = 0; g < 4; ++g) { u32x2 w; w.x = cvtpk2(p[4 * g], p[4 * g + 1]); w.y = cvtpk2(p[4 * g + 2], p[4 * g + 3]);
                    *(LAS u32x2*)(lds + O_P + (32 * it + l31) * PP + (32 * jt + 8 * g + 4 * hh) * 2) = w; }
            }
            f32x16 o[2];
#pragma unroll
            for (int it = 0; it < 2; ++it)
#pragma unroll
                for (int r = 0; r < 16; ++r) o[it][r] = 0.f;
            if (FULL)
#pragma unroll
            for (int ks = 0; ks < 8; ++ks) { const int dt = ks >> 1, s2 = ks & 1; u32x4 ap;
                ap.x = cvtpk2(S[dt][8 * s2 + 0], S[dt][8 * s2 + 1]); ap.y = cvtpk2(S[dt][8 * s2 + 2], S[dt][8 * s2 + 3]); ap.z = cvtpk2(S[dt][8 * s2 + 4], S[dt][8 * s2 + 5]); ap.w = cvtpk2(S[dt][8 * s2 + 6], S[dt][8 * s2 + 7]);
                const bf16x8 a = __builtin_bit_cast(bf16x8, ap);
#pragma unroll
                for (int it = 0; it < 2; ++it) { const LAS unsigned char* qa = lds + O_QC + (32 * it + l31) * TP + (32 * dt + 16 * s2 + 4 * hh) * 2;
                    const s16x4 lo = *(const LAS s16x4*)qa, hi = *(const LAS s16x4*)(qa + 16);
                    o[it] = MFMA32(a, __builtin_shufflevector(lo, hi, 0, 1, 2, 3, 4, 5, 6, 7), o[it]); } }
            if (FULL) CORE_BAR();
            bf16x8 vf[4];
#pragma unroll
            for (int s4 = 0; s4 < 4; ++s4) vf[s4] = tr_frag(vsl + (16 * s4 + troff) * VP + trcol, VP);
            if (FULL)
#pragma unroll
            for (int it = 0; it < 2; ++it)
#pragma unroll
                for (int s4 = 0; s4 < 4; ++s4) { if (it == 0 && s4 >= 2) continue;
                    const bf16x8 pb = *(const LAS bf16x8*)(lds + O_P + (32 * it + l31) * PP + (16 * s4 + 8 * hh) * 2);
                    o[it] = MFMA32(vf[s4], pb, o[it]); }
            if (FULL)
#pragma unroll
            for (int it = 0; it < 2; ++it) { float ss = 0.f;
#pragma unroll
                for (int r = 0; r < 16; ++r) ss += o[it][r] * o[it][r];
                ss += __shfl_xor(ss, 32);
                if (hh == 0) part[wave * 64 + 32 * it + l31] = ss; }
            { const LAS float* el = (const LAS float*)(lds + O_VEC) + par * 384 + 256;
#pragma unroll
              for (int dt = 0; dt < 4; ++dt)
#pragma unroll
                for (int g = 0; g < 4; ++g) { const f32x4 e4 = *(const LAS f32x4*)(el + 32 * dt + 8 * g + 4 * hh);
#pragma unroll
                    for (int j = 0; j < 4; ++j) S[dt][4 * g + j] *= e4[j]; }
#pragma unroll
              for (int dt = 0; dt < 4; ++dt)
#pragma unroll
                for (int s4 = 0; s4 < 4; ++s4) S[dt] = MFMA32(tr_frag(lds + O_KST + (16 * s4 + troff) * TP + 64 * dt + trcol, TP), vf[s4], S[dt]); }
            CORE_VEC(par ^ 1);
            CORE_BAR();
            if (FULL) {
#pragma unroll
                for (int it = 0; it < 2; ++it) { float tot = 0.f;
#pragma unroll
                    for (int w8 = 0; w8 < 8; ++w8) tot += part[w8 * 64 + 32 * it + l31];
                    const float rstd = rsqrtf(tot * (1.f / 256.f) + EPS);
#pragma unroll
                    for (int g = 0; g < 4; ++g) { u32x2 w; w.x = cvtpk2(o[it][4 * g] * rstd, o[it][4 * g + 1] * rstd); w.y = cvtpk2(o[it][4 * g + 2] * rstd, o[it][4 * g + 3] * rstd);
                        *(LAS u32x2*)(vsl + (32 * it + l31) * VP + (8 * g + 4 * hh) * 2) = w; } }
                asm volatile("s_waitcnt lgkmcnt(0)" ::: "memory");
#pragma unroll
                for (int q = 0; q < 4; ++q) { const int rw = 16 * q + (lane >> 2); f32x4 a0, a1, g0, g1;
                    unpack8(*(const LAS u32x4*)(vsl + rw * VP + 16 * (lane & 3)), a0, a1); unpack8(psg[q], g0, g1);
                    *(GAS u32x4*)(OG + (row0 + rw) * 1024 + h * 256 + wave * 32 + 8 * (lane & 3)) = pack8(a0 * g0, a1 * g1); }
            }
            CORE_PREP(par ^ 1);
            CORE_BAR();
        }
        if (!FULL) { GAS float* up = (GAS float*)USEG + (((size_t)(bh * NSEG + seg) * 8 + wave) * 64) * 64 + lane;
#pragma unroll
            for (int dt = 0; dt < 4; ++dt)
#pragma unroll
                for (int r = 0; r < 16; ++r) up[(dt * 16 + r) * 64] = S[dt][r]; }
#undef CORE_LOAD
#undef CORE_VEC
#undef CORE_PREP
    }
}

struct MArgs { const float* in[24]; float* out; unsigned char* ws; int ph_lo, ph_hi, li, pad; };

#define CVT_ITEMS(IT_LO, IT_HI, GW_, NGW_) do { \
        LAS float* scr = (LAS float*)(lds + wave * 16384); \
        constexpr int I_A = 1536, I_B = 256, I_C = 512, I_D = 1024, I_E = 512, I_F = 256, I_G = 16384; \
        for (int it = (IT_LO) + (GW_); it < (IT_HI); it += (NGW_)) { \
            int r = it; \
            if (r < I_A) { cvt_item(in[2], 3088, 0, in[1], W1, 1024, 0, r / 96, r % 96, scr, lane); continue; } r -= I_A; \
            if (r < I_B) { cvt_item_la(in[2], in[3], in[1], W1, r / 16, r % 16, scr, lane); continue; } r -= I_B; \
            if (r < I_C) { cvt_item(in[6], 1024, 0, in[5], WO, 1024, 0, r / 32, r % 32, scr, lane, 255); continue; } r -= I_C; \
            if (r < I_D) { cvt_item(in[8], 2048, 0, in[7], WLI, 1024, 0, r / 64, r % 64, scr, lane); continue; } r -= I_D; \
            if (r < I_E) { cvt_item(in[16], 1024, 0, nullptr, WLO, 1024, 0, r / 32, r % 32, scr, lane); continue; } r -= I_E; \
            if (r < I_F) { const int seg = r / 16, q = r % 16, nb4 = seg >> 2, half = (seg >> 1) & 1, pn = seg & 1; \
                cvt_item((half ? in[13] : in[11]) + (size_t)nb4 * 65536, 256, pn * 128, nullptr, WG + (size_t)nb4 * 512 * 256, 256, pn * 256 + half * 128, q / 4, q % 4, scr, lane); continue; } r -= I_F; \
            if (r < I_G) { const int seg = r / 64, q = r % 64, le = seg >> 2, half = (seg >> 1) & 1, pn = seg & 1; \
                cvt_item((half ? in[21] : in[20]) + (size_t)le * 1024 * 256, 256, pn * 128, in[17] + (le >> 5) * D, WGU + (size_t)le * 512 * 1024, 1024, pn * 256 + half * 128, q / 4, q % 4, scr, lane); continue; } r -= I_G; \
            { const int le = r / 128, q = r % 128; cvt_item(in[22] + (size_t)le * 256 * 1024, 1024, 0, nullptr, WD + (size_t)le * 1024 * 256, 256, 0, q / 32, q % 32, scr, lane); } \
        } } while (0)
constexpr int CVT_W1_ITEMS = 1536 + 256, CVT_ALL_ITEMS = 1536 + 256 + 512 + 1024 + 512 + 256 + 16384 + 8192;
__global__ void __launch_bounds__(NTHR, 2) mega(MArgs args) {
    extern __shared__ __attribute__((aligned(16))) unsigned char lds_raw[];
    LAS unsigned char* lds = (LAS unsigned char*)lds_raw;
    volatile LAS unsigned* MISC = (volatile LAS unsigned*)(lds + LDS_MISC);
    const int wave = __builtin_amdgcn_readfirstlane((int)(threadIdx.x >> 6));
    const int G = gridDim.x, bx = blockIdx.x;
    unsigned char* ws = args.ws;
    unsigned* ctl = (unsigned*)(ws + WS_CTL);
    { const int tid0 = wave * 64 + lane_id_v();
      for (int u = tid0; u < (LDS_BYTES - LDS_MISC) / 4; u += NTHR) ((LAS unsigned*)(lds + LDS_MISC))[u] = 0u;
      __syncthreads(); }
    XcdBarrier bar = xcd_barrier_post(ctl + CW_BAR + args.li * XCD_BAR_WORDS, MISC + 8, wave == 0 && lane_id_v() == 0);
#define TIDLANE const int lane = lane_id_v(), tid = wave * 64 + lane; (void)tid; (void)lane;
    const int lo = args.ph_lo, hi = args.ph_hi;
#define IN(k) (lo <= (k) && (k) < hi)
#define BOTH(k) (IN(k) && IN((k) + 1))
    const float* const* in = args.in;
#define PH_PTRS unsigned char* wsp = args.ws; asm volatile("" : "+s"(wsp)); \
    float *RS0 = (float*)(wsp + WS_RS0), *RS1 = (float*)(wsp + WS_RS1), *RS2 = (float*)(wsp + WS_RS2), *RS3 = (float*)(wsp + WS_RS3); \
    float *EREF = (float*)(wsp + WS_EREF), *ELAST = (float*)(wsp + WS_ELAST), *ELR = (float*)(wsp + WS_ELR); \
    bf16 *S0 = (bf16*)(wsp + WS_S0), *S1 = (bf16*)(wsp + WS_S1), *S2 = (bf16*)(wsp + WS_S2), *S3 = (bf16*)(wsp + WS_S3), *S4 = (bf16*)(wsp + WS_S4), *S5 = (bf16*)(wsp + WS_S5); \
    bf16 *W1 = (bf16*)(wsp + WS_W1), *WO = (bf16*)(wsp + WS_WO), *WLI = (bf16*)(wsp + WS_WLI), *WLO = (bf16*)(wsp + WS_WLO), *WG = (bf16*)(wsp + WS_WG), *WGU = (bf16*)(wsp + WS_WGU), *WD = (bf16*)(wsp + WS_WD); \
    int* LIST = (int*)(wsp + WS_LIST); float* LW = (float*)(wsp + WS_LW); int* POS = (int*)(wsp + WS_POS); const bf16* WR = (const bf16*)(wsp + WS_WR); unsigned* ctlp = (unsigned*)(wsp + WS_CTL); \
    (void)RS0; (void)RS1; (void)RS2; (void)RS3; (void)EREF; (void)ELAST; (void)ELR; (void)S0; (void)S1; (void)S2; (void)S3; (void)S4; (void)S5; \
    (void)W1; (void)WO; (void)WLI; (void)WLO; (void)WG; (void)WGU; (void)WD; (void)LIST; (void)LW; (void)POS; (void)WR; (void)ctlp;

    if (IN(0)) { PH_PTRS TIDLANE
        const int gw = bx * NWAVES + wave, NGW = G * NWAVES;
        bf16* XB = S0;
        for (int row = gw; row < T; row += 2 * NGW) {
            const int row2 = row + NGW < T ? row + NGW : row;
            const GAS f32x4* xr = (const GAS f32x4*)(in[0] + (size_t)row * D) + lane; const GAS f32x4* xr2 = (const GAS f32x4*)(in[0] + (size_t)row2 * D) + lane; f32x4 v[4], v2[4]; float s = 0.f, s2 = 0.f;
#pragma unroll
            for (int j = 0; j < 4; ++j) { v[j] = xr[64 * j]; v2[j] = xr2[64 * j]; }
#pragma unroll
            for (int j = 0; j < 4; ++j) { s += (v[j].x * v[j].x + v[j].y * v[j].y) + (v[j].z * v[j].z + v[j].w * v[j].w); s2 += (v2[j].x * v2[j].x + v2[j].y * v2[j].y) + (v2[j].z * v2[j].z + v2[j].w * v2[j].w); }
            s = wave_sum(s); s2 = wave_sum(s2);
            GAS u32x2* o8 = (GAS u32x2*)(XB + (size_t)row * D) + lane; GAS u32x2* o82 = (GAS u32x2*)(XB + (size_t)row2 * D) + lane;
#pragma unroll
            for (int j = 0; j < 4; ++j) { u32x2 w; w.x = cvt_pk_bf16(v[j].x, v[j].y); w.y = cvt_pk_bf16(v[j].z, v[j].w); o8[64 * j] = w; u32x2 w2; w2.x = cvt_pk_bf16(v2[j].x, v2[j].y); w2.y = cvt_pk_bf16(v2[j].z, v2[j].w); o82[64 * j] = w2; }
            if (lane == 0) { RS0[row] = rsqrtf(s * (1.f / D) + EPS); RS0[row2] = rsqrtf(s2 * (1.f / D) + EPS); }
        }
        CVT_ITEMS(0, CVT_ALL_ITEMS, gw, NGW);
        float* SP = (float*)(wsp + WS_SP); bf16* WRw = (bf16*)(wsp + WS_WR);
        for (int i = bx * NTHR + tid; i < 1024; i += G * NTHR) { const float l = -in[15][i]; SP[i] = fmaxf(l, 0.f) + log1pf(__expf(-fabsf(l))); }
        for (int i = bx * NTHR + tid; i < 2 * 48 * 1024; i += G * NTHR) { const int l = i / (48 * 1024), n = (i / 1024) % 48, k = i % 1024; float v = 0.f;
            if (n < 4) v = in[18][(size_t)l * D * 4 + k * 4 + n]; else if (n < 36) v = in[19][(size_t)l * D * 32 + k * 32 + n - 4];
            WRw[i] = f2bf(v * in[17][l * D + k]); }
        if (BOTH(0)) xcd_barrier(bar, wave);
    }
    if (IN(1)) { PH_PTRS
        pg8::SchedDense S{128, 14, G, bx, (const char*)S0, (const char*)W1, (size_t)256 * 1024 * 2, (size_t)256 * 1024 * 2, 1, 0};
        EpiG1 E{S1, S1 + (size_t)T * 512, S2, S3, S4, S4 + (size_t)T * 512, EREF, ELAST, ELR, nullptr, RS0, in[4]};
        pg8::gemm_phase<EpiG1, pg8::SchedDense, false>(lds, 1024, 1024, 1024, S, E, wave);
        if (BOTH(1)) xcd_barrier(bar, wave);
    }
    if (IN(2)) { PH_PTRS
        gla_core_phase<false>(lds, S1, S1 + (size_t)T * 512, S2, S3, S4, S4 + (size_t)T * 512, EREF, ELAST, ELR, S0, (float*)S5, bx, G, wave);
        xcd_barrier(bar, wave);
        gla_core_phase<true>(lds, S1, S1 + (size_t)T * 512, S2, S3, S4, S4 + (size_t)T * 512, EREF, ELAST, ELR, S0, (float*)S5, bx, G, wave);
        if (BOTH(2)) xcd_barrier(bar, wave);
    }
    if (IN(3)) { PH_PTRS
        pg8::SchedDense S{128, 4, G, bx, (const char*)S0, (const char*)WO, (size_t)256 * 1024 * 2, (size_t)256 * 1024 * 2, 1, 0};
        EpiResidF E{in[0], nullptr, S1};
        pg8::gemm_phase<EpiResidF, pg8::SchedDense, false>(lds, 1024, 1024, 1024, S, E, wave);
        if (BOTH(3)) xcd_barrier(bar, wave);
    }

    LAS int* ts = (LAS int*)(lds + LDS_MISC + TS_OFF);
#define MOE_PHASES(P, LAYER, XIN, RSX, ACTB, YB, XOUT, RSOUT, FW, OUTP) \
    if (IN(P)) { PH_PTRS TIDLANE router_phase(lds, XIN, WR + (size_t)(LAYER) * 48 * 1024, RSX, ctlp + CW_CNT + 64 * (LAYER), LIST, LW, POS, bx, G, tid, lane, wave); if (BOTH(P)) xcd_barrier(bar, wave); } \
    if (IN(P + 1)) { PH_PTRS TIDLANE build_ts(ctlp + CW_CNT + 64 * (LAYER), ts, tid); \
        pg8::SchedMoe S{ts, G, bx, 2, (const char*)(XIN), (const char*)(WGU + (size_t)(LAYER) * 32 * 512 * 1024), LIST, (size_t)512 * 1024 * 2, (size_t)256 * 1024 * 2, 0, true}; \
        EpiM1 E{ACTB, LIST, LW, RSX}; \
        pg8::gemm_phase<EpiM1, pg8::SchedMoe, true>(lds, 1024, 1024, 1024, S, E, wave); if (BOTH(P + 1)) xcd_barrier(bar, wave); } \
    if (IN(P + 2)) { PH_PTRS TIDLANE build_ts(ctlp + CW_CNT + 64 * (LAYER), ts, tid); \
        pg8::SchedMoe S{ts, G, bx, 4, (const char*)(ACTB), (const char*)(WD + (size_t)(LAYER) * 32 * 1024 * 256), LIST, (size_t)1024 * 256 * 2, (size_t)256 * 256 * 2, (size_t)256 * 256 * 2, false}; \
        EpiStore E{YB, 1024, 0}; \
        pg8::gemm_phase<EpiStore, pg8::SchedMoe, false>(lds, 256, 256, 256, S, E, wave); if (BOTH(P + 2)) xcd_barrier(bar, wave); } \
    if (IN(P + 3)) { PH_PTRS TIDLANE build_ts(ctlp + CW_CNT + 64 * (LAYER), ts, tid); \
        combine_phase(ts, XIN, YB, POS, XOUT, RSOUT, FW, OUTP, bx, G, lane, wave); if (BOTH(P + 3)) xcd_barrier(bar, wave); }

    MOE_PHASES(4, 0, S1, RS1, S2, S3, S0, RS2, nullptr, nullptr)
    if (IN(8)) { PH_PTRS
        pg8::SchedDense S{128, 8, G, bx, (const char*)S0, (const char*)WLI, (size_t)256 * 1024 * 2, (size_t)256 * 1024 * 2, 1, 0};
        EpiL1 E{S1, S2, RS2};
        pg8::gemm_phase<EpiL1, pg8::SchedDense, false>(lds, 1024, 1024, 1024, S, E, wave);
        if (BOTH(8)) xcd_barrier(bar, wave);
    }
    if (IN(9)) { PH_PTRS TIDLANE conv_phase(S1, in[9], in[10], S3, bx, G, tid); if (BOTH(9)) xcd_barrier(bar, wave); }
    if (IN(10)) { PH_PTRS
        pg8::SchedDense S{128, 8, G, bx, (const char*)S3, (const char*)WG, (size_t)256 * 1024 * 2, (size_t)256 * 256 * 2, 2, (size_t)512};
        EpiL2 E{S3, S4, S5, in[12], in[14], (const float*)(wsp + WS_SP)};
        pg8::gemm_phase<EpiL2, pg8::SchedDense, false>(lds, 1024, 256, 256, S, E, wave);
        if (BOTH(10)) xcd_barrier(bar, wave);
    }
    if (IN(11)) { PH_PTRS TIDLANE scan_a_phase(lds, S4, S5, (float*)(wsp + WS_AGG), (float*)(wsp + WS_CARRY), bx, G, tid); if (BOTH(11)) xcd_barrier(bar, wave); }
    if (IN(12)) { PH_PTRS TIDLANE scan_c_phase(S4, S5, S2, (const float*)(wsp + WS_AGG), (const float*)(wsp + WS_CARRY), S1, bx, G, tid); if (BOTH(12)) xcd_barrier(bar, wave); }
    if (IN(13)) { PH_PTRS
        pg8::SchedDense S{128, 4, G, bx, (const char*)S1, (const char*)WLO, (size_t)256 * 1024 * 2, (size_t)256 * 1024 * 2, 1, 0};
        EpiResidF E{nullptr, S0, S5};
        pg8::gemm_phase<EpiResidF, pg8::SchedDense, false>(lds, 1024, 1024, 1024, S, E, wave);
        if (BOTH(13)) xcd_barrier(bar, wave);
    }
    MOE_PHASES(14, 1, S5, RS3, S3, S0, (bf16*)nullptr, (float*)nullptr, in[23], args.out)
#undef MOE_PHASES
#undef PH_PTRS
#undef TIDLANE
#undef CVT_ITEMS
#undef IN
#undef BOTH
}

static int mega_grid() {
    static int grid = 0;
    if (grid == 0) {
        int dev = 0, cus = 0;
        if (hipGetDevice(&dev) != hipSuccess || hipDeviceGetAttribute(&cus, hipDeviceAttributeMultiprocessorCount, dev) != hipSuccess) { grid = -1; return grid; }
        if (hipFuncSetAttribute((const void*)mega, hipFuncAttributeMaxDynamicSharedMemorySize, LDS_BYTES) != hipSuccess) { fprintf(stderr, "hipFuncSetAttribute failed\n"); grid = -1; return grid; }
        int per_cu = 0;
        if (hipOccupancyMaxActiveBlocksPerMultiprocessor(&per_cu, (const void*)mega, NTHR, LDS_BYTES) != hipSuccess || per_cu < 1) { fprintf(stderr, "occupancy query: %d\n", per_cu); (void)hipGetLastError(); }
        grid = cus;
    }
    return grid;
}
static void launch_mega(const MArgs& base, int lo, int hi, int li, hipStream_t stream) {
    MArgs a = base; a.ph_lo = lo; a.ph_hi = hi; a.li = li; a.pad = 0;
    hipLaunchKernelGGL(mega, dim3(mega_grid()), dim3(NTHR), LDS_BYTES, stream, a);
}
extern "C" void kernel_launch(void* const* d_in, const int* in_sizes, int n_in, void* d_out, int out_size, void* d_ws, size_t ws_size, hipStream_t stream) {
    if (n_in != 24 || out_size != T * D || ws_size < WS_END) { fprintf(stderr, "kernel_launch: unexpected shapes (n_in %d out %d ws %zu)\n", n_in, out_size, ws_size); return; }
    if (mega_grid() <= 0) return;
    const float* const* in = (const float* const*)d_in; unsigned char* ws = (unsigned char*)d_ws;
    (void)hipMemsetAsync(ws + WS_CTL, 0, 1 * MiB, stream);
    MArgs base{}; for (int i = 0; i < 24; ++i) base.in[i] = in[i]; base.out = (float*)d_out; base.ws = ws;
    launch_mega(base, 0, 18, 0, stream);
}
```
